# Optimizing an MI355X kernel written in HIP

```python
import math
import jax, jax.numpy as jnp
from jax import lax
import numpy as np

D_MODEL = 2048
BATCH = 4
SEQ = 4096
DEPTH = 2

GRID_W = 64
CTX_LEN = 256
N_MIXERS = 2
N_CONV_LAYERS = (DEPTH + 1) // 2
N_MLSTM_LAYERS = DEPTH // 2
CONV_WIDTH = 3
MLSTM_HEADS = 8
MLSTM_DQK = D_MODEL // (2 * MLSTM_HEADS)
MLSTM_DV = D_MODEL // MLSTM_HEADS
MLSTM_CHUNK = 64
N_EXPERTS = 16
N_GROUPS = 4
EXPERTS_PER_GROUP = N_EXPERTS // N_GROUPS
TOP_K = 2
D_EXPERT = D_MODEL // 2
ALPHA = (2 * DEPTH) ** 0.25
BETA = (8 * DEPTH) ** -0.25
LN_EPS = 1e-5
HEAD_NORM_EPS = 1e-6

kernel_name = "hybrid_conv_mlstm_grouped_moe_deepnorm_dit"

F32 = jnp.float32


def _layer_norm(x, g, b):
    xf = x.astype(F32)
    mu = jnp.mean(xf, axis=-1, keepdims=True)
    var = jnp.mean(jnp.square(xf - mu), axis=-1, keepdims=True)
    return ((xf - mu) * lax.rsqrt(var + LN_EPS) * g + b).astype(x.dtype)


def _conv3(z, w, axis):
    n = z.shape[axis]
    pad = [(0, 0)] * z.ndim
    pad[axis] = (1, 1)
    zp = jnp.pad(z, pad)
    return (w[0] * lax.slice_in_dim(zp, 0, n, axis=axis)
            + w[1] * lax.slice_in_dim(zp, 1, n + 1, axis=axis)
            + w[2] * lax.slice_in_dim(zp, 2, n + 2, axis=axis))


def _conv_mixer_latent(h, w_in, w_conv, w_out):
    bsz, s, d = h.shape
    rows = s // GRID_W
    bg, cg, v = jnp.split(h @ w_in, 3, axis=-1)
    z = (cg * v).reshape(bsz, rows, GRID_W, d)
    half = d // 2
    z_row = _conv3(z[..., :half], w_conv[:, :half], axis=2)
    z_col = _conv3(z[..., half:], w_conv[:, half:], axis=1)
    z = jnp.concatenate([z_row, z_col], axis=-1).reshape(bsz, s, d)
    return (bg * z) @ w_out


def _conv_mixer_seq(h, w_in, w_conv, w_out):
    bg, cg, v = jnp.split(h @ w_in, 3, axis=-1)
    return (bg * _conv3(cg * v, w_conv, axis=1)) @ w_out


def _zero_state(bsz):
    return (jnp.zeros((bsz, MLSTM_HEADS, MLSTM_DV, MLSTM_DQK), F32),
            jnp.zeros((bsz, MLSTM_HEADS, MLSTM_DQK), F32),
            jnp.zeros((bsz, MLSTM_HEADS), F32))


def _mlstm_scan(q, k, v, i_pre, f_pre, state, with_outputs):
    bsz, s = q.shape[:2]
    nc = s // MLSTM_CHUNK

    def chunks(a):
        a = a.reshape((bsz, nc, MLSTM_CHUNK) + a.shape[2:])
        return jnp.swapaxes(jnp.moveaxis(a, 1, 0), 2, 3)

    qs = chunks(q.astype(F32) * (MLSTM_DQK ** -0.5))
    ks = chunks(k.astype(F32))
    vs = chunks(v.astype(F32))
    i_s = chunks(i_pre.astype(F32))
    lf_s = chunks(jax.nn.log_sigmoid(f_pre.astype(F32)))
    tril = jnp.tril(jnp.ones((MLSTM_CHUNK, MLSTM_CHUNK), dtype=bool))

    def step(carry, inp):
        c_st, n_st, m_st = carry
        qc, kc, vc, ic, lfc = inp
        b = jnp.cumsum(lfc, axis=-1)
        b_end = b[..., -1]
        w_log = b_end[..., None] - b + ic
        m_next = jnp.maximum(b_end + m_st, jnp.max(w_log, axis=-1))
        decay = jnp.exp(b_end + m_st - m_next)
        w = jnp.exp(w_log - m_next[..., None])
        c_next = decay[..., None, None] * c_st + jnp.einsum('bhl,bhlv,bhlk->bhvk', w, vc, kc)
        n_next = decay[..., None] * n_st + jnp.einsum('bhl,bhlk->bhk', w, kc)
        if not with_outputs:
            return (c_next, n_next, m_next), None
        d_log = jnp.where(tril, b[..., :, None] - b[..., None, :] + ic[..., None, :], -jnp.inf)
        a_inter = b + m_st[..., None]
        m_q = jnp.maximum(a_inter, jnp.max(d_log, axis=-1))
        p = jnp.exp(d_log - m_q[..., None]) * jnp.einsum('bhqk,bhsk->bhqs', qc, kc)
        inter = jnp.exp(a_inter - m_q)
        num = (jnp.einsum('bhqs,bhsv->bhqv', p, vc)
               + inter[..., None] * jnp.einsum('bhqk,bhvk->bhqv', qc, c_st))
        den = jnp.sum(p, axis=-1) + inter * jnp.einsum('bhqk,bhk->bhq', qc, n_st)
        h = num / jnp.maximum(jnp.abs(den), jnp.exp(-m_q))[..., None]
        return (c_next, n_next, m_next), h

    state, hs = lax.scan(step, state, (qs, ks, vs, i_s, lf_s))
    if not with_outputs:
        return state, None
    h = jnp.moveaxis(jnp.swapaxes(hs, 2, 3), 0, 1).reshape(bsz, s, MLSTM_HEADS, MLSTM_DV)
    return state, h


def _mlstm_bidir(q, k, v, gates, state_f, state_b, with_outputs):
    st_f, h_f = _mlstm_scan(q, k, v, gates[:, :, 0], gates[:, :, 1], state_f, with_outputs)
    fl = lambda a: jnp.flip(a, axis=1)
    st_b, h_b = _mlstm_scan(fl(q), fl(k), fl(v), fl(gates[:, :, 2]), fl(gates[:, :, 3]),
                            state_b, with_outputs)
    h = h_f + fl(h_b) if with_outputs else None
    return st_f, st_b, h


def _mlstm_project(h, w_in, w_gate, b_gate):
    bsz, s, _ = h.shape
    qk = MLSTM_HEADS * MLSTM_DQK
    vw = MLSTM_HEADS * MLSTM_DV
    u = h @ w_in
    q = u[..., :qk].reshape(bsz, s, MLSTM_HEADS, MLSTM_DQK)
    k = u[..., qk:2 * qk].reshape(bsz, s, MLSTM_HEADS, MLSTM_DQK)
    v = u[..., 2 * qk:2 * qk + vw].reshape(bsz, s, MLSTM_HEADS, MLSTM_DV)
    o = u[..., 2 * qk + vw:]
    gates = (h @ w_gate + b_gate).astype(F32).reshape(bsz, s, 4, MLSTM_HEADS)
    return q, k, v, o, gates


def _mlstm_out(h_sum, o, norm_g, w_out, dtype):
    bsz, s = h_sum.shape[:2]
    mu = jnp.mean(h_sum, axis=-1, keepdims=True)
    var = jnp.mean(jnp.square(h_sum - mu), axis=-1, keepdims=True)
    hn = ((h_sum - mu) * lax.rsqrt(var + HEAD_NORM_EPS)).reshape(bsz, s, MLSTM_HEADS * MLSTM_DV)
    y = (hn * norm_g * jax.nn.sigmoid(o.astype(F32))).astype(dtype)
    return y @ w_out


def _mlstm_mixer(hx, hc, w_in, w_gate, b_gate, norm_g, w_out, ctx_outputs):
    bsz = hx.shape[0]
    qc, kc, vc, oc, gc = _mlstm_project(hc, w_in, w_gate, b_gate)
    qx, kx, vx, ox, gx = _mlstm_project(hx, w_in, w_gate, b_gate)
    st_f, st_b, hc_sum = _mlstm_bidir(qc, kc, vc, gc, _zero_state(bsz), _zero_state(bsz), ctx_outputs)
    _, _, hx_sum = _mlstm_bidir(qx, kx, vx, gx, st_f, st_b, True)
    out_x = _mlstm_out(hx_sum, ox, norm_g, w_out, hx.dtype)
    out_c = _mlstm_out(hc_sum, oc, norm_g, w_out, hc.dtype) if ctx_outputs else None
    return out_x, out_c


def _moe(h, router_w, router_b, w_gate, w_up, w_down):
    shape = h.shape
    t = h.reshape(-1, shape[-1])
    s = jax.nn.sigmoid((t @ router_w).astype(F32))
    sel = s + router_b.astype(F32)
    grp = jnp.sum(lax.top_k(sel.reshape(-1, N_GROUPS, EXPERTS_PER_GROUP), 2)[0], axis=-1)
    g_best = jnp.argmax(grp, axis=-1)
    in_grp = (jnp.arange(N_EXPERTS) // EXPERTS_PER_GROUP)[None, :] == g_best[:, None]
    _, idx = lax.top_k(jnp.where(in_grp, sel, -jnp.inf), TOP_K)
    wts = jnp.take_along_axis(s, idx, axis=-1)
    wts = wts / jnp.sum(wts, axis=-1, keepdims=True)
    combine = jnp.sum(jax.nn.one_hot(idx, N_EXPERTS, dtype=F32) * wts[..., None], axis=1).astype(t.dtype)
    out = jnp.zeros_like(t)
    for e in range(N_EXPERTS):
        he = jax.nn.silu(t @ w_gate[e]) * (t @ w_up[e])
        out = out + combine[:, e:e + 1] * (he @ w_down[e])
    return out.reshape(shape)


def setup_inputs(seed: int = 0) -> dict:
    key = jax.random.key(seed)
    ks = jax.random.split(key, 24)
    nrm = lambda k, shape, scale: jax.random.normal(k, shape, F32) * scale
    d = D_MODEL
    h = MLSTM_HEADS
    fb = jnp.linspace(3.0, 6.0, h, dtype=F32)
    gate_bias_base = jnp.concatenate([jnp.zeros((h,), F32), fb, jnp.zeros((h,), F32), fb])
    ml_in_w = 2 * h * MLSTM_DQK + 2 * h * MLSTM_DV
    return {
        "x": nrm(ks[0], (BATCH, SEQ, d), 1.0),
        "c": nrm(ks[1], (BATCH, d), 1.0),
        "ctx": nrm(ks[2], (BATCH, CTX_LEN, d), 1.0),
        "c_ctx": nrm(ks[3], (d,), 1.0),
        "w_ada": nrm(ks[4], (DEPTH, d, 6 * d), 0.5 * d ** -0.5),
        "b_ada": nrm(ks[5], (DEPTH, 6 * d), 0.02),
        "ln_g": 1.0 + nrm(ks[6], (DEPTH, 2, d), 0.02),
        "ln_b": nrm(ks[7], (DEPTH, 2, d), 0.02),
        "conv_w_in": nrm(ks[8], (N_CONV_LAYERS, d, 3 * d), d ** -0.5),
        "conv_w": nrm(ks[9], (N_CONV_LAYERS, CONV_WIDTH, d), CONV_WIDTH ** -0.5),
        "conv_w_out": nrm(ks[10], (N_CONV_LAYERS, d, d), BETA * d ** -0.5),
        "ml_w_in": nrm(ks[11], (N_MLSTM_LAYERS, d, ml_in_w), d ** -0.5),
        "ml_w_gate": nrm(ks[12], (N_MLSTM_LAYERS, d, 4 * h), 0.5 * d ** -0.5),
        "ml_b_gate": gate_bias_base + nrm(ks[13], (N_MLSTM_LAYERS, 4 * h), 0.01),
        "ml_norm_g": 1.0 + nrm(ks[14], (N_MLSTM_LAYERS, h * MLSTM_DV), 0.02),
        "ml_w_out": nrm(ks[15], (N_MLSTM_LAYERS, h * MLSTM_DV, d), BETA * (h * MLSTM_DV) ** -0.5),
        "router_w": nrm(ks[16], (d, N_EXPERTS), d ** -0.5),
        "router_b": nrm(ks[17], (N_EXPERTS,), 0.01),
        "exp_w_gate": nrm(ks[18], (DEPTH, N_EXPERTS, d, D_EXPERT), d ** -0.5),
        "exp_w_up": nrm(ks[19], (DEPTH, N_EXPERTS, d, D_EXPERT), d ** -0.5),
        "exp_w_down": nrm(ks[20], (DEPTH, N_EXPERTS, D_EXPERT, d), BETA * D_EXPERT ** -0.5),
    }


def reference(x, c, ctx, c_ctx, w_ada, b_ada, ln_g, ln_b, conv_w_in, conv_w, conv_w_out,
              ml_w_in, ml_w_gate, ml_b_gate, ml_norm_g, ml_w_out, router_w, router_b,
              exp_w_gate, exp_w_up, exp_w_down):
    n_ctx = ctx.shape[1]
    for i in range(DEPTH):
        last = i == DEPTH - 1
        j = i // N_MIXERS
        mod_x = (jax.nn.silu(c) @ w_ada[i] + b_ada[i])[:, None, :]
        sh1, sc1, g1, sh2, sc2, g2 = jnp.split(mod_x, 6, axis=-1)
        mod_c = jax.nn.silu(c_ctx) @ w_ada[i] + b_ada[i]
        csh1, csc1, cg1, csh2, csc2, cg2 = jnp.split(mod_c, 6, axis=-1)

        hx = x * (1.0 + sc1) + sh1
        hc = ctx * (1.0 + csc1) + csh1
        if i % N_MIXERS == 0:
            mx = _conv_mixer_latent(hx, conv_w_in[j], conv_w[j], conv_w_out[j])
            mc = None if last else _conv_mixer_seq(hc, conv_w_in[j], conv_w[j], conv_w_out[j])
        else:
            mx, mc = _mlstm_mixer(hx, hc, ml_w_in[j], ml_w_gate[j], ml_b_gate[j],
                                  ml_norm_g[j], ml_w_out[j], not last)
        x = _layer_norm(ALPHA * x + g1 * mx, ln_g[i, 0], ln_b[i, 0])

        hx2 = x * (1.0 + sc2) + sh2
        if last:
            ex = _moe(hx2, router_w, router_b, exp_w_gate[i], exp_w_up[i], exp_w_down[i])
            x = _layer_norm(ALPHA * x + g2 * ex, ln_g[i, 1], ln_b[i, 1])
        else:
            ctx = _layer_norm(ALPHA * ctx + cg1 * mc, ln_g[i, 0], ln_b[i, 0])
            hc2 = ctx * (1.0 + csc2) + csh2
            e_all = _moe(jnp.concatenate([hc2, hx2], axis=1), router_w, router_b,
                         exp_w_gate[i], exp_w_up[i], exp_w_down[i])
            ctx = _layer_norm(ALPHA * ctx + cg2 * e_all[:, :n_ctx], ln_g[i, 1], ln_b[i, 1])
            x = _layer_norm(ALPHA * x + g2 * e_all[:, n_ctx:], ln_g[i, 1], ln_b[i, 1])
    return x
```

```cpp
#include <hip/hip_runtime.h>
#include <cstdio>
#include <cstdint>

#ifndef MK_N_LAUNCHES
#define MK_N_LAUNCHES 1
#endif

#define LAS __attribute__((address_space(3)))
typedef unsigned short bf16;
typedef short bf16x8 __attribute__((ext_vector_type(8)));
typedef short s16x4 __attribute__((ext_vector_type(4)));
typedef float f32x4 __attribute__((ext_vector_type(4)));
typedef unsigned u32x4 __attribute__((ext_vector_type(4)));
typedef unsigned u32x2 __attribute__((ext_vector_type(2)));

constexpr int D = 2048, NB = 4, SEQ = 4096, NLAT = NB * SEQ, CTXL = 256, NCTX = NB * CTXL, NTOK = NLAT + NCTX;
constexpr int NE = 16, DE = 1024, NH = 8, DQK = 128, DV = 256;
constexpr int MLW = 6144, MLN = 6400;
constexpr int NWAVES = 8, NTHR = 512, GRID = 256;
constexpr float ALPHA = 1.41421356237f, LN_EPS = 1e-5f, HN_EPS = 1e-6f;
constexpr int MAXTILES = 153;

constexpr size_t MiB = 1u << 20;
constexpr size_t WS_CTL = 0, CTL_ZERO_BYTES = 1 * MiB;
constexpr size_t WS_MOD = 1 * MiB;
constexpr size_t WS_MISC = 2 * MiB;
constexpr size_t WS_ROUTE = WS_MISC + 0, WS_BLKCNT = WS_MISC + 0x48000, WS_SROW = WS_MISC + 0x50000, WS_SWT = WS_MISC + 0x80000, WS_TILEE = WS_MISC + 0xB0000, WS_TTOT = WS_MISC + 0xB0400;
constexpr size_t WS_CTXRES = 6 * MiB;
constexpr size_t WS_GATES = 14 * MiB;
constexpr size_t WS_WT_CIN = 17 * MiB, WS_WT_COUT = 41 * MiB, WS_WT_MIN = 49 * MiB, WS_WT_MOUT = 74 * MiB, WS_WT_E1 = 82 * MiB, WS_WT_E2 = 338 * MiB;
constexpr size_t WS_HA = 466 * MiB, WS_RB = 534 * MiB, WS_RC = 602 * MiB, WS_RH = 670 * MiB, WS_REX = 747 * MiB, WS_HB2 = 883 * MiB, WS_END = 947 * MiB;
constexpr int CW_BAR = 4096;

constexpr int RING_BYTES = 131072, LDSCTL_OFF = 139264, LDS_TILEE = LDSCTL_OFF, LDS_MISC = LDSCTL_OFF + 1024, LDS_BYTES = 147456;

__device__ __forceinline__ unsigned cvt_pk_bf16(float lo, float hi) { unsigned r; asm volatile("v_cvt_pk_bf16_f32 %0, %1, %2" : "=v"(r) : "v"(lo), "v"(hi)); return r; }
__device__ __forceinline__ float bf_lo(unsigned u) { return __uint_as_float(u << 16); }
__device__ __forceinline__ float bf_hi(unsigned u) { return __uint_as_float(u & 0xffff0000u); }
__device__ __forceinline__ float wave_sum(float v) {
#pragma unroll
    for (int o = 1; o < 64; o <<= 1) v += __shfl_xor(v, o);
    return v;
}
#define LDS_WAIT() asm volatile("s_waitcnt lgkmcnt(0)" ::: "memory")
#define VM_WAIT() asm volatile("s_waitcnt vmcnt(0)" ::: "memory")

#define XB_TMO      128
#define XB_XCNT(j)  (256  + 64 * (j))
#define XB_XSUB(j)  (1280 + 64 * (j))
#define XB_XGEN(j)  (2304 + 64 * (j))
#define XB_TOP      3328
#define XB_TOPGEN   3392
#define XCD_BAR_WORDS 3456
#define XB_SPIN_CAP (1u << 18)
__device__ __forceinline__ unsigned xb_ld(unsigned* p)              { return __hip_atomic_load(p, __ATOMIC_RELAXED, __HIP_MEMORY_SCOPE_AGENT); }
__device__ __forceinline__ unsigned xb_add(unsigned* p, unsigned v) { return __hip_atomic_fetch_add(p, v, __ATOMIC_RELAXED, __HIP_MEMORY_SCOPE_AGENT); }
__device__ __forceinline__ unsigned xb_xcc_id() { return (unsigned)__builtin_amdgcn_s_getreg((3 << 11) | 20) & 0xFu; }
#define XB_SPIN(cond, bar) do { unsigned _sp = 0; while (cond) { __builtin_amdgcn_s_sleep(1); \
    if ((++_sp & 255u) == 0u) { if (xb_ld(&(bar)[XB_TMO])) break; if (_sp > XB_SPIN_CAP) { atomicAdd(&(bar)[XB_TMO], 1u); break; } } } } while (0)
struct XcdBarrier { unsigned* bar; unsigned x; volatile LAS unsigned* st; };
__device__ __forceinline__ XcdBarrier xcd_barrier_post(unsigned* bar, volatile LAS unsigned* st) {
    XcdBarrier b; b.bar = bar; b.x = xb_xcc_id(); b.st = st;
    if (threadIdx.x == 0) (void)xb_add(&bar[XB_XCNT(b.x)], 1u);
    return b;
}
__device__ __forceinline__ void xcd_barrier_complete(unsigned* bar, unsigned x, unsigned& nloc, unsigned& nx) {
    const unsigned G = gridDim.x * gridDim.y * gridDim.z;
    unsigned sum, cnt, mine, sp = 0u;
    for (;;) {
        sum = 0u; cnt = 0u; mine = 0u;
#pragma unroll
        for (unsigned j = 0; j < 16; ++j) { const unsigned c = xb_ld(&bar[XB_XCNT(j)]); sum += c; cnt += (c > 0u) ? 1u : 0u; mine = (j == x) ? c : mine; }
        if (sum == G) break;
        __builtin_amdgcn_s_sleep(1);
        if ((++sp & 255u) == 0u) { if (xb_ld(&bar[XB_TMO])) break; if (sp > XB_SPIN_CAP) { atomicAdd(&bar[XB_TMO], 1u); break; } }
    }
    nloc = mine > 0u ? mine : 1u; nx = cnt > 0u ? cnt : 1u;
}
__device__ __forceinline__ void xcd_barrier(const XcdBarrier& b) {
    asm volatile("s_waitcnt vmcnt(0)" ::: "memory");
    __syncthreads();
    if (threadIdx.x == 0) {
        unsigned* bar = b.bar;
        __builtin_amdgcn_s_waitcnt(0);
        unsigned nloc = b.st[0], nx = b.st[1];
        if (nloc == 0u) { xcd_barrier_complete(bar, b.x, nloc, nx); b.st[0] = nloc; b.st[1] = nx; }
        const unsigned old = xb_add(&bar[XB_XSUB(b.x)], 1u);
        const unsigned gen = old / nloc;
        if (old + 1u == (gen + 1u) * nloc) {
            __builtin_amdgcn_fence(__ATOMIC_RELEASE, "agent");
            asm volatile("s_waitcnt vmcnt(0)" ::: "memory");
            const unsigned og = xb_add(&bar[XB_TOP], 1u);
            const unsigned tg = og / nx;
            if (og + 1u == (tg + 1u) * nx) xb_add(&bar[XB_TOPGEN], 1u);
            else XB_SPIN(xb_ld(&bar[XB_TOPGEN]) == tg, bar);
            __builtin_amdgcn_fence(__ATOMIC_ACQUIRE, "agent");
            xb_add(&bar[XB_XGEN(b.x)], 1u);
            asm volatile("s_waitcnt vmcnt(0)" ::: "memory");
        } else {
            XB_SPIN(xb_ld(&bar[XB_XGEN(b.x)]) == gen, bar);
            __builtin_amdgcn_fence(__ATOMIC_ACQUIRE, "agent");
            asm volatile("s_waitcnt vmcnt(0)" ::: "memory");
        }
    }
    __syncthreads();
}

namespace pg8 {
constexpr int BM = 256, BK = 64, HALF = 128, HTB = HALF * BK * 2, NXCD = 8, WGM = 8;
__device__ __forceinline__ int lds_byte(int r, int c) { const int st = (r >> 4) * 2 + (c >> 5), rr = r & 15, cc = c & 31, ob = rr * 64 + cc * 2; return st * 1024 + (ob ^ (((ob >> 9) & 1) << 5)); }
__device__ __forceinline__ void stage_rc(int b, int& R, int& C) { const int st = b / 1024, sb = b % 1024, swz = sb ^ (((sb >> 9) & 1) << 5); R = (st >> 1) * 16 + swz / 64; C = (st & 1) * 32 + (swz % 64) / 2; }
__device__ __forceinline__ int perm32(int rho) { const int n = rho >> 4, i = rho & 15; return 8 * (i >> 2) + 4 * n + (i & 3); }

struct Unit { int pm, pn; const char* a; const char* b; };

__device__ __forceinline__ bool order_next(int i, int G, int c, int nM, int nN, int& pm, int& pn) {
    const int nwg = nM * nN; const long L = (long)i * G + c; if (L >= nwg) return false;
    int wgid = (int)L; { const int q = nwg / NXCD, r = nwg % NXCD, xcd = wgid % NXCD, off = wgid / NXCD; wgid = (xcd < r ? xcd * (q + 1) : r * (q + 1) + (xcd - r) * q) + off; }
    const int nig = WGM * nN, gid = wgid / nig, fm = gid * WGM, gsz = (nM - fm) < WGM ? (nM - fm) : WGM;
    pm = fm + ((wgid % nig) % gsz); pn = (wgid % nig) / gsz; return true;
}
struct SchedPlain {
    const char* A; const char* Bt; int nM, nN, G, c; size_t tstep;
    __device__ __forceinline__ void init(const bf16* A_, const bf16* Bt_, int M, int N, int K, int G_, int c_) { A = (const char*)A_; Bt = (const char*)Bt_; nM = M / BM; nN = N / BM; G = G_; c = c_; tstep = (size_t)BM * K * 2; }
    __device__ __forceinline__ bool next(int i, Unit& u) const { if (!order_next(i, G, c, nM, nN, u.pm, u.pn)) return false; u.a = A + (size_t)u.pm * tstep; u.b = Bt + (size_t)u.pn * tstep; return true; }
};
struct SchedMoe {
    const char* A; const char* Bt; const int* srow; const LAS int* tile_e; int nM, nN, G, c; size_t tstepA, tstepB, estepB;
    __device__ __forceinline__ bool next(int i, Unit& u) const { if (!order_next(i, G, c, nM, nN, u.pm, u.pn)) return false;
        const int e = tile_e[u.pm]; u.a = A + (size_t)u.pm * tstepA; u.b = Bt + (size_t)e * estepB + (size_t)u.pn * tstepB; return true; }
};

template <class Epi, class Sched, bool GATHER>
__device__ __forceinline__ void gemm_phase(LAS unsigned char* lds, const int wid, const int K, const Sched& S, const Epi& E) {
    int lane_ = (int)__builtin_amdgcn_mbcnt_hi(~0u, __builtin_amdgcn_mbcnt_lo(~0u, 0u)); asm volatile("" : "+v"(lane_));
    const int lane = lane_, tid = wid * 64 + lane, wr = wid >> 2, wc = wid & 3, fr = lane & 15, fq = lane >> 4;
    const int nt = K / BK;
    int R0, C0, R1, C1; stage_rc(tid * 16, R0, C0); stage_rc(tid * 16 + 8192, R1, C1);
    unsigned voffB[2]; voffB[0] = (unsigned)(((R0 & ~31) + perm32(R0 & 31)) * K + C0) * 2u; voffB[1] = (unsigned)(((R1 & ~31) + perm32(R1 & 31)) * K + C1) * 2u;
    unsigned cv[4], nv[4];
    const size_t kstep = (size_t)(BK * 2);
    const size_t hstep = (size_t)HALF * K * 2;
    const unsigned ldsw = (unsigned)wid * 1024u;
    const int aoff = lds_byte(wr * 64 + fr, fq * 8), boff = lds_byte(wc * 32 + fr, fq * 8);
#define PG8_SA(b, h) (((b) * 2 + (h)) * HTB)
#define PG8_SB(b, h) ((4 + (b) * 2 + (h)) * HTB)
#define PG8_STG(bufoff, ptr, o0, o1) do { const char* p_ = (const char*)(ptr); asm volatile("" : "+s"(p_));     \
        __builtin_amdgcn_global_load_lds((const unsigned*)(p_ + (o0)), (LAS unsigned*)(lds + (bufoff) + ldsw), 16, 0, 0); \
        __builtin_amdgcn_global_load_lds((const unsigned*)(p_ + (o1)), (LAS unsigned*)(lds + (bufoff) + ldsw + 8192), 16, 0, 0); } while (0)
#define PG8_STGB(bufoff, ptr) PG8_STG(bufoff, ptr, voffB[0], voffB[1])
#define PG8_STGA(bufoff, ptr, h, V) do { if constexpr (GATHER) { PG8_STG(bufoff, ptr, (V)[2 * (h)], (V)[2 * (h) + 1]); } else { PG8_STG(bufoff, (ptr) + (h) * hstep, (V)[0], (V)[1]); } } while (0)
#define PG8_LDA(dst, b, h) do { _Pragma("unroll") for (int m = 0; m < 4; ++m) _Pragma("unroll") for (int k = 0; k < 2; ++k) dst[m][k] = *(const LAS bf16x8*)(lds + PG8_SA(b, h) + aoff + m * 2048 + k * 1024); } while (0)
#define PG8_LDB(dst, b, h) do { _Pragma("unroll") for (int n = 0; n < 2; ++n) _Pragma("unroll") for (int k = 0; k < 2; ++k) dst[n][k] = *(const LAS bf16x8*)(lds + PG8_SB(b, h) + boff + n * 2048 + k * 1024); } while (0)
#define PG8_MMA(ai, bj, At, Bt) do { __builtin_amdgcn_s_setprio(1); _Pragma("unroll") for (int m = 0; m < 4; ++m) _Pragma("unroll") for (int n = 0; n < 2; ++n) _Pragma("unroll") for (int k = 0; k < 2; ++k) \
        acc[ai][bj][m][n] = __builtin_amdgcn_mfma_f32_16x16x32_bf16(Bt[n][k], At[m][k], acc[ai][bj][m][n], 0, 0, 0); __builtin_amdgcn_s_setprio(0); } while (0)
#define PG8_WAIT_V(n) asm volatile("s_waitcnt vmcnt(" #n ")" ::: "memory")
#define PG8_WAIT_L(n) asm volatile("s_waitcnt lgkmcnt(" #n ")" ::: "memory")
#define PG8_BAR __builtin_amdgcn_s_barrier()
#define PG8_SCHED __builtin_amdgcn_sched_barrier(0)
#define PG8_TRIP(A1, A2, B2, V2) do { const char* a3_ = (A2) + kstep; const char* b3_ = (B2) + kstep; \
        PG8_LDB(B0, 0, 0); PG8_LDB(B1, 0, 1); PG8_SCHED; PG8_LDA(At, 0, 0); PG8_STGA(PG8_SA(1, 1), A1, 1, cv); \
        PG8_WAIT_V(8); PG8_WAIT_L(0); PG8_BAR; PG8_MMA(0, 0, At, B0); PG8_MMA(0, 1, At, B1); PG8_BAR; PG8_SCHED; \
        PG8_LDA(At, 0, 1); PG8_STGB(PG8_SB(0, 0), B2); PG8_STGB(PG8_SB(0, 1), (B2) + hstep); PG8_STGA(PG8_SA(0, 0), A2, 0, V2); \
        PG8_WAIT_V(8); PG8_WAIT_L(0); PG8_BAR; PG8_MMA(1, 0, At, B0); PG8_MMA(1, 1, At, B1); PG8_BAR; PG8_SCHED; \
        PG8_LDB(B0, 1, 0); PG8_LDB(B1, 1, 1); PG8_SCHED; PG8_LDA(At, 1, 0); PG8_STGA(PG8_SA(0, 1), A2, 1, V2); \
        PG8_WAIT_V(8); PG8_WAIT_L(0); PG8_BAR; PG8_MMA(0, 0, At, B0); PG8_MMA(0, 1, At, B1); PG8_BAR; PG8_SCHED; \
        PG8_LDA(At, 1, 1); PG8_STGB(PG8_SB(1, 0), b3_); PG8_STGB(PG8_SB(1, 1), b3_ + hstep); PG8_STGA(PG8_SA(1, 0), a3_, 0, V2); \
        PG8_WAIT_V(8); PG8_WAIT_L(0); PG8_BAR; PG8_MMA(1, 0, At, B0); PG8_MMA(1, 1, At, B1); PG8_BAR; PG8_SCHED; } while (0)
#define PG8_OFFS(u, v) do { if constexpr (GATHER) { const int* sr_ = S.srow + (u).pm * 256; int t0_ = sr_[R0], t1_ = sr_[R1], t2_ = sr_[128 + R0], t3_ = sr_[128 + R1]; \
        t0_ = t0_ < 0 ? 0 : (t0_ >> 1); t1_ = t1_ < 0 ? 0 : (t1_ >> 1); t2_ = t2_ < 0 ? 0 : (t2_ >> 1); t3_ = t3_ < 0 ? 0 : (t3_ >> 1); \
        (v)[0] = (unsigned)(t0_ * K + C0) * 2u; (v)[1] = (unsigned)(t1_ * K + C1) * 2u; (v)[2] = (unsigned)(t2_ * K + C0) * 2u; (v)[3] = (unsigned)(t3_ * K + C1) * 2u; } } while (0)
    Unit cur, nxt; int ui = 0;
    if (!S.next(0, cur)) return;
    f32x4 acc[2][2][4][2];
#pragma unroll
    for (int a = 0; a < 2; ++a)
#pragma unroll
        for (int b = 0; b < 2; ++b)
#pragma unroll
            for (int m = 0; m < 4; ++m)
#pragma unroll
                for (int n = 0; n < 2; ++n) acc[a][b][m][n] = (f32x4){0.f, 0.f, 0.f, 0.f};
    bf16x8 At[4][2], B0[2][2], B1[2][2];
    if constexpr (GATHER) { PG8_OFFS(cur, cv); }
    else { cv[0] = (unsigned)(R0 * K + C0) * 2u; cv[1] = (unsigned)(R1 * K + C1) * 2u; cv[2] = 0u; cv[3] = 0u; }
    const char* cA = cur.a; const char* cB = cur.b;
    PG8_STGB(PG8_SB(0, 0), cB); PG8_STGB(PG8_SB(0, 1), cB + hstep); PG8_STGA(PG8_SA(0, 0), cA, 0, cv); PG8_STGA(PG8_SA(0, 1), cA, 1, cv);
    if (wr == 1) PG8_BAR;
    PG8_WAIT_V(2); PG8_BAR;
    PG8_STGB(PG8_SB(1, 0), cB + kstep); PG8_STGA(PG8_SA(1, 0), cA + kstep, 0, cv); PG8_STGB(PG8_SB(1, 1), cB + hstep + kstep);
    PG8_WAIT_V(6); PG8_BAR;
    for (;;) {
        const bool has_next = S.next(ui + 1, nxt);
        const char* nA = has_next ? nxt.a : cA; const char* nB = has_next ? nxt.b : cB;
        if constexpr (GATHER) { if (has_next) { PG8_OFFS(nxt, nv); } else { nv[0] = cv[0]; nv[1] = cv[1]; nv[2] = cv[2]; nv[3] = cv[3]; } }
        for (int t = 0; t < nt - 2; t += 2) { const char* a1 = cA + (size_t)(t + 1) * kstep; const char* a2 = cA + (size_t)(t + 2) * kstep; const char* b2 = cB + (size_t)(t + 2) * kstep; PG8_TRIP(a1, a2, b2, cv); }
        { const char* a1 = cA + (size_t)(nt - 1) * kstep; if constexpr (GATHER) { PG8_TRIP(a1, nA, nB, nv); } else { PG8_TRIP(a1, nA, nB, cv); } }
        if (wr == 0) PG8_BAR;
        E(acc, cur, wr, wc, fr, fq);
        if (!has_next) break;
#pragma unroll
        for (int a = 0; a < 2; ++a)
#pragma unroll
            for (int b = 0; b < 2; ++b)
#pragma unroll
                for (int m = 0; m < 4; ++m)
#pragma unroll
                    for (int n = 0; n < 2; ++n) acc[a][b][m][n] = (f32x4){0.f, 0.f, 0.f, 0.f};
        cur = nxt; cA = nA; cB = nB; ++ui;
        if constexpr (GATHER) { cv[0] = nv[0]; cv[1] = nv[1]; cv[2] = nv[2]; cv[3] = nv[3]; }
        if (wr == 1) PG8_BAR;
    }
    PG8_WAIT_V(0);
    PG8_BAR;
#undef PG8_SA
#undef PG8_SB
#undef PG8_STG
#undef PG8_STGB
#undef PG8_STGA
#undef PG8_LDA
#undef PG8_LDB
#undef PG8_MMA
#undef PG8_WAIT_V
#undef PG8_WAIT_L
#undef PG8_BAR
#undef PG8_SCHED
#undef PG8_TRIP
#undef PG8_OFFS
}

__device__ __forceinline__ u32x4 pack8(const f32x4 v0, const f32x4 v1) { u32x4 w; w.x = cvt_pk_bf16(v0[0], v0[1]); w.y = cvt_pk_bf16(v0[2], v0[3]); w.z = cvt_pk_bf16(v1[0], v1[1]); w.w = cvt_pk_bf16(v1[2], v1[3]); return w; }
struct EpiBf16 {
    bf16* O; int ldc;
    __device__ __forceinline__ void operator()(const f32x4 (&acc)[2][2][4][2], const Unit& u, int wr, int wc, int fr, int fq) const {
        const int row0 = u.pm * BM + wr * 64 + fr, col0 = u.pn * BM + wc * 32 + 8 * fq;
#pragma unroll
        for (int ai = 0; ai < 2; ++ai)
#pragma unroll
            for (int m = 0; m < 4; ++m) { bf16* rowp = O + (size_t)(row0 + ai * HALF + m * 16) * ldc + col0;
#pragma unroll
                for (int bj = 0; bj < 2; ++bj) *(u32x4*)(rowp + bj * HALF) = pack8(acc[ai][bj][m][0], acc[ai][bj][m][1]); }
    }
};
struct EpiConv1 {
    bf16* BG; bf16* Z;
    __device__ __forceinline__ void operator()(const f32x4 (&acc)[2][2][4][2], const Unit& u, int wr, int wc, int fr, int fq) const {
        const int row0 = u.pm * BM + wr * 64 + fr;
        if (u.pn < 8) {
            const int col0 = u.pn * BM + wc * 32 + 8 * fq;
#pragma unroll
            for (int ai = 0; ai < 2; ++ai)
#pragma unroll
                for (int m = 0; m < 4; ++m) { bf16* rowp = BG + (size_t)(row0 + ai * HALF + m * 16) * D + col0;
#pragma unroll
                    for (int bj = 0; bj < 2; ++bj) *(u32x4*)(rowp + bj * HALF) = pack8(acc[ai][bj][m][0], acc[ai][bj][m][1]); }
        } else {
            const int col0 = (u.pn - 8) * HALF + wc * 32 + 8 * fq;
#pragma unroll
            for (int ai = 0; ai < 2; ++ai)
#pragma unroll
                for (int m = 0; m < 4; ++m) { bf16* rowp = Z + (size_t)(row0 + ai * HALF + m * 16) * D + col0;
                    *(u32x4*)rowp = pack8(acc[ai][0][m][0] * acc[ai][1][m][0], acc[ai][0][m][1] * acc[ai][1][m][1]); }
        }
    }
};
struct EpiMlIn {
    bf16* O; float* gates;
    __device__ __forceinline__ void operator()(const f32x4 (&acc)[2][2][4][2], const Unit& u, int wr, int wc, int fr, int fq) const {
        const int row0 = u.pm * BM + wr * 64 + fr;
        if (u.pn < 24) {
            const int col0 = u.pn * BM + wc * 32 + 8 * fq;
#pragma unroll
            for (int ai = 0; ai < 2; ++ai)
#pragma unroll
                for (int m = 0; m < 4; ++m) { bf16* rowp = O + (size_t)(row0 + ai * HALF + m * 16) * MLW + col0;
#pragma unroll
                    for (int bj = 0; bj < 2; ++bj) *(u32x4*)(rowp + bj * HALF) = pack8(acc[ai][bj][m][0], acc[ai][bj][m][1]); }
        } else if (wc == 0) {
#pragma unroll
            for (int ai = 0; ai < 2; ++ai)
#pragma unroll
                for (int m = 0; m < 4; ++m) { float* rowp = gates + (size_t)(row0 + ai * HALF + m * 16) * 32 + 8 * fq;
                    *(f32x4*)rowp = acc[ai][0][m][0]; *(f32x4*)(rowp + 4) = acc[ai][0][m][1]; }
        }
    }
};
__device__ __forceinline__ float silu_f(float g) { return g * __builtin_amdgcn_rcpf(1.0f + __expf(-g)); }
struct EpiMoe1 {
    bf16* H;
    __device__ __forceinline__ void operator()(const f32x4 (&acc)[2][2][4][2], const Unit& u, int wr, int wc, int fr, int fq) const {
        const int row0 = u.pm * BM + wr * 64 + fr, col0 = u.pn * HALF + wc * 32 + 8 * fq;
#pragma unroll
        for (int ai = 0; ai < 2; ++ai)
#pragma unroll
            for (int m = 0; m < 4; ++m) { bf16* rowp = H + (size_t)(row0 + ai * HALF + m * 16) * DE + col0; f32x4 h0, h1;
#pragma unroll
                for (int j = 0; j < 4; ++j) { h0[j] = silu_f(acc[ai][0][m][0][j]) * acc[ai][1][m][0][j]; h1[j] = silu_f(acc[ai][0][m][1][j]) * acc[ai][1][m][1][j]; }
                *(u32x4*)rowp = pack8(h0, h1); }
    }
};
struct EpiMoe2 {
    bf16* EX; const int* srow; const float* swt;
    __device__ __forceinline__ void operator()(const f32x4 (&acc)[2][2][4][2], const Unit& u, int wr, int wc, int fr, int fq) const {
        const int row0 = u.pm * BM + wr * 64 + fr, col0 = u.pn * BM + wc * 32 + 8 * fq;
#pragma unroll
        for (int ai = 0; ai < 2; ++ai)
#pragma unroll
            for (int m = 0; m < 4; ++m) { const int r = row0 + ai * HALF + m * 16; const int ent = srow[r]; const float w = swt[r];
                if (ent >= 0) { bf16* rowp = EX + ((size_t)(ent & 1) * NTOK + (size_t)(ent >> 1)) * D + col0;
#pragma unroll
                    for (int bj = 0; bj < 2; ++bj) *(u32x4*)(rowp + bj * HALF) = pack8(acc[ai][bj][m][0] * w, acc[ai][bj][m][1] * w); } }
    }
};
}

struct Args { const float* in[21]; float* out; unsigned char* ws; int ph_lo, ph_hi; };
struct Frame {
    LAS unsigned char* lds;
    int G, bid, wave0;
    const float* in[21]; float* out; unsigned char* ws;
};
enum { I_X = 0, I_C, I_CTX, I_CCTX, I_WADA, I_BADA, I_LNG, I_LNB, I_CWIN, I_CW, I_CWOUT, I_MWIN, I_MWG, I_MBG, I_MNG, I_MWOUT, I_RW, I_RB, I_EWG, I_EWU, I_EWD };

#define PHASE_IDS() int lane_ = (int)__builtin_amdgcn_mbcnt_hi(~0u, __builtin_amdgcn_mbcnt_lo(~0u, 0u)); asm volatile("" : "+v"(lane_)); const int lane = lane_; const int wave = F.wave0; const int tid = wave * 64 + lane; (void)tid
__device__ __forceinline__ int mod_row(int trow) { return trow < NLAT ? (trow >> 12) : 4; }
__device__ __forceinline__ const float* mod_vec(const Frame& F, int layer, int r, int j) { return (const float*)(F.ws + WS_MOD) + ((size_t)(layer * 5 + r) * 6 + j) * D; }

__device__ __forceinline__ void cvt_tile(const float* src, size_t src_pitch, bf16* dst, size_t dst_pitch, float scale, LAS float* scr, int lane) {
#pragma unroll 8
    for (int i = 0; i < 64; ++i) scr[i * 65 + lane] = src[(size_t)i * src_pitch + lane];
    LDS_WAIT(); asm volatile("" ::: "memory");
    const int c = lane & 7;
#pragma unroll
    for (int j = 0; j < 8; ++j) { const int n = (lane >> 3) + 8 * j; const LAS float* s = scr + (8 * c) * 65 + n;
        u32x4 o; o.x = cvt_pk_bf16(s[0] * scale, s[65] * scale); o.y = cvt_pk_bf16(s[2 * 65] * scale, s[3 * 65] * scale); o.z = cvt_pk_bf16(s[4 * 65] * scale, s[5 * 65] * scale); o.w = cvt_pk_bf16(s[6 * 65] * scale, s[7 * 65] * scale);
        *(u32x4*)(dst + (size_t)n * dst_pitch + 8 * c) = o; }
    LDS_WAIT(); asm volatile("" ::: "memory");
}
__device__ __forceinline__ void gemv_item(Frame& F, int l, int chunk, int tid, int lane, int wave) {
    LAS float* sc = (LAS float*)F.lds;
    LAS float* red = (LAS float*)(F.lds + 40960);
    for (int idx = tid; idx < 5 * D; idx += NTHR) { const int r = idx / D, k = idx % D; const float cv = r < 4 ? F.in[I_C][r * D + k] : F.in[I_CCTX][k]; sc[idx] = cv / (1.0f + expf(-cv)); }
    __syncthreads();
    float* mod = (float*)(F.ws + WS_MOD);
    const int n0 = chunk * 32, col = lane & 31, kp = lane >> 5, kbase = wave * 256;
    const float* W = F.in[I_WADA] + (size_t)l * D * 12288 + n0 + col;
    float acc[5] = {0.f, 0.f, 0.f, 0.f, 0.f};
    for (int kk = 0; kk < 128; kk += 8) {
        float wv[8];
#pragma unroll
        for (int u = 0; u < 8; ++u) wv[u] = W[(size_t)(kbase + 2 * (kk + u) + kp) * 12288];
#pragma unroll
        for (int u = 0; u < 8; ++u) { const int k = kbase + 2 * (kk + u) + kp;
#pragma unroll
            for (int r = 0; r < 5; ++r) acc[r] += sc[r * D + k] * wv[u]; }
    }
#pragma unroll
    for (int r = 0; r < 5; ++r) { acc[r] += __shfl_xor(acc[r], 32); if (lane < 32) red[(wave * 5 + r) * 32 + lane] = acc[r]; }
    __syncthreads();
    if (tid < 160) { const int r = tid >> 5, cc = tid & 31; float s = 0.f;
#pragma unroll
        for (int w = 0; w < 8; ++w) s += red[(w * 5 + r) * 32 + cc];
        mod[(size_t)(l * 5 + r) * 12288 + n0 + cc] = s + F.in[I_BADA][l * 12288 + n0 + cc]; }
    __syncthreads();
}
__device__ __forceinline__ void conv_tile(Frame& F, int t, LAS float* scr, int lane) {
    if (t < 3072) { const int kb = t / 96, n0 = (t % 96) * 64; int dr; if (n0 < 2048) dr = n0; else if (n0 < 4096) { const int q = n0 - 2048; dr = 2048 + (q >> 7) * 256 + (q & 127); } else { const int q = n0 - 4096; dr = 2048 + (q >> 7) * 256 + 128 + (q & 127); }
        cvt_tile(F.in[I_CWIN] + (size_t)kb * 64 * 6144 + n0, 6144, (bf16*)(F.ws + WS_WT_CIN) + (size_t)dr * D + kb * 64, D, 1.f, scr, lane); }
    else { t -= 3072; const int kb = t / 32, n0 = (t % 32) * 64;
        cvt_tile(F.in[I_CWOUT] + (size_t)kb * 64 * D + n0, D, (bf16*)(F.ws + WS_WT_COUT) + (size_t)n0 * D + kb * 64, D, 1.f, scr, lane); }
}
__device__ __forceinline__ void ml_tile(Frame& F, int t, LAS float* scr, int lane) {
    const float QS = 0.08838834764831845f;
    if (t < 3072) { const int kb = t / 96, n0 = (t % 96) * 64;
        cvt_tile(F.in[I_MWIN] + (size_t)kb * 64 * MLW + n0, MLW, (bf16*)(F.ws + WS_WT_MIN) + (size_t)n0 * D + kb * 64, D, n0 < 1024 ? QS : 1.f, scr, lane); }
    else { t -= 3072; const int kb = t / 32, n0 = (t % 32) * 64;
        cvt_tile(F.in[I_MWOUT] + (size_t)kb * 64 * D + n0, D, (bf16*)(F.ws + WS_WT_MOUT) + (size_t)n0 * D + kb * 64, D, 1.f, scr, lane); }
}
__device__ __forceinline__ void exp_tile(Frame& F, int l, int t, LAS float* scr, int lane) {
    if (t < 16384) { const int up = t >= 8192; if (up) t -= 8192; const int le = l * NE + t / 512, q = t % 512, kb = q / 16, n0 = (q % 16) * 64;
        const float* src = (up ? F.in[I_EWU] : F.in[I_EWG]) + (size_t)le * D * DE + (size_t)kb * 64 * DE + n0;
        const int dr = (n0 >> 7) * 256 + (up ? 128 : 0) + (n0 & 127);
        cvt_tile(src, DE, (bf16*)(F.ws + WS_WT_E1) + (size_t)le * D * D + (size_t)dr * D + kb * 64, D, 1.f, scr, lane); }
    else { t -= 16384; const int le = l * NE + t / 512, q = t % 512, kb = q / 32, n0 = (q % 32) * 64;
        cvt_tile(F.in[I_EWD] + (size_t)le * DE * D + (size_t)kb * 64 * D + n0, D, (bf16*)(F.ws + WS_WT_E2) + (size_t)le * D * DE + (size_t)n0 * DE + kb * 64, DE, 1.f, scr, lane); }
}
constexpr int Q_E0 = 3072, Q_GV1 = Q_E0 + 384, Q_ML = Q_GV1 + 512, Q_END = Q_ML + 3072;
constexpr int CW_QHEAD = 8192;
__device__ __forceinline__ void bg_item(Frame& F, int it, int tid, int lane, int wave) {
    LAS float* scr = (LAS float*)(F.lds + wave * 16640);
    if (it < Q_E0) exp_tile(F, 0, it * 8 + wave, scr, lane);
    else if (it < Q_GV1) gemv_item(F, 1, it - Q_E0, tid, lane, wave);
    else if (it < Q_ML) ml_tile(F, (it - Q_GV1) * 8 + wave, scr, lane);
    else exp_tile(F, 1, (it - Q_ML) * 8 + wave, scr, lane);
}
__device__ __forceinline__ void bg_pull(Frame& F, int limit, int phase, unsigned target) {
    PHASE_IDS();
    unsigned* ctl = (unsigned*)(F.ws + WS_CTL);
    LAS unsigned* bc = (LAS unsigned*)(F.lds + LDS_MISC + 128);
    for (;;) {
        __syncthreads();
        if (tid == 0) { unsigned it = 0xffffffffu;
            const bool stop = (phase >= 0) && (__hip_atomic_load(ctl + CW_QHEAD + 64 * (1 + phase), __ATOMIC_RELAXED, __HIP_MEMORY_SCOPE_AGENT) >= target);
            if (!stop && __hip_atomic_load(ctl + CW_QHEAD, __ATOMIC_RELAXED, __HIP_MEMORY_SCOPE_AGENT) < (unsigned)limit) { it = __hip_atomic_fetch_add(ctl + CW_QHEAD, 1u, __ATOMIC_RELAXED, __HIP_MEMORY_SCOPE_AGENT); if (it >= (unsigned)Q_END) it = 0xffffffffu; }
            *bc = it; }
        __syncthreads();
        const unsigned it = *bc;
        if (it == 0xffffffffu) break;
        bg_item(F, (int)it, tid, lane, wave);
    }
}
__device__ __forceinline__ void bg_signal_done(Frame& F, int phase) {
    if (threadIdx.x == 0) __hip_atomic_fetch_add((unsigned*)(F.ws + WS_CTL) + CW_QHEAD + 64 * (1 + phase), 1u, __ATOMIC_RELAXED, __HIP_MEMORY_SCOPE_AGENT);
}
__device__ __forceinline__ void p0_prologue(Frame& F) {
    PHASE_IDS();
    for (int it = F.bid; it < 384; it += F.G) gemv_item(F, 0, it, tid, lane, wave);
    LAS float* scr = (LAS float*)(F.lds + wave * 16640);
    const int gw = F.bid * NWAVES + wave, NGW = F.G * NWAVES;
    for (int t = gw; t < 4096; t += NGW) conv_tile(F, t, scr, lane);
    { bf16* wt = (bf16*)(F.ws + WS_WT_MIN) + (size_t)MLW * D; const float* wg = F.in[I_MWG];
      for (int idx = F.bid * NTHR + tid; idx < 256 * D; idx += F.G * NTHR) { const int n = idx / D, k = idx % D; const float v = n < 32 ? wg[k * 32 + n] : 0.f; wt[idx] = (bf16)(cvt_pk_bf16(v, 0.f) & 0xffffu); } }
}

#define SCHED_FENCE() __builtin_amdgcn_sched_barrier(0)
__device__ __forceinline__ void p1_modulate(Frame& F) {
    PHASE_IDS();
    const int gw = F.bid * NWAVES + wave;
    bf16* HA = (bf16*)(F.ws + WS_HA);
    f32x4 a[8], b[8], x[8], xn[8];
    { const int r = (8 * gw) >> 12; const float* sh = mod_vec(F, 0, r, 0); const float* scv = mod_vec(F, 0, r, 1);
#pragma unroll
      for (int j = 0; j < 8; ++j) { const int c = 256 * j + 4 * lane; a[j] = *(const f32x4*)(scv + c) + 1.0f; b[j] = *(const f32x4*)(sh + c); xn[j] = *(const f32x4*)(F.in[I_X] + (size_t)(8 * gw) * D + c); } }
    for (int i = 0; i < 8; ++i) { const int row = 8 * gw + i;
#pragma unroll
        for (int j = 0; j < 8; ++j) x[j] = xn[j];
        if (i < 7) {
#pragma unroll
            for (int j = 0; j < 8; ++j) xn[j] = *(const f32x4*)(F.in[I_X] + (size_t)(row + 1) * D + 256 * j + 4 * lane); }
        SCHED_FENCE();
#pragma unroll
        for (int j = 0; j < 8; ++j) { const f32x4 h = x[j] * a[j] + b[j]; u32x2 o; o.x = cvt_pk_bf16(h[0], h[1]); o.y = cvt_pk_bf16(h[2], h[3]); *(u32x2*)(HA + (size_t)row * D + 256 * j + 4 * lane) = o; }
    }
    if (gw < NCTX) { const float* sh = mod_vec(F, 0, 4, 0); const float* scv = mod_vec(F, 0, 4, 1);
#pragma unroll
        for (int j = 0; j < 8; ++j) { const int c = 256 * j + 4 * lane; a[j] = *(const f32x4*)(scv + c) + 1.0f; b[j] = *(const f32x4*)(sh + c); x[j] = *(const f32x4*)(F.in[I_CTX] + (size_t)gw * D + c); }
        SCHED_FENCE();
#pragma unroll
        for (int j = 0; j < 8; ++j) { const f32x4 h = x[j] * a[j] + b[j]; u32x2 o; o.x = cvt_pk_bf16(h[0], h[1]); o.y = cvt_pk_bf16(h[2], h[3]); *(u32x2*)(HA + (size_t)(NLAT + gw) * D + 256 * j + 4 * lane) = o; } }
}

__device__ __forceinline__ void p3_conv(Frame& F) {
    PHASE_IDS();
    const int gw = F.bid * NWAVES + wave, NGW = F.G * NWAVES;
    const bf16* BG = (const bf16*)(F.ws + WS_RB); const bf16* Z = (const bf16*)(F.ws + WS_RC); bf16* U = (bf16*)(F.ws + WS_HA);
    const float* cw = F.in[I_CW];
    f32x4 wt[4][3][2];
#pragma unroll
    for (int j = 0; j < 4; ++j)
#pragma unroll
        for (int t = 0; t < 3; ++t) { wt[j][t][0] = *(const f32x4*)(cw + t * D + 512 * j + 8 * lane); wt[j][t][1] = *(const f32x4*)(cw + t * D + 512 * j + 8 * lane + 4); }
    for (int row = gw; row < NTOK; row += NGW) {
        u32x4 zc[4], bg[4], zp[4], zn[4];
        int dpa, dna, dpb, dnb; bool vpa, vna, vpb, vnb;
        if (row < NLAT) { const int s = row & (SEQ - 1), gc = s & 63, gr = s >> 6; vpa = gc > 0; vna = gc < 63; dpa = -1; dna = 1; vpb = gr > 0; vnb = gr < 63; dpb = -64; dnb = 64; }
        else { const int t = (row - NLAT) & (CTXL - 1); vpa = vpb = t > 0; vna = vnb = t < CTXL - 1; dpa = dpb = -1; dna = dnb = 1; }
#pragma unroll
        for (int j = 0; j < 4; ++j) { const int c = 512 * j + 8 * lane; const bool vp = j < 2 ? vpa : vpb, vn = j < 2 ? vna : vnb; const int dp = j < 2 ? dpa : dpb, dn = j < 2 ? dna : dnb;
            zc[j] = *(const u32x4*)(Z + (size_t)row * D + c); bg[j] = *(const u32x4*)(BG + (size_t)row * D + c);
            zp[j] = *(const u32x4*)(Z + (size_t)(vp ? row + dp : row) * D + c); zn[j] = *(const u32x4*)(Z + (size_t)(vn ? row + dn : row) * D + c);
            if (!vp) zp[j] = (u32x4){0u, 0u, 0u, 0u}; if (!vn) zn[j] = (u32x4){0u, 0u, 0u, 0u}; }
        SCHED_FENCE();
#pragma unroll
        for (int j = 0; j < 4; ++j) { float o[8];
#pragma unroll
            for (int q = 0; q < 4; ++q) {
                const float w0l = wt[j][0][q >> 1][2 * (q & 1)], w0h = wt[j][0][q >> 1][2 * (q & 1) + 1], w1l = wt[j][1][q >> 1][2 * (q & 1)], w1h = wt[j][1][q >> 1][2 * (q & 1) + 1], w2l = wt[j][2][q >> 1][2 * (q & 1)], w2h = wt[j][2][q >> 1][2 * (q & 1) + 1];
                o[2 * q] = bf_lo(bg[j][q]) * (w0l * bf_lo(zp[j][q]) + w1l * bf_lo(zc[j][q]) + w2l * bf_lo(zn[j][q]));
                o[2 * q + 1] = bf_hi(bg[j][q]) * (w0h * bf_hi(zp[j][q]) + w1h * bf_hi(zc[j][q]) + w2h * bf_hi(zn[j][q])); }
            u32x4 w; w.x = cvt_pk_bf16(o[0], o[1]); w.y = cvt_pk_bf16(o[2], o[3]); w.z = cvt_pk_bf16(o[4], o[5]); w.w = cvt_pk_bf16(o[6], o[7]);
            *(u32x4*)(U + (size_t)row * D + 512 * j + 8 * lane) = w; }
    }
}

__device__ __forceinline__ void lnB_phase(Frame& F, int layer) {
    PHASE_IDS();
    const int nrows = layer == 0 ? 68 : 64;
    const float* lg = F.in[I_LNG] + (layer * 2 + 1) * D; const float* lb = F.in[I_LNB] + (layer * 2 + 1) * D;
    const bf16* EX = (const bf16*)(F.ws + WS_REX);
#define LNB_ROW(li) ((li) < 64 ? F.bid * 64 + (li) : NLAT + F.bid * 4 + ((li) - 64))
#define LNB_XP(li) ((li) < 64 ? F.out + (size_t)(F.bid * 64 + (li)) * D : (float*)(F.ws + WS_CTXRES) + (size_t)(F.bid * 4 + ((li) - 64)) * D)
#define LNB_LOAD(li, X, E0, E1) do { const float* xp_ = LNB_XP(li); const bf16* ep_ = EX + (size_t)LNB_ROW(li) * D; \
        _Pragma("unroll") for (int j = 0; j < 8; ++j) { X[j] = *(const f32x4*)(xp_ + 256 * j + 4 * lane); E0[j] = *(const u32x2*)(ep_ + 256 * j + 4 * lane); E1[j] = *(const u32x2*)(ep_ + (size_t)NTOK * D + 256 * j + 4 * lane); } } while (0)
    f32x4 xn_[8]; u32x2 e0_[8], e1_[8];
    if (wave < nrows) LNB_LOAD(wave, xn_, e0_, e1_);
    for (int li = wave; li < nrows; li += NWAVES) {
        const int row = LNB_ROW(li); const int mr = mod_row(row);
        float* xout = LNB_XP(li);
        const float* gv = mod_vec(F, layer, mr, 5);
        f32x4 v[8]; float s = 0.f;
#pragma unroll
        for (int j = 0; j < 8; ++j) { const f32x4 g = *(const f32x4*)(gv + 256 * j + 4 * lane);
            const f32x4 m = (f32x4){bf_lo(e0_[j].x) + bf_lo(e1_[j].x), bf_hi(e0_[j].x) + bf_hi(e1_[j].x), bf_lo(e0_[j].y) + bf_lo(e1_[j].y), bf_hi(e0_[j].y) + bf_hi(e1_[j].y)};
            v[j] = xn_[j] * ALPHA + g * m; s += (v[j][0] + v[j][1]) + (v[j][2] + v[j][3]); }
        if (li + NWAVES < nrows) LNB_LOAD(li + NWAVES, xn_, e0_, e1_);
        f32x4 L[8], B[8];
#pragma unroll
        for (int j = 0; j < 8; ++j) { const int c = 256 * j + 4 * lane; L[j] = *(const f32x4*)(lg + c); B[j] = *(const f32x4*)(lb + c); }
        SCHED_FENCE();
        const float mean = wave_sum(s) * (1.f / D); float s2 = 0.f;
#pragma unroll
        for (int j = 0; j < 8; ++j) { v[j] = v[j] - mean; s2 += (v[j][0] * v[j][0] + v[j][1] * v[j][1]) + (v[j][2] * v[j][2] + v[j][3] * v[j][3]); }
        const float rstd = 1.0f / sqrtf(wave_sum(s2) * (1.f / D) + LN_EPS);
#pragma unroll
        for (int j = 0; j < 8; ++j) { const int c = 256 * j + 4 * lane; v[j] = v[j] * rstd * L[j] + B[j]; *(f32x4*)(xout + c) = v[j]; }
        if (layer == 0) {
            const float* sh = mod_vec(F, 1, mr, 0); const float* scv = mod_vec(F, 1, mr, 1);
#pragma unroll
            for (int j = 0; j < 8; ++j) { const int c = 256 * j + 4 * lane; L[j] = *(const f32x4*)(scv + c); B[j] = *(const f32x4*)(sh + c); }
            SCHED_FENCE();
            bf16* HA = (bf16*)(F.ws + WS_HA) + (size_t)row * D;
#pragma unroll
            for (int j = 0; j < 8; ++j) { const int c = 256 * j + 4 * lane; const f32x4 h = v[j] * (L[j] + 1.0f) + B[j]; u32x2 o; o.x = cvt_pk_bf16(h[0], h[1]); o.y = cvt_pk_bf16(h[2], h[3]); *(u32x2*)(HA + c) = o; }
        }
    }
#undef LNB_ROW
#undef LNB_XP
#undef LNB_LOAD
}

constexpr int LDS_LOGITS = RING_BYTES;
__device__ __forceinline__ void lnA_phase(Frame& F, int layer) {
    PHASE_IDS();
    LAS float* RwL = (LAS float*)F.lds;
    LAS float* LG = (LAS float*)(F.lds + LDS_LOGITS);
    LAS int* cnt = (LAS int*)(F.lds + LDS_MISC + 64);
    for (int idx = tid; idx < D * 4; idx += NTHR) { const int c = idx >> 2, e4 = (idx & 3) * 4; const f32x4 w = *(const f32x4*)(F.in[I_RW] + c * 16 + e4);
        RwL[(e4 + 0) * D + c] = w[0]; RwL[(e4 + 1) * D + c] = w[1]; RwL[(e4 + 2) * D + c] = w[2]; RwL[(e4 + 3) * D + c] = w[3]; }
    if (tid < 16) cnt[tid] = 0;
    __syncthreads();
    const int nrows = layer == 0 ? 68 : 64;
    const float* lg = F.in[I_LNG] + (layer * 2) * D; const float* lb = F.in[I_LNB] + (layer * 2) * D;
    const bf16* MX = (const bf16*)(F.ws + WS_RB);
#define LNA_ROW(li) ((li) < 64 ? F.bid * 64 + (li) : NLAT + F.bid * 4 + ((li) - 64))
#define LNA_XIN(li) ((li) < 64 ? (layer == 0 ? F.in[I_X] + (size_t)(F.bid * 64 + (li)) * D : F.out + (size_t)(F.bid * 64 + (li)) * D) : F.in[I_CTX] + (size_t)(F.bid * 4 + ((li) - 64)) * D)
#define LNA_LOAD(li, X, M) do { const float* xp_ = LNA_XIN(li); const bf16* mp_ = MX + (size_t)LNA_ROW(li) * D; \
        _Pragma("unroll") for (int j = 0; j < 8; ++j) { X[j] = *(const f32x4*)(xp_ + 256 * j + 4 * lane); M[j] = *(const u32x2*)(mp_ + 256 * j + 4 * lane); } } while (0)
    f32x4 xn_[8]; u32x2 mn_[8];
    if (wave < nrows) LNA_LOAD(wave, xn_, mn_);
    for (int li = wave; li < nrows; li += NWAVES) {
        const int row = LNA_ROW(li); const int mr = mod_row(row);
        float* xout = li < 64 ? F.out + (size_t)row * D : (float*)(F.ws + WS_CTXRES) + (size_t)(row - NLAT) * D;
        const float* gv = mod_vec(F, layer, mr, 2); const float* sh = mod_vec(F, layer, mr, 3); const float* scv = mod_vec(F, layer, mr, 4);
        f32x4 v[8]; float s = 0.f;
#pragma unroll
        for (int j = 0; j < 8; ++j) { const f32x4 g = *(const f32x4*)(gv + 256 * j + 4 * lane); const f32x4 m = (f32x4){bf_lo(mn_[j].x), bf_hi(mn_[j].x), bf_lo(mn_[j].y), bf_hi(mn_[j].y)};
            v[j] = xn_[j] * ALPHA + g * m; s += (v[j][0] + v[j][1]) + (v[j][2] + v[j][3]); }
        if (li + NWAVES < nrows) LNA_LOAD(li + NWAVES, xn_, mn_);
        f32x4 L[8], B[8], S[8], H[8];
#pragma unroll
        for (int j = 0; j < 8; ++j) { const int c = 256 * j + 4 * lane; L[j] = *(const f32x4*)(lg + c); B[j] = *(const f32x4*)(lb + c); S[j] = *(const f32x4*)(scv + c); H[j] = *(const f32x4*)(sh + c); }
        SCHED_FENCE();
        const float mean = wave_sum(s) * (1.f / D); float s2 = 0.f;
#pragma unroll
        for (int j = 0; j < 8; ++j) { v[j] = v[j] - mean; s2 += (v[j][0] * v[j][0] + v[j][1] * v[j][1]) + (v[j][2] * v[j][2] + v[j][3] * v[j][3]); }
        const float rstd = 1.0f / sqrtf(wave_sum(s2) * (1.f / D) + LN_EPS);
        bf16* HA = (bf16*)(F.ws + WS_HA) + (size_t)row * D;
#pragma unroll
        for (int j = 0; j < 8; ++j) { const int c = 256 * j + 4 * lane; v[j] = v[j] * rstd * L[j] + B[j]; *(f32x4*)(xout + c) = v[j];
            v[j] = v[j] * (S[j] + 1.0f) + H[j];
            u32x2 o; o.x = cvt_pk_bf16(v[j][0], v[j][1]); o.y = cvt_pk_bf16(v[j][2], v[j][3]); *(u32x2*)(HA + c) = o; }
        float p[16]; f32x4 wA[8], wB[8];
#pragma unroll
        for (int j = 0; j < 8; ++j) wA[j] = *(const LAS f32x4*)(RwL + 256 * j + 4 * lane);
#pragma unroll
        for (int e = 0; e < 16; ++e) {
            if (e + 1 < 16) {
#pragma unroll
                for (int j = 0; j < 8; ++j) { const f32x4 t = *(const LAS f32x4*)(RwL + (e + 1) * D + 256 * j + 4 * lane); if (e & 1) wA[j] = t; else wB[j] = t; } }
            SCHED_FENCE();
            f32x4 a4 = (f32x4){0.f, 0.f, 0.f, 0.f};
#pragma unroll
            for (int j = 0; j < 8; ++j) a4 += v[j] * ((e & 1) ? wB[j] : wA[j]);
            p[e] = (a4[0] + a4[1]) + (a4[2] + a4[3]);
            SCHED_FENCE();
        }
        float q8[8], q4[4], q2[2], q1;
        { const bool hi = (lane & 32) != 0;
#pragma unroll
          for (int i = 0; i < 8; ++i) { const float keep = hi ? p[8 + i] : p[i], give = hi ? p[i] : p[8 + i]; q8[i] = keep + __shfl_xor(give, 32); } }
        { const bool hi = (lane & 16) != 0;
#pragma unroll
          for (int i = 0; i < 4; ++i) { const float keep = hi ? q8[4 + i] : q8[i], give = hi ? q8[i] : q8[4 + i]; q4[i] = keep + __shfl_xor(give, 16); } }
        { const bool hi = (lane & 8) != 0;
#pragma unroll
          for (int i = 0; i < 2; ++i) { const float keep = hi ? q4[2 + i] : q4[i], give = hi ? q4[i] : q4[2 + i]; q2[i] = keep + __shfl_xor(give, 8); } }
        { const bool hi = (lane & 4) != 0; const float keep = hi ? q2[1] : q2[0], give = hi ? q2[0] : q2[1]; q1 = keep + __shfl_xor(give, 4); }
        q1 += __shfl_xor(q1, 1); q1 += __shfl_xor(q1, 2);
        if ((lane & 3) == 0) LG[li * 16 + (lane >> 2)] = q1;
    }
    __syncthreads();
    if (tid < nrows) {
        const int row = LNA_ROW(tid);
        float sg[16], sel[16];
#pragma unroll
        for (int e4 = 0; e4 < 4; ++e4) { const f32x4 l4 = *(const LAS f32x4*)(LG + tid * 16 + 4 * e4); const f32x4 rb4 = *(const f32x4*)(F.in[I_RB] + 4 * e4);
#pragma unroll
            for (int i = 0; i < 4; ++i) { sg[4 * e4 + i] = 1.0f / (1.0f + expf(-l4[i])); sel[4 * e4 + i] = sg[4 * e4 + i] + rb4[i]; } }
        float grp[4];
#pragma unroll
        for (int g = 0; g < 4; ++g) { const float a = sel[4 * g], b = sel[4 * g + 1], c = sel[4 * g + 2], d = sel[4 * g + 3];
            const float h1 = fmaxf(a, b), l1 = fminf(a, b), h2 = fmaxf(c, d), l2 = fminf(c, d); grp[g] = fmaxf(h1, h2) + fmaxf(fminf(h1, h2), fmaxf(l1, l2)); }
        int gb = 0; float best = grp[0];
#pragma unroll
        for (int g = 1; g < 4; ++g) if (grp[g] > best) { best = grp[g]; gb = g; }
        float cs[4], cg[4];
#pragma unroll
        for (int i = 0; i < 4; ++i) { cs[i] = gb == 0 ? sel[i] : gb == 1 ? sel[4 + i] : gb == 2 ? sel[8 + i] : sel[12 + i]; cg[i] = gb == 0 ? sg[i] : gb == 1 ? sg[4 + i] : gb == 2 ? sg[8 + i] : sg[12 + i]; }
        int i0 = 0; float b0 = cs[0];
#pragma unroll
        for (int i = 1; i < 4; ++i) if (cs[i] > b0) { b0 = cs[i]; i0 = i; }
        int i1 = -1; float b1 = 0.f;
#pragma unroll
        for (int i = 0; i < 4; ++i) if (i != i0 && (i1 < 0 || cs[i] > b1)) { b1 = cs[i]; i1 = i; }
        const float s0 = i0 == 0 ? cg[0] : i0 == 1 ? cg[1] : i0 == 2 ? cg[2] : cg[3], s1 = i1 == 0 ? cg[0] : i1 == 1 ? cg[1] : i1 == 2 ? cg[2] : cg[3];
        const float den = s0 + s1; const int e0 = 4 * gb + i0, e1 = 4 * gb + i1;
        int* rt = (int*)(F.ws + WS_ROUTE) + (size_t)row * 4; rt[0] = e0; rt[1] = e1; ((float*)rt)[2] = s0 / den; ((float*)rt)[3] = s1 / den;
        __hip_atomic_fetch_add(cnt + e0, 1, __ATOMIC_RELAXED, __HIP_MEMORY_SCOPE_WORKGROUP); __hip_atomic_fetch_add(cnt + e1, 1, __ATOMIC_RELAXED, __HIP_MEMORY_SCOPE_WORKGROUP);
    }
    __syncthreads();
    if (tid < 16) ((int*)(F.ws + WS_BLKCNT))[F.bid * 16 + tid] = cnt[tid];
#undef LNA_ROW
#undef LNA_XIN
#undef LNA_LOAD
}

__device__ __forceinline__ void list_phase(Frame& F, int layer) {
    PHASE_IDS();
    LAS int* bc = (LAS int*)F.lds;
    LAS int* base = bc + 4096;
    LAS int* tot = base + 16;
    LAS int* tpre = tot + 16;
    const int* blk = (const int*)(F.ws + WS_BLKCNT);
    for (int idx = tid; idx < 4096; idx += NTHR) bc[idx] = blk[idx];
    __syncthreads();
    if (tid < 16) { int s = 0, b0 = 0; for (int b = 0; b < 256; ++b) { if (b == F.bid) b0 = s; s += bc[b * 16 + tid]; } base[tid] = b0; tot[tid] = s; }
    __syncthreads();
    if (tid == 0) { int t = 0; for (int e = 0; e < 16; ++e) { tpre[e] = t; t += (tot[e] + 255) >> 8; } tpre[16] = t; }
    __syncthreads();
    int* srow = (int*)(F.ws + WS_SROW); float* swt = (float*)(F.ws + WS_SWT);
    if (tid < 16) { const int e = tid; int pos = tpre[e] * 256 + base[e];
        const int nrows = (layer == 0) ? 68 : 64;
        for (int i = 0; i < nrows; ++i) { const int row = i < 64 ? F.bid * 64 + i : NLAT + F.bid * 4 + (i - 64);
            const int* rt = (const int*)(F.ws + WS_ROUTE) + (size_t)row * 4; const int e0 = rt[0], e1 = rt[1];
            if (e0 == e) { srow[pos] = row * 2; swt[pos] = ((const float*)rt)[2]; ++pos; }
            if (e1 == e) { srow[pos] = row * 2 + 1; swt[pos] = ((const float*)rt)[3]; ++pos; } } }
    if (F.bid < 16) { const int e = F.bid, lo = tpre[e] * 256 + tot[e], hi = tpre[e + 1] * 256; for (int p = lo + tid; p < hi; p += NTHR) { srow[p] = -1; swt[p] = 0.f; } }
    if (F.bid == 0) { int* te = (int*)(F.ws + WS_TILEE); for (int t = tid; t < tpre[16]; t += NTHR) { int e = 0; for (int q = 1; q < 16; ++q) if (t >= tpre[q]) e = q; te[t] = e; } if (tid == 0) *(int*)(F.ws + WS_TTOT) = tpre[16]; }
}

__device__ __forceinline__ void moe_gemm1(Frame& F, int layer, int phase) {
    PHASE_IDS();
    LAS int* te = (LAS int*)(F.lds + LDS_TILEE);
    const int T = *(const int*)(F.ws + WS_TTOT);
    for (int t = tid; t < T && t < 160; t += NTHR) te[t] = ((const int*)(F.ws + WS_TILEE))[t];
    __syncthreads();
    pg8::SchedMoe S; S.A = (const char*)(F.ws + WS_HA); S.Bt = (const char*)(F.ws + WS_WT_E1) + (size_t)layer * NE * D * D * 2; S.srow = (const int*)(F.ws + WS_SROW); S.tile_e = te;
    const int rounds = (8 * T + F.G - 1) / F.G, NG = (8 * T + rounds - 1) / rounds;
    S.nM = T; S.nN = 8; S.G = NG; S.c = F.bid; S.tstepA = 0; S.tstepB = (size_t)256 * D * 2; S.estepB = (size_t)D * D * 2;
    if (F.bid < NG) { pg8::EpiMoe1 E{(bf16*)(F.ws + WS_RH)};
        pg8::gemm_phase<pg8::EpiMoe1, pg8::SchedMoe, true>(F.lds, F.wave0, D, S, E); bg_signal_done(F, phase); }
    bg_pull(F, Q_END, phase, (unsigned)(NG - 8));
}
__device__ __forceinline__ void moe_gemm2(Frame& F, int layer, int phase) {
    PHASE_IDS();
    LAS int* te = (LAS int*)(F.lds + LDS_TILEE);
    const int T = *(const int*)(F.ws + WS_TTOT);
    for (int t = tid; t < T && t < 160; t += NTHR) te[t] = ((const int*)(F.ws + WS_TILEE))[t];
    __syncthreads();
    pg8::SchedMoe S; S.A = (const char*)(F.ws + WS_RH); S.Bt = (const char*)(F.ws + WS_WT_E2) + (size_t)layer * NE * D * DE * 2; S.srow = nullptr; S.tile_e = te;
    const int rounds = (8 * T + F.G - 1) / F.G, NG = (8 * T + rounds - 1) / rounds;
    S.nM = T; S.nN = 8; S.G = NG; S.c = F.bid; S.tstepA = (size_t)256 * DE * 2; S.tstepB = (size_t)256 * DE * 2; S.estepB = (size_t)D * DE * 2;
    if (F.bid < NG) { pg8::EpiMoe2 E{(bf16*)(F.ws + WS_REX), (const int*)(F.ws + WS_SROW), (const float*)(F.ws + WS_SWT)};
        pg8::gemm_phase<pg8::EpiMoe2, pg8::SchedMoe, false>(F.lds, F.wave0, DE, S, E); bg_signal_done(F, phase); }
    bg_pull(F, Q_END, phase, (unsigned)(NG - 8));
}

constexpr int SC_QS = 0, SC_KS = 17408, SC_VS = 34816, SC_VW = 46080, SC_PS = 57344, SC_CB0 = 66560, SC_CB1 = 88320, SC_GA = 110080;
constexpr int QP = 136, VP = 88, PP = 72;
__device__ __forceinline__ bf16x8 lds_row8(const LAS unsigned char* base, int row, int pitch, int col) { return *(const LAS bf16x8*)(base + (row * pitch + col) * 2); }
typedef short v4i16_t __attribute__((ext_vector_type(4)));
__device__ __forceinline__ bf16x8 lds_tr8(const LAS unsigned char* base, int pitch, int k0, int x0, int lane) {
    const int g = lane >> 4, q = (lane & 15) >> 2, p = lane & 3;
    const LAS unsigned char* a = base + ((k0 + 8 * g + q) * pitch + x0 + 4 * p) * 2;
    const s16x4 lo = __builtin_bit_cast(s16x4, __builtin_amdgcn_ds_read_tr16_b64_v4i16((LAS v4i16_t*)a));
    const s16x4 hi = __builtin_bit_cast(s16x4, __builtin_amdgcn_ds_read_tr16_b64_v4i16((LAS v4i16_t*)(a + 4 * pitch * 2)));
    return (bf16x8){lo[0], lo[1], lo[2], lo[3], hi[0], hi[1], hi[2], hi[3]};
}
constexpr size_t WS_GSCR = 810 * MiB;
__device__ __forceinline__ float fexp(float x) { return __builtin_amdgcn_exp2f(x * 1.44269504088896f); }
__device__ __forceinline__ void scan_phase(Frame& F) {
    PHASE_IDS();
    const int x8 = F.bid & 7, y = F.bid >> 3, vs = y & 3, grp = x8 * 8 + (y >> 2), dir = grp & 1, hh = (grp >> 1) & 7, bb = grp >> 4;
    const int w = wave, i16 = lane & 15, g = lane >> 4;
    const bf16* QKVO = (const bf16*)(F.ws + WS_RC); const float* GT = (const float*)(F.ws + WS_GATES);
    bf16* HOUT = dir == 0 ? (bf16*)(F.ws + WS_RB) : (bf16*)(F.ws + WS_HB2);
    float* GS = (float*)(F.ws + WS_GSCR) + (size_t)F.bid * (68 * 192);
    LAS unsigned char* L = F.lds;
    LAS float* SE = (LAS float*)(L + SC_GA + 2560);
#define SCAN_TOK(step, r) ((step) < 4 ? (NLAT + bb * CTXL + (dir ? (CTXL - 1 - ((step) * 64 + (r))) : ((step) * 64 + (r)))) : (bb * SEQ + (dir ? (SEQ - 1 - (((step) - 4) * 64 + (r))) : (((step) - 4) * 64 + (r)))))
    for (int idx = tid; idx < 64 * 24; idx += NTHR) { const int r = idx / 24, c = 64 + idx % 24; ((LAS bf16*)(L + SC_VS))[r * VP + c] = (c == 64) ? (bf16)0x3F80 : (bf16)0; ((LAS bf16*)(L + SC_VW))[r * VP + c] = 0; }
    { const float big = F.in[I_MBG][(dir * 2) * 8 + hh], bfg = F.in[I_MBG][(dir * 2 + 1) * 8 + hh];
      for (int step = w; step < 68; step += NWAVES) {
        const size_t tg = (size_t)SCAN_TOK(step, lane); const float gi = GT[tg * 32 + (dir * 2) * 8 + hh] + big, gf = GT[tg * 32 + (dir * 2 + 1) * 8 + hh] + bfg;
        const float lf = fminf(gf, 0.f) - log1pf(expf(-fabsf(gf)));
        float bc = lf;
#pragma unroll
        for (int o = 1; o < 64; o <<= 1) { const float t = __shfl_up(bc, o); if (lane >= o) bc += t; }
        const float a = gi - bc; float cm = a;
#pragma unroll
        for (int o = 1; o < 64; o <<= 1) { const float t = __shfl_up(cm, o); if (lane >= o) cm = fmaxf(cm, t); }
        GS[step * 192 + lane] = a; GS[step * 192 + 64 + lane] = bc; GS[step * 192 + 128 + lane] = cm;
        if (lane == 63) { SE[step] = bc; SE[68 + step] = cm; } } }
    __syncthreads();
    if (tid == 0) { float m = 0.f; for (int st = 0; st < 68; ++st) { SE[136 + st] = m; m = SE[st] + fmaxf(m, SE[68 + st]); } }
    f32x4 accc[5];
#pragma unroll
    for (int i = 0; i < 5; ++i) accc[i] = (f32x4){0.f, 0.f, 0.f, 0.f};
    const int qr0 = tid >> 4, qc = (tid & 15) * 8;
    const int vr = tid >> 3, vc = (tid & 7) * 8;
    u32x4 rq0, rq1, rk0, rk1, rv; float ga = 0.f, gb = 0.f, gc = 0.f, av = 0.f;
#define SCAN_LOAD(step) do { const size_t t0_ = (size_t)SCAN_TOK(step, qr0), t1_ = (size_t)SCAN_TOK(step, qr0 + 32), tv_ = (size_t)SCAN_TOK(step, vr); \
        if ((step) >= 4) { rq0 = *(const u32x4*)(QKVO + t0_ * MLW + hh * DQK + qc); rq1 = *(const u32x4*)(QKVO + t1_ * MLW + hh * DQK + qc); } \
        rk0 = *(const u32x4*)(QKVO + t0_ * MLW + 1024 + hh * DQK + qc); rk1 = *(const u32x4*)(QKVO + t1_ * MLW + 1024 + hh * DQK + qc); \
        rv = *(const u32x4*)(QKVO + tv_ * MLW + 2048 + hh * DV + vs * 64 + vc); av = GS[(step) * 192 + vr]; \
        if (w == 0) { ga = GS[(step) * 192 + lane]; gb = GS[(step) * 192 + 64 + lane]; gc = GS[(step) * 192 + 128 + lane]; } } while (0)
    __syncthreads();
    SCAN_LOAD(0);
    for (int step = 0; step < 68; ++step) {
        const bool outp = step >= 4;
        LAS float* GA = (LAS float*)(L + SC_GA) + (step & 1) * 320;
        LAS unsigned char* CBc = L + ((step & 1) ? SC_CB1 : SC_CB0); LAS unsigned char* CBn = L + ((step & 1) ? SC_CB0 : SC_CB1);
        const float m_st = SE[136 + step], Mend = fmaxf(m_st, SE[68 + step]), decay = fexp(m_st - Mend);
        __syncthreads();
        if (w == 0) { const float M = fmaxf(m_st, gc); GA[lane] = ga; GA[64 + lane] = M; GA[128 + lane] = fexp(m_st - M); GA[192 + lane] = fexp(-(gb + M)); }
        if (outp) { *(LAS u32x4*)(L + SC_QS + (qr0 * QP + qc) * 2) = rq0; *(LAS u32x4*)(L + SC_QS + ((qr0 + 32) * QP + qc) * 2) = rq1; }
        *(LAS u32x4*)(L + SC_KS + (qr0 * QP + qc) * 2) = rk0; *(LAS u32x4*)(L + SC_KS + ((qr0 + 32) * QP + qc) * 2) = rk1;
        *(LAS u32x4*)(L + SC_VS + (vr * VP + vc) * 2) = rv;
        { const float wr_ = fexp(av - Mend); u32x4 o; o.x = cvt_pk_bf16(bf_lo(rv.x) * wr_, bf_hi(rv.x) * wr_); o.y = cvt_pk_bf16(bf_lo(rv.y) * wr_, bf_hi(rv.y) * wr_); o.z = cvt_pk_bf16(bf_lo(rv.z) * wr_, bf_hi(rv.z) * wr_); o.w = cvt_pk_bf16(bf_lo(rv.w) * wr_, bf_hi(rv.w) * wr_);
          *(LAS u32x4*)(L + SC_VW + (vr * VP + vc) * 2) = o;
          if (vc == 0) ((LAS bf16*)(L + SC_VW))[vr * VP + 64] = (bf16)(cvt_pk_bf16(wr_, 0.f) & 0xffffu); }
        if (step + 1 < 68) SCAN_LOAD(step + 1);
        __syncthreads();
        const int tb = w & 3;
        if (outp) {
            const int sb0 = 2 * (w >> 2);
            f32x4 sa[2] = {(f32x4){0.f, 0.f, 0.f, 0.f}, (f32x4){0.f, 0.f, 0.f, 0.f}};
#pragma unroll
            for (int ks = 0; ks < 4; ++ks) { const bf16x8 bq = lds_row8(L + SC_QS, 16 * tb + i16, QP, 32 * ks + 8 * g);
#pragma unroll
                for (int j = 0; j < 2; ++j) { const bf16x8 ak = lds_row8(L + SC_KS, 16 * (sb0 + j) + i16, QP, 32 * ks + 8 * g); sa[j] = __builtin_amdgcn_mfma_f32_16x16x32_bf16(ak, bq, sa[j], 0, 0, 0); } }
            const int t = 16 * tb + i16; const float Mt = GA[64 + t];
#pragma unroll
            for (int j = 0; j < 2; ++j) { const int s0 = 16 * (sb0 + j) + 4 * g; const f32x4 a4 = *(const LAS f32x4*)(GA + s0); float p[4];
#pragma unroll
                for (int r = 0; r < 4; ++r) p[r] = (s0 + r <= t) ? fexp(a4[r] - Mt) * sa[j][r] : 0.f;
                u32x2 o; o.x = cvt_pk_bf16(p[0], p[1]); o.y = cvt_pk_bf16(p[2], p[3]); *(LAS u32x2*)(L + SC_PS + (t * PP + s0) * 2) = o; }
        }
#pragma unroll
        for (int i = 0; i < 5; ++i) accc[i] = accc[i] * decay;
#pragma unroll
        for (int ks = 0; ks < 2; ++ks) { const bf16x8 ak = lds_tr8(L + SC_KS, QP, 32 * ks, 16 * w, lane);
#pragma unroll
            for (int i = 0; i < 5; ++i) { const bf16x8 bv = lds_tr8(L + SC_VW, VP, 32 * ks, 16 * i, lane); accc[i] = __builtin_amdgcn_mfma_f32_16x16x32_bf16(ak, bv, accc[i], 0, 0, 0); } }
#pragma unroll
        for (int i = 0; i < 5; ++i) { u32x2 o; o.x = cvt_pk_bf16(accc[i][0], accc[i][1]); o.y = cvt_pk_bf16(accc[i][2], accc[i][3]); *(LAS u32x2*)(CBn + ((16 * i + i16) * QP + 16 * w + 4 * g) * 2) = o; }
        if (outp) {
            __syncthreads();
            const int half = w >> 2; const int vb[3] = {2 * half, 2 * half + 1, 4};
            f32x4 oa[3] = {(f32x4){0.f, 0.f, 0.f, 0.f}, (f32x4){0.f, 0.f, 0.f, 0.f}, (f32x4){0.f, 0.f, 0.f, 0.f}};
#pragma unroll
            for (int ks = 0; ks < 4; ++ks) { const bf16x8 bq = lds_row8(L + SC_QS, 16 * tb + i16, QP, 32 * ks + 8 * g);
#pragma unroll
                for (int j = 0; j < 3; ++j) { const bf16x8 ac = lds_row8(CBc, 16 * vb[j] + i16, QP, 32 * ks + 8 * g); oa[j] = __builtin_amdgcn_mfma_f32_16x16x32_bf16(ac, bq, oa[j], 0, 0, 0); } }
            const int t = 16 * tb + i16; const float it = GA[128 + t];
#pragma unroll
            for (int j = 0; j < 3; ++j) oa[j] = oa[j] * it;
#pragma unroll
            for (int ks = 0; ks < 2; ++ks) { const bf16x8 bp = lds_row8(L + SC_PS, 16 * tb + i16, PP, 32 * ks + 8 * g);
#pragma unroll
                for (int j = 0; j < 3; ++j) { const bf16x8 av8 = lds_tr8(L + SC_VS, VP, 32 * ks, 16 * vb[j], lane); oa[j] = __builtin_amdgcn_mfma_f32_16x16x32_bf16(av8, bp, oa[j], 0, 0, 0); } }
            const float den = __shfl(oa[2][0], i16);
            const float inv = __builtin_amdgcn_rcpf(fmaxf(fabsf(den), GA[192 + t]));
            const size_t tok = (size_t)SCAN_TOK(step, t);
#pragma unroll
            for (int j = 0; j < 2; ++j) { u32x2 o; o.x = cvt_pk_bf16(oa[j][0] * inv, oa[j][1] * inv); o.y = cvt_pk_bf16(oa[j][2] * inv, oa[j][3] * inv);
                *(u32x2*)(HOUT + tok * D + hh * DV + vs * 64 + 16 * vb[j] + 4 * g) = o; }
        }
    }
    __syncthreads();
#undef SCAN_TOK
#undef SCAN_LOAD
}

__device__ __forceinline__ void headnorm_phase(Frame& F) {
    PHASE_IDS();
    const int gw = F.bid * NWAVES + wave, NGW = F.G * NWAVES;
    const bf16* HF = (const bf16*)(F.ws + WS_RB); const bf16* HB = (const bf16*)(F.ws + WS_HB2); const bf16* QKVO = (const bf16*)(F.ws + WS_RC); bf16* Y = (bf16*)(F.ws + WS_HA);
    const float* ng = F.in[I_MNG];
    f32x4 gn[4][2];
#pragma unroll
    for (int j = 0; j < 4; ++j) { gn[j][0] = *(const f32x4*)(ng + 512 * j + 8 * lane); gn[j][1] = *(const f32x4*)(ng + 512 * j + 8 * lane + 4); }
    u32x4 an[4], bn[4], on[4];
#define HN_LOAD(row) do { _Pragma("unroll") for (int j = 0; j < 4; ++j) { const int c = 512 * j + 8 * lane; an[j] = *(const u32x4*)(HF + (size_t)(row) * D + c); bn[j] = *(const u32x4*)(HB + (size_t)(row) * D + c); on[j] = *(const u32x4*)(QKVO + (size_t)(row) * MLW + 4096 + c); } } while (0)
    if (gw < NLAT) HN_LOAD(gw);
    for (int row = gw; row < NLAT; row += NGW) {
        u32x4 a[4], b[4], o[4];
#pragma unroll
        for (int j = 0; j < 4; ++j) { a[j] = an[j]; b[j] = bn[j]; o[j] = on[j]; }
        if (row + NGW < NLAT) HN_LOAD(row + NGW);
        SCHED_FENCE();
#pragma unroll
        for (int j = 0; j < 4; ++j) {
            float h[8]; float s = 0.f;
#pragma unroll
            for (int q = 0; q < 4; ++q) { h[2 * q] = bf_lo(a[j][q]) + bf_lo(b[j][q]); h[2 * q + 1] = bf_hi(a[j][q]) + bf_hi(b[j][q]); s += h[2 * q] + h[2 * q + 1]; }
#pragma unroll
            for (int o2 = 1; o2 < 32; o2 <<= 1) s += __shfl_xor(s, o2);
            const float mean = s * (1.f / DV); float s2 = 0.f;
#pragma unroll
            for (int q = 0; q < 8; ++q) { h[q] -= mean; s2 += h[q] * h[q]; }
#pragma unroll
            for (int o2 = 1; o2 < 32; o2 <<= 1) s2 += __shfl_xor(s2, o2);
            const float rstd = 1.0f / sqrtf(s2 * (1.f / DV) + HN_EPS);
            float yv[8];
#pragma unroll
            for (int q = 0; q < 4; ++q) { const float o0 = bf_lo(o[j][q]), o1 = bf_hi(o[j][q]); const float n0 = gn[j][q >> 1][2 * (q & 1)], n1 = gn[j][q >> 1][2 * (q & 1) + 1];
                yv[2 * q] = h[2 * q] * rstd * n0 * __builtin_amdgcn_rcpf(1.0f + __expf(-o0)); yv[2 * q + 1] = h[2 * q + 1] * rstd * n1 * __builtin_amdgcn_rcpf(1.0f + __expf(-o1)); }
            u32x4 wv; wv.x = cvt_pk_bf16(yv[0], yv[1]); wv.y = cvt_pk_bf16(yv[2], yv[3]); wv.z = cvt_pk_bf16(yv[4], yv[5]); wv.w = cvt_pk_bf16(yv[6], yv[7]);
            *(u32x4*)(Y + (size_t)row * D + 512 * j + 8 * lane) = wv;
        }
    }
#undef HN_LOAD
}

constexpr int NPH = 19;
__global__ void __launch_bounds__(NTHR, 2) fwd_kernel(Args args) {
    extern __shared__ __attribute__((aligned(16))) unsigned char lds_raw[];
    Frame F;
    F.lds = (LAS unsigned char*)lds_raw;
    F.G = gridDim.x; F.bid = blockIdx.x; F.wave0 = __builtin_amdgcn_readfirstlane(threadIdx.x >> 6);
#pragma unroll
    for (int i = 0; i < 21; ++i) F.in[i] = args.in[i];
    F.out = args.out; F.ws = args.ws;
    for (int u = threadIdx.x; u < (LDS_BYTES - LDSCTL_OFF) / 4; u += NTHR) ((LAS unsigned*)(F.lds + LDSCTL_OFF))[u] = 0u;
    __syncthreads();
#if MK_N_LAUNCHES == 1
    XcdBarrier bar = xcd_barrier_post((unsigned*)(F.ws + WS_CTL) + CW_BAR, (volatile LAS unsigned*)(F.lds + LDS_MISC));
#define GRID_BAR() xcd_barrier(bar)
#else
#define GRID_BAR() do { } while (0)
#endif
    const int lo = args.ph_lo, hi = args.ph_hi;
#ifndef PHASE_MASK
#define PHASE_MASK 0x7ffff
#endif
#define IN(k) (((PHASE_MASK >> (k)) & 1) && lo <= (k) && (k) < hi)
#define SEAM(k) do { if (IN(k) && IN((k) + 1)) GRID_BAR(); } while (0)

#ifndef DUP_MASK
#define DUP_MASK 0x0
#endif
#define PHASE(k, body) do { if (IN(k)) { body; if ((DUP_MASK >> (k)) & 1) { GRID_BAR(); body; } } SEAM(k); } while (0)
    PHASE(0, p0_prologue(F));
    PHASE(1, p1_modulate(F));
    PHASE(2, ({
        constexpr int NG = 234;
        if (F.bid < NG) { pg8::SchedPlain S; S.init((const bf16*)(F.ws + WS_HA), (const bf16*)(F.ws + WS_WT_CIN), NTOK, 6144, D, NG, F.bid);
            pg8::EpiConv1 E{(bf16*)(F.ws + WS_RB), (bf16*)(F.ws + WS_RC)};
            pg8::gemm_phase<pg8::EpiConv1, pg8::SchedPlain, false>(F.lds, F.wave0, D, S, E); bg_signal_done(F, 2); }
        bg_pull(F, Q_END, 2, NG - 8); }));
    PHASE(3, p3_conv(F));
    PHASE(4, ({
        constexpr int NG = 182;
        if (F.bid < NG) { pg8::SchedPlain S; S.init((const bf16*)(F.ws + WS_HA), (const bf16*)(F.ws + WS_WT_COUT), NTOK, D, D, NG, F.bid);
            pg8::EpiBf16 E{(bf16*)(F.ws + WS_RB), D};
            pg8::gemm_phase<pg8::EpiBf16, pg8::SchedPlain, false>(F.lds, F.wave0, D, S, E); bg_signal_done(F, 4); }
        bg_pull(F, Q_END, 4, NG - 8); }));
    PHASE(5, lnA_phase(F, 0));
    PHASE(6, ({ list_phase(F, 0); bg_pull(F, Q_GV1, -1, 0u); }));
    PHASE(7, moe_gemm1(F, 0, 7));
    PHASE(8, moe_gemm2(F, 0, 8));
    PHASE(9, ({ lnB_phase(F, 0); bg_pull(F, Q_ML, -1, 0u); }));
    PHASE(10, ({
        constexpr int NG = 243;
        if (F.bid < NG) { pg8::SchedPlain S; S.init((const bf16*)(F.ws + WS_HA), (const bf16*)(F.ws + WS_WT_MIN), NTOK, MLN, D, NG, F.bid);
            pg8::EpiMlIn E{(bf16*)(F.ws + WS_RC), (float*)(F.ws + WS_GATES)};
            pg8::gemm_phase<pg8::EpiMlIn, pg8::SchedPlain, false>(F.lds, F.wave0, D, S, E); bg_signal_done(F, 10); }
        bg_pull(F, Q_END, 10, NG - 8); }));
    PHASE(11, scan_phase(F));
    PHASE(12, headnorm_phase(F));
    PHASE(13, ({
        pg8::SchedPlain S; S.init((const bf16*)(F.ws + WS_HA), (const bf16*)(F.ws + WS_WT_MOUT), NLAT, D, D, F.G, F.bid);
        pg8::EpiBf16 E{(bf16*)(F.ws + WS_RB), D};
        pg8::gemm_phase<pg8::EpiBf16, pg8::SchedPlain, false>(F.lds, F.wave0, D, S, E); }));
    PHASE(14, lnA_phase(F, 1));
    PHASE(15, ({ list_phase(F, 1); bg_pull(F, Q_END, -1, 0u); }));
    PHASE(16, moe_gemm1(F, 1, 16));
    PHASE(17, moe_gemm2(F, 1, 17));
    PHASE(18, lnB_phase(F, 1));
#undef PHASE
#undef IN
#undef SEAM
}

extern "C" void kernel_launch(void* const* d_in, const int* in_sizes, int n_in, void* d_out, int out_size, void* d_ws, size_t ws_size, hipStream_t stream) {
    static int grid = 0;
    if (grid == 0) {
        if (n_in != 21 || out_size != NLAT * D || ws_size < WS_END) { fprintf(stderr, "kernel_launch: unexpected problem (n_in %d, out %d, ws %zu; need ws >= %zu)\n", n_in, out_size, ws_size, (size_t)WS_END); grid = -1; return; }
        int dev = 0, cus = 0, per_cu = 0;
        if (hipGetDevice(&dev) != hipSuccess || hipDeviceGetAttribute(&cus, hipDeviceAttributeMultiprocessorCount, dev) != hipSuccess) { grid = -1; return; }
        if (hipFuncSetAttribute((const void*)fwd_kernel, hipFuncAttributeMaxDynamicSharedMemorySize, LDS_BYTES) != hipSuccess) { fprintf(stderr, "kernel_launch: hipFuncSetAttribute failed\n"); grid = -1; return; }
        if (hipOccupancyMaxActiveBlocksPerMultiprocessor(&per_cu, (const void*)fwd_kernel, NTHR, LDS_BYTES) != hipSuccess || per_cu < 1) fprintf(stderr, "kernel_launch: occupancy query reports %d\n", per_cu);
        (void)hipGetLastError();
        if (cus < GRID) { fprintf(stderr, "kernel_launch: needs %d CUs, device has %d\n", GRID, cus); grid = -1; return; }
        grid = GRID;
    }
    if (grid < 0) return;
    (void)in_sizes;
    if (hipMemsetAsync((char*)d_ws + WS_CTL, 0, CTL_ZERO_BYTES, stream) != hipSuccess) return;
    Args a{};
    for (int i = 0; i < 21; ++i) a.in[i] = (const float*)d_in[i];
    a.out = (float*)d_out; a.ws = (unsigned char*)d_ws;
#if MK_N_LAUNCHES == 1
    a.ph_lo = 0; a.ph_hi = NPH;
    hipLaunchKernelGGL(fwd_kernel, dim3(grid), dim3(NTHR), LDS_BYTES, stream, a);
#else
    for (int p = 0; p < NPH; ++p) { a.ph_lo = p; a.ph_hi = p + 1; hipLaunchKernelGGL(fwd_kernel, dim3(grid), dim3(NTHR), LDS_BYTES, stream, a); }
#endif
}
```

```cpp
#include <hip/hip_runtime.h>
#include <cstdio>
#include <cstdint>

#ifndef MK_N_LAUNCHES
#define MK_N_LAUNCHES 1
#endif

#define LAS __attribute__((address_space(3)))
typedef unsigned short bf16;
typedef short bf16x8 __attribute__((ext_vector_type(8)));
typedef short s16x4 __attribute__((ext_vector_type(4)));
typedef float f32x4 __attribute__((ext_vector_type(4)));
typedef unsigned u32x4 __attribute__((ext_vector_type(4)));
typedef unsigned u32x2 __attribute__((ext_vector_type(2)));

constexpr int D = 2048, NB = 4, SEQ = 4096, NLAT = NB * SEQ, CTXL = 256, NCTX = NB * CTXL, NTOK = NLAT + NCTX;
constexpr int NE = 16, DE = 1024, NH = 8, DQK = 128, DV = 256;
constexpr int MLW = 6144, MLN = 6400;
constexpr int NWAVES = 8, NTHR = 512, GRID = 256;
constexpr float ALPHA = 1.41421356237f, LN_EPS = 1e-5f, HN_EPS = 1e-6f;
constexpr int MAXTILES = 153;

constexpr size_t MiB = 1u << 20;
constexpr size_t WS_CTL = 0, CTL_ZERO_BYTES = 1 * MiB;
constexpr size_t WS_MOD = 1 * MiB;
constexpr size_t WS_MISC = 2 * MiB;
constexpr size_t WS_ROUTE = WS_MISC + 0, WS_BLKCNT = WS_MISC + 0x48000, WS_SROW = WS_MISC + 0x50000, WS_SWT = WS_MISC + 0x80000, WS_TILEE = WS_MISC + 0xB0000, WS_TTOT = WS_MISC + 0xB0400;
constexpr size_t WS_CTXRES = 6 * MiB;
constexpr size_t WS_GATES = 14 * MiB;
constexpr size_t WS_WT_CIN = 17 * MiB, WS_WT_COUT = 41 * MiB, WS_WT_MIN = 49 * MiB, WS_WT_MOUT = 74 * MiB, WS_WT_E1 = 82 * MiB, WS_WT_E2 = 338 * MiB;
constexpr size_t WS_HA = 466 * MiB, WS_RB = 534 * MiB, WS_RC = 602 * MiB, WS_RH = 670 * MiB, WS_REX = 747 * MiB, WS_HB2 = 883 * MiB, WS_END = 947 * MiB;
constexpr int CW_BAR = 4096;

constexpr int RING_BYTES = 131072, LDSCTL_OFF = 139264, LDS_TILEE = LDSCTL_OFF, LDS_MISC = LDSCTL_OFF + 1024, LDS_BYTES = 147456;

__device__ __forceinline__ unsigned cvt_pk_bf16(float lo, float hi) { unsigned r; asm volatile("v_cvt_pk_bf16_f32 %0, %1, %2" : "=v"(r) : "v"(lo), "v"(hi)); return r; }
__device__ __forceinline__ float bf_lo(unsigned u) { return __uint_as_float(u << 16); }
__device__ __forceinline__ float bf_hi(unsigned u) { return __uint_as_float(u & 0xffff0000u); }
__device__ __forceinline__ float wave_sum(float v) {
#pragma unroll
    for (int o = 1; o < 64; o <<= 1) v += __shfl_xor(v, o);
    return v;
}
#define LDS_WAIT() asm volatile("s_waitcnt lgkmcnt(0)" ::: "memory")
#define VM_WAIT() asm volatile("s_waitcnt vmcnt(0)" ::: "memory")

#define XB_TMO      128
#define XB_XCNT(j)  (256  + 64 * (j))
#define XB_XSUB(j)  (1280 + 64 * (j))
#define XB_XGEN(j)  (2304 + 64 * (j))
#define XB_TOP      3328
#define XB_TOPGEN   3392
#define XCD_BAR_WORDS 3456
#define XB_SPIN_CAP (1u << 18)
__device__ __forceinline__ unsigned xb_ld(unsigned* p)              { return __hip_atomic_load(p, __ATOMIC_RELAXED, __HIP_MEMORY_SCOPE_AGENT); }
__device__ __forceinline__ unsigned xb_add(unsigned* p, unsigned v) { return __hip_atomic_fetch_add(p, v, __ATOMIC_RELAXED, __HIP_MEMORY_SCOPE_AGENT); }
__device__ __forceinline__ unsigned xb_xcc_id() { return (unsigned)__builtin_amdgcn_s_getreg((3 << 11) | 20) & 0xFu; }
#define XB_SPIN(cond, bar) do { unsigned _sp = 0; while (cond) { __builtin_amdgcn_s_sleep(1); \
    if ((++_sp & 255u) == 0u) { if (xb_ld(&(bar)[XB_TMO])) break; if (_sp > XB_SPIN_CAP) { atomicAdd(&(bar)[XB_TMO], 1u); break; } } } } while (0)
struct XcdBarrier { unsigned* bar; unsigned x; volatile LAS unsigned* st; };
__device__ __forceinline__ XcdBarrier xcd_barrier_post(unsigned* bar, volatile LAS unsigned* st) {
    XcdBarrier b; b.bar = bar; b.x = xb_xcc_id(); b.st = st;
    if (threadIdx.x == 0) (void)xb_add(&bar[XB_XCNT(b.x)], 1u);
    return b;
}
__device__ __forceinline__ void xcd_barrier_complete(unsigned* bar, unsigned x, unsigned& nloc, unsigned& nx) {
    const unsigned G = gridDim.x * gridDim.y * gridDim.z;
    unsigned sum, cnt, mine, sp = 0u;
    for (;;) {
        sum = 0u; cnt = 0u; mine = 0u;
#pragma unroll
        for (unsigned j = 0; j < 16; ++j) { const unsigned c = xb_ld(&bar[XB_XCNT(j)]); sum += c; cnt += (c > 0u) ? 1u : 0u; mine = (j == x) ? c : mine; }
        if (sum == G) break;
        __builtin_amdgcn_s_sleep(1);
        if ((++sp & 255u) == 0u) { if (xb_ld(&bar[XB_TMO])) break; if (sp > XB_SPIN_CAP) { atomicAdd(&bar[XB_TMO], 1u); break; } }
    }
    nloc = mine > 0u ? mine : 1u; nx = cnt > 0u ? cnt : 1u;
}
__device__ __forceinline__ void xcd_barrier(const XcdBarrier& b) {
    asm volatile("s_waitcnt vmcnt(0)" ::: "memory");
    __syncthreads();
    if (threadIdx.x == 0) {
        unsigned* bar = b.bar;
        __builtin_amdgcn_s_waitcnt(0);
        unsigned nloc = b.st[0], nx = b.st[1];
        if (nloc == 0u) { xcd_barrier_complete(bar, b.x, nloc, nx); b.st[0] = nloc; b.st[1] = nx; }
        const unsigned old = xb_add(&bar[XB_XSUB(b.x)], 1u);
        const unsigned gen = old / nloc;
        if (old + 1u == (gen + 1u) * nloc) {
            __builtin_amdgcn_fence(__ATOMIC_RELEASE, "agent");
            asm volatile("s_waitcnt vmcnt(0)" ::: "memory");
            const unsigned og = xb_add(&bar[XB_TOP], 1u);
            const unsigned tg = og / nx;
            if (og + 1u == (tg + 1u) * nx) xb_add(&bar[XB_TOPGEN], 1u);
            else XB_SPIN(xb_ld(&bar[XB_TOPGEN]) == tg, bar);
            __builtin_amdgcn_fence(__ATOMIC_ACQUIRE, "agent");
            xb_add(&bar[XB_XGEN(b.x)], 1u);
            asm volatile("s_waitcnt vmcnt(0)" ::: "memory");
        } else {
            XB_SPIN(xb_ld(&bar[XB_XGEN(b.x)]) == gen, bar);
            __builtin_amdgcn_fence(__ATOMIC_ACQUIRE, "agent");
            asm volatile("s_waitcnt vmcnt(0)" ::: "memory");
        }
    }
    __syncthreads();
}

namespace pg8 {
constexpr int BM = 256, BK = 64, HALF = 128, HTB = HALF * BK * 2, NXCD = 8, WGM = 8;
__device__ __forceinline__ int lds_byte(int r, int c) { const int st = (r >> 4) * 2 + (c >> 5), rr = r & 15, cc = c & 31, ob = rr * 64 + cc * 2; return st * 1024 + (ob ^ (((ob >> 9) & 1) << 5)); }
__device__ __forceinline__ void stage_rc(int b, int& R, int& C) { const int st = b / 1024, sb = b % 1024, swz = sb ^ (((sb >> 9) & 1) << 5); R = (st >> 1) * 16 + swz / 64; C = (st & 1) * 32 + (swz % 64) / 2; }
__device__ __forceinline__ int perm32(int rho) { const int n = rho >> 4, i = rho & 15; return 8 * (i >> 2) + 4 * n + (i & 3); }

struct Unit { int pm, pn; const char* a; const char* b; };

__device__ __forceinline__ bool order_next(int i, int G, int c, int nM, int nN, int& pm, int& pn) {
    const int nwg = nM * nN; const long L = (long)i * G + c; if (L >= nwg) return false;
    int wgid = (int)L; { const int q = nwg / NXCD, r = nwg % NXCD, xcd = wgid % NXCD, off = wgid / NXCD; wgid = (xcd < r ? xcd * (q + 1) : r * (q + 1) + (xcd - r) * q) + off; }
    const int nig = WGM * nN, gid = wgid / nig, fm = gid * WGM, gsz = (nM - fm) < WGM ? (nM - fm) : WGM;
    pm = fm + ((wgid % nig) % gsz); pn = (wgid % nig) / gsz; return true;
}
struct SchedPlain {
    const char* A; const char* Bt; int nM, nN, G, c; size_t tstep;
    __device__ __forceinline__ void init(const bf16* A_, const bf16* Bt_, int M, int N, int K, int G_, int c_) { A = (const char*)A_; Bt = (const char*)Bt_; nM = M / BM; nN = N / BM; G = G_; c = c_; tstep = (size_t)BM * K * 2; }
    __device__ __forceinline__ bool next(int i, Unit& u) const { if (!order_next(i, G, c, nM, nN, u.pm, u.pn)) return false; u.a = A + (size_t)u.pm * tstep; u.b = Bt + (size_t)u.pn * tstep; return true; }
};
struct SchedMoe {
    const char* A; const char* Bt; const int* srow; const LAS int* tile_e; int nM, nN, G, c; size_t tstepA, tstepB, estepB;
    __device__ __forceinline__ bool next(int i, Unit& u) const { if (!order_next(i, G, c, nM, nN, u.pm, u.pn)) return false;
        const int e = tile_e[u.pm]; u.a = A + (size_t)u.pm * tstepA; u.b = Bt + (size_t)e * estepB + (size_t)u.pn * tstepB; return true; }
};

template <class Epi, class Sched, bool GATHER>
__device__ __forceinline__ void gemm_phase(LAS unsigned char* lds, const int wid, const int K, const Sched& S, const Epi& E) {
    int lane_ = (int)__builtin_amdgcn_mbcnt_hi(~0u, __builtin_amdgcn_mbcnt_lo(~0u, 0u)); asm volatile("" : "+v"(lane_));
    const int lane = lane_, tid = wid * 64 + lane, wr = wid >> 2, wc = wid & 3, fr = lane & 15, fq = lane >> 4;
    const int nt = K / BK;
    int R0, C0, R1, C1; stage_rc(tid * 16, R0, C0); stage_rc(tid * 16 + 8192, R1, C1);
    unsigned voffB[2]; voffB[0] = (unsigned)(((R0 & ~31) + perm32(R0 & 31)) * K + C0) * 2u; voffB[1] = (unsigned)(((R1 & ~31) + perm32(R1 & 31)) * K + C1) * 2u;
    unsigned cv[4], nv[4];
    const size_t kstep = (size_t)(BK * 2);
    const size_t hstep = (size_t)HALF * K * 2;
    const unsigned ldsw = (unsigned)wid * 1024u;
    const int aoff = lds_byte(wr * 64 + fr, fq * 8), boff = lds_byte(wc * 32 + fr, fq * 8);
#define PG8_SA(b, h) (((b) * 2 + (h)) * HTB)
#define PG8_SB(b, h) ((4 + (b) * 2 + (h)) * HTB)
#define PG8_STG(bufoff, ptr, o0, o1) do { const char* p_ = (const char*)(ptr); asm volatile("" : "+s"(p_));     \
        __builtin_amdgcn_global_load_lds((const unsigned*)(p_ + (o0)), (LAS unsigned*)(lds + (bufoff) + ldsw), 16, 0, 0); \
        __builtin_amdgcn_global_load_lds((const unsigned*)(p_ + (o1)), (LAS unsigned*)(lds + (bufoff) + ldsw + 8192), 16, 0, 0); } while (0)
#define PG8_STGB(bufoff, ptr) PG8_STG(bufoff, ptr, voffB[0], voffB[1])
#define PG8_STGA(bufoff, ptr, h, V) do { if constexpr (GATHER) { PG8_STG(bufoff, ptr, (V)[2 * (h)], (V)[2 * (h) + 1]); } else { PG8_STG(bufoff, (ptr) + (h) * hstep, (V)[0], (V)[1]); } } while (0)
#define PG8_LDA(dst, b, h) do { _Pragma("unroll") for (int m = 0; m < 4; ++m) _Pragma("unroll") for (int k = 0; k < 2; ++k) dst[m][k] = *(const LAS bf16x8*)(lds + PG8_SA(b, h) + aoff + m * 2048 + k * 1024); } while (0)
#define PG8_LDB(dst, b, h) do { _Pragma("unroll") for (int n = 0; n < 2; ++n) _Pragma("unroll") for (int k = 0; k < 2; ++k) dst[n][k] = *(const LAS bf16x8*)(lds + PG8_SB(b, h) + boff + n * 2048 + k * 1024); } while (0)
#define PG8_MMA(ai, bj, At, Bt) do { __builtin_amdgcn_s_setprio(1); _Pragma("unroll") for (int m = 0; m < 4; ++m) _Pragma("unroll") for (int n = 0; n < 2; ++n) _Pragma("unroll") for (int k = 0; k < 2; ++k) \
        acc[ai][bj][m][n] = __builtin_amdgcn_mfma_f32_16x16x32_bf16(Bt[n][k], At[m][k], acc[ai][bj][m][n], 0, 0, 0); __builtin_amdgcn_s_setprio(0); } while (0)
#define PG8_WAIT_V(n) asm volatile("s_waitcnt vmcnt(" #n ")" ::: "memory")
#define PG8_WAIT_L(n) asm volatile("s_waitcnt lgkmcnt(" #n ")" ::: "memory")
#define PG8_BAR __builtin_amdgcn_s_barrier()
#define PG8_SCHED __builtin_amdgcn_sched_barrier(0)
#define PG8_TRIP(A1, A2, B2, V2) do { const char* a3_ = (A2) + kstep; const char* b3_ = (B2) + kstep; \
        PG8_LDB(B0, 0, 0); PG8_LDB(B1, 0, 1); PG8_SCHED; PG8_LDA(At, 0, 0); PG8_STGA(PG8_SA(1, 1), A1, 1, cv); \
        PG8_WAIT_V(8); PG8_WAIT_L(0); PG8_BAR; PG8_MMA(0, 0, At, B0); PG8_MMA(0, 1, At, B1); PG8_BAR; PG8_SCHED; \
        PG8_LDA(At, 0, 1); PG8_STGB(PG8_SB(0, 0), B2); PG8_STGB(PG8_SB(0, 1), (B2) + hstep); PG8_STGA(PG8_SA(0, 0), A2, 0, V2); \
        PG8_WAIT_V(8); PG8_WAIT_L(0); PG8_BAR; PG8_MMA(1, 0, At, B0); PG8_MMA(1, 1, At, B1); PG8_BAR; PG8_SCHED; \
        PG8_LDB(B0, 1, 0); PG8_LDB(B1, 1, 1); PG8_SCHED; PG8_LDA(At, 1, 0); PG8_STGA(PG8_SA(0, 1), A2, 1, V2); \
        PG8_WAIT_V(8); PG8_WAIT_L(0); PG8_BAR; PG8_MMA(0, 0, At, B0); PG8_MMA(0, 1, At, B1); PG8_BAR; PG8_SCHED; \
        PG8_LDA(At, 1, 1); PG8_STGB(PG8_SB(1, 0), b3_); PG8_STGB(PG8_SB(1, 1), b3_ + hstep); PG8_STGA(PG8_SA(1, 0), a3_, 0, V2); \
        PG8_WAIT_V(8); PG8_WAIT_L(0); PG8_BAR; PG8_MMA(1, 0, At, B0); PG8_MMA(1, 1, At, B1); PG8_BAR; PG8_SCHED; } while (0)
#define PG8_OFFS(u, v) do { if constexpr (GATHER) { const int* sr_ = S.srow + (u).pm * 256; int t0_ = sr_[R0], t1_ = sr_[R1], t2_ = sr_[128 + R0], t3_ = sr_[128 + R1]; \
        t0_ = t0_ < 0 ? 0 : (t0_ >> 1); t1_ = t1_ < 0 ? 0 : (t1_ >> 1); t2_ = t2_ < 0 ? 0 : (t2_ >> 1); t3_ = t3_ < 0 ? 0 : (t3_ >> 1); \
        (v)[0] = (unsigned)(t0_ * K + C0) * 2u; (v)[1] = (unsigned)(t1_ * K + C1) * 2u; (v)[2] = (unsigned)(t2_ * K + C0) * 2u; (v)[3] = (unsigned)(t3_ * K + C1) * 2u; } } while (0)
    Unit cur, nxt; int ui = 0;
    if (!S.next(0, cur)) return;
    f32x4 acc[2][2][4][2];
#pragma unroll
    for (int a = 0; a < 2; ++a)
#pragma unroll
        for (int b = 0; b < 2; ++b)
#pragma unroll
            for (int m = 0; m < 4; ++m)
#pragma unroll
                for (int n = 0; n < 2; ++n) acc[a][b][m][n] = (f32x4){0.f, 0.f, 0.f, 0.f};
    bf16x8 At[4][2], B0[2][2], B1[2][2];
    if constexpr (GATHER) { PG8_OFFS(cur, cv); }
    else { cv[0] = (unsigned)(R0 * K + C0) * 2u; cv[1] = (unsigned)(R1 * K + C1) * 2u; cv[2] = 0u; cv[3] = 0u; }
    const char* cA = cur.a; const char* cB = cur.b;
    PG8_STGB(PG8_SB(0, 0), cB); PG8_STGB(PG8_SB(0, 1), cB + hstep); PG8_STGA(PG8_SA(0, 0), cA, 0, cv); PG8_STGA(PG8_SA(0, 1), cA, 1, cv);
    if (wr == 1) PG8_BAR;
    PG8_WAIT_V(2); PG8_BAR;
    PG8_STGB(PG8_SB(1, 0), cB + kstep); PG8_STGA(PG8_SA(1, 0), cA + kstep, 0, cv); PG8_STGB(PG8_SB(1, 1), cB + hstep + kstep);
    PG8_WAIT_V(6); PG8_BAR;
    for (;;) {
        const bool has_next = S.next(ui + 1, nxt);
        const char* nA = has_next ? nxt.a : cA; const char* nB = has_next ? nxt.b : cB;
        if constexpr (GATHER) { if (has_next) { PG8_OFFS(nxt, nv); } else { nv[0] = cv[0]; nv[1] = cv[1]; nv[2] = cv[2]; nv[3] = cv[3]; } }
        for (int t = 0; t < nt - 2; t += 2) { const char* a1 = cA + (size_t)(t + 1) * kstep; const char* a2 = cA + (size_t)(t + 2) * kstep; const char* b2 = cB + (size_t)(t + 2) * kstep; PG8_TRIP(a1, a2, b2, cv); }
        { const char* a1 = cA + (size_t)(nt - 1) * kstep; if constexpr (GATHER) { PG8_TRIP(a1, nA, nB, nv); } else { PG8_TRIP(a1, nA, nB, cv); } }
        if (wr == 0) PG8_BAR;
        E(acc, cur, wr, wc, fr, fq);
        if (!has_next) break;
#pragma unroll
        for (int a = 0; a < 2; ++a)
#pragma unroll
            for (int b = 0; b < 2; ++b)
#pragma unroll
                for (int m = 0; m < 4; ++m)
#pragma unroll
                    for (int n = 0; n < 2; ++n) acc[a][b][m][n] = (f32x4){0.f, 0.f, 0.f, 0.f};
        cur = nxt; cA = nA; cB = nB; ++ui;
        if constexpr (GATHER) { cv[0] = nv[0]; cv[1] = nv[1]; cv[2] = nv[2]; cv[3] = nv[3]; }
        if (wr == 1) PG8_BAR;
    }
    PG8_WAIT_V(0);
    PG8_BAR;
#undef PG8_SA
#undef PG8_SB
#undef PG8_STG
#undef PG8_STGB
#undef PG8_STGA
#undef PG8_LDA
#undef PG8_LDB
#undef PG8_MMA
#undef PG8_WAIT_V
#undef PG8_WAIT_L
#undef PG8_BAR
#undef PG8_SCHED
#undef PG8_TRIP
#undef PG8_OFFS
}

__device__ __forceinline__ u32x4 pack8(const f32x4 v0, const f32x4 v1) { u32x4 w; w.x = cvt_pk_bf16(v0[0], v0[1]); w.y = cvt_pk_bf16(v0[2], v0[3]); w.z = cvt_pk_bf16(v1[0], v1[1]); w.w = cvt_pk_bf16(v1[2], v1[3]); return w; }
struct EpiBf16 {
    bf16* O; int ldc;
    __device__ __forceinline__ void operator()(const f32x4 (&acc)[2][2][4][2], const Unit& u, int wr, int wc, int fr, int fq) const {
        const int row0 = u.pm * BM + wr * 64 + fr, col0 = u.pn * BM + wc * 32 + 8 * fq;
#pragma unroll
        for (int ai = 0; ai < 2; ++ai)
#pragma unroll
            for (int m = 0; m < 4; ++m) { bf16* rowp = O + (size_t)(row0 + ai * HALF + m * 16) * ldc + col0;
#pragma unroll
                for (int bj = 0; bj < 2; ++bj) *(u32x4*)(rowp + bj * HALF) = pack8(acc[ai][bj][m][0], acc[ai][bj][m][1]); }
    }
};
struct EpiConv1 {
    bf16* BG; bf16* Z;
    __device__ __forceinline__ void operator()(const f32x4 (&acc)[2][2][4][2], const Unit& u, int wr, int wc, int fr, int fq) const {
        const int row0 = u.pm * BM + wr * 64 + fr;
        if (u.pn < 8) {
            const int col0 = u.pn * BM + wc * 32 + 8 * fq;
#pragma unroll
            for (int ai = 0; ai < 2; ++ai)
#pragma unroll
                for (int m = 0; m < 4; ++m) { bf16* rowp = BG + (size_t)(row0 + ai * HALF + m * 16) * D + col0;
#pragma unroll
                    for (int bj = 0; bj < 2; ++bj) *(u32x4*)(rowp + bj * HALF) = pack8(acc[ai][bj][m][0], acc[ai][bj][m][1]); }
        } else {
            const int col0 = (u.pn - 8) * HALF + wc * 32 + 8 * fq;
#pragma unroll
            for (int ai = 0; ai < 2; ++ai)
#pragma unroll
                for (int m = 0; m < 4; ++m) { bf16* rowp = Z + (size_t)(row0 + ai * HALF + m * 16) * D + col0;
                    *(u32x4*)rowp = pack8(acc[ai][0][m][0] * acc[ai][1][m][0], acc[ai][0][m][1] * acc[ai][1][m][1]); }
        }
    }
};
struct EpiMlIn {
    bf16* O; float* gates;
    __device__ __forceinline__ void operator()(const f32x4 (&acc)[2][2][4][2], const Unit& u, int wr, int wc, int fr, int fq) const {
        const int row0 = u.pm * BM + wr * 64 + fr;
        if (u.pn < 24) {
            const int col0 = u.pn * BM + wc * 32 + 8 * fq;
#pragma unroll
            for (int ai = 0; ai < 2; ++ai)
#pragma unroll
                for (int m = 0; m < 4; ++m) { bf16* rowp = O + (size_t)(row0 + ai * HALF + m * 16) * MLW + col0;
#pragma unroll
                    for (int bj = 0; bj < 2; ++bj) *(u32x4*)(rowp + bj * HALF) = pack8(acc[ai][bj][m][0], acc[ai][bj][m][1]); }
        } else if (wc == 0) {
#pragma unroll
            for (int ai = 0; ai < 2; ++ai)
#pragma unroll
                for (int m = 0; m < 4; ++m) { float* rowp = gates + (size_t)(row0 + ai * HALF + m * 16) * 32 + 8 * fq;
                    *(f32x4*)rowp = acc[ai][0][m][0]; *(f32x4*)(rowp + 4) = acc[ai][0][m][1]; }
        }
    }
};
__device__ __forceinline__ float silu_f(float g) { return g * __builtin_amdgcn_rcpf(1.0f + __expf(-g)); }
struct EpiMoe1 {
    bf16* H;
    __device__ __forceinline__ void operator()(const f32x4 (&acc)[2][2][4][2], const Unit& u, int wr, int wc, int fr, int fq) const {
        const int row0 = u.pm * BM + wr * 64 + fr, col0 = u.pn * HALF + wc * 32 + 8 * fq;
#pragma unroll
        for (int ai = 0; ai < 2; ++ai)
#pragma unroll
            for (int m = 0; m < 4; ++m) { bf16* rowp = H + (size_t)(row0 + ai * HALF + m * 16) * DE + col0; f32x4 h0, h1;
#pragma unroll
                for (int j = 0; j < 4; ++j) { h0[j] = silu_f(acc[ai][0][m][0][j]) * acc[ai][1][m][0][j]; h1[j] = silu_f(acc[ai][0][m][1][j]) * acc[ai][1][m][1][j]; }
                *(u32x4*)rowp = pack8(h0, h1); }
    }
};
struct EpiMoe2 {
    bf16* EX; const int* srow; const float* swt;
    __device__ __forceinline__ void operator()(const f32x4 (&acc)[2][2][4][2], const Unit& u, int wr, int wc, int fr, int fq) const {
        const int row0 = u.pm * BM + wr * 64 + fr, col0 = u.pn * BM + wc * 32 + 8 * fq;
#pragma unroll
        for (int ai = 0; ai < 2; ++ai)
#pragma unroll
            for (int m = 0; m < 4; ++m) { const int r = row0 + ai * HALF + m * 16; const int ent = srow[r]; const float w = swt[r];
                if (ent >= 0) { bf16* rowp = EX + ((size_t)(ent & 1) * NTOK + (size_t)(ent >> 1)) * D + col0;
#pragma unroll
                    for (int bj = 0; bj < 2; ++bj) *(u32x4*)(rowp + bj * HALF) = pack8(acc[ai][bj][m][0] * w, acc[ai][bj][m][1] * w); } }
    }
};
}

struct Args { const float* in[21]; float* out; unsigned char* ws; int ph_lo, ph_hi; };
struct Frame {
    LAS unsigned char* lds;
    int G, bid, wave0;
    const float* in[21]; float* out; unsigned char* ws;
};
enum { I_X = 0, I_C, I_CTX, I_CCTX, I_WADA, I_BADA, I_LNG, I_LNB, I_CWIN, I_CW, I_CWOUT, I_MWIN, I_MWG, I_MBG, I_MNG, I_MWOUT, I_RW, I_RB, I_EWG, I_EWU, I_EWD };

#define PHASE_IDS() int lane_ = (int)__builtin_amdgcn_mbcnt_hi(~0u, __builtin_amdgcn_mbcnt_lo(~0u, 0u)); asm volatile("" : "+v"(lane_)); const int lane = lane_; const int wave = F.wave0; const int tid = wave * 64 + lane; (void)tid
__device__ __forceinline__ int mod_row(int trow) { return trow < NLAT ? (trow >> 12) : 4; }
__device__ __forceinline__ const float* mod_vec(const Frame& F, int layer, int r, int j) { return (const float*)(F.ws + WS_MOD) + ((size_t)(layer * 5 + r) * 6 + j) * D; }

__device__ __forceinline__ void cvt_tile(const float* src, size_t src_pitch, bf16* dst, size_t dst_pitch, float scale, LAS float* scr, int lane) {
#pragma unroll 8
    for (int i = 0; i < 64; ++i) scr[i * 65 + lane] = src[(size_t)i * src_pitch + lane];
    LDS_WAIT(); asm volatile("" ::: "memory");
    const int c = lane & 7;
#pragma unroll
    for (int j = 0; j < 8; ++j) { const int n = (lane >> 3) + 8 * j; const LAS float* s = scr + (8 * c) * 65 + n;
        u32x4 o; o.x = cvt_pk_bf16(s[0] * scale, s[65] * scale); o.y = cvt_pk_bf16(s[2 * 65] * scale, s[3 * 65] * scale); o.z = cvt_pk_bf16(s[4 * 65] * scale, s[5 * 65] * scale); o.w = cvt_pk_bf16(s[6 * 65] * scale, s[7 * 65] * scale);
        *(u32x4*)(dst + (size_t)n * dst_pitch + 8 * c) = o; }
    LDS_WAIT(); asm volatile("" ::: "memory");
}
__device__ __forceinline__ void gemv_item(Frame& F, int l, int chunk, int tid, int lane, int wave) {
    LAS float* sc = (LAS float*)F.lds;
    LAS float* red = (LAS float*)(F.lds + 40960);
    for (int idx = tid; idx < 5 * D; idx += NTHR) { const int r = idx / D, k = idx % D; const float cv = r < 4 ? F.in[I_C][r * D + k] : F.in[I_CCTX][k]; sc[idx] = cv / (1.0f + expf(-cv)); }
    __syncthreads();
    float* mod = (float*)(F.ws + WS_MOD);
    const int n0 = chunk * 32, col = lane & 31, kp = lane >> 5, kbase = wave * 256;
    const float* W = F.in[I_WADA] + (size_t)l * D * 12288 + n0 + col;
    float acc[5] = {0.f, 0.f, 0.f, 0.f, 0.f};
    for (int kk = 0; kk < 128; kk += 8) {
        float wv[8];
#pragma unroll
        for (int u = 0; u < 8; ++u) wv[u] = W[(size_t)(kbase + 2 * (kk + u) + kp) * 12288];
#pragma unroll
        for (int u = 0; u < 8; ++u) { const int k = kbase + 2 * (kk + u) + kp;
#pragma unroll
            for (int r = 0; r < 5; ++r) acc[r] += sc[r * D + k] * wv[u]; }
    }
#pragma unroll
    for (int r = 0; r < 5; ++r) { acc[r] += __shfl_xor(acc[r], 32); if (lane < 32) red[(wave * 5 + r) * 32 + lane] = acc[r]; }
    __syncthreads();
    if (tid < 160) { const int r = tid >> 5, cc = tid & 31; float s = 0.f;
#pragma unroll
        for (int w = 0; w < 8; ++w) s += red[(w * 5 + r) * 32 + cc];
        mod[(size_t)(l * 5 + r) * 12288 + n0 + cc] = s + F.in[I_BADA][l * 12288 + n0 + cc]; }
    __syncthreads();
}
__device__ __forceinline__ void conv_tile(Frame& F, int t, LAS float* scr, int lane) {
    if (t < 3072) { const int kb = t / 96, n0 = (t % 96) * 64; int dr; if (n0 < 2048) dr = n0; else if (n0 < 4096) { const int q = n0 - 2048; dr = 2048 + (q >> 7) * 256 + (q & 127); } else { const int q = n0 - 4096; dr = 2048 + (q >> 7) * 256 + 128 + (q & 127); }
        cvt_tile(F.in[I_CWIN] + (size_t)kb * 64 * 6144 + n0, 6144, (bf16*)(F.ws + WS_WT_CIN) + (size_t)dr * D + kb * 64, D, 1.f, scr, lane); }
    else { t -= 3072; const int kb = t / 32, n0 = (t % 32) * 64;
        cvt_tile(F.in[I_CWOUT] + (size_t)kb * 64 * D + n0, D, (bf16*)(F.ws + WS_WT_COUT) + (size_t)n0 * D + kb * 64, D, 1.f, scr, lane); }
}
__device__ __forceinline__ void ml_tile(Frame& F, int t, LAS float* scr, int lane) {
    const float QS = 0.08838834764831845f;
    if (t < 3072) { const int kb = t / 96, n0 = (t % 96) * 64;
        cvt_tile(F.in[I_MWIN] + (size_t)kb * 64 * MLW + n0, MLW, (bf16*)(F.ws + WS_WT_MIN) + (size_t)n0 * D + kb * 64, D, n0 < 1024 ? QS : 1.f, scr, lane); }
    else { t -= 3072; const int kb = t / 32, n0 = (t % 32) * 64;
        cvt_tile(F.in[I_MWOUT] + (size_t)kb * 64 * D + n0, D, (bf16*)(F.ws + WS_WT_MOUT) + (size_t)n0 * D + kb * 64, D, 1.f, scr, lane); }
}
__device__ __forceinline__ void exp_tile(Frame& F, int l, int t, LAS float* scr, int lane) {
    if (t < 16384) { const int up = t >= 8192; if (up) t -= 8192; const int le = l * NE + t / 512, q = t % 512, kb = q / 16, n0 = (q % 16) * 64;
        const float* src = (up ? F.in[I_EWU] : F.in[I_EWG]) + (size_t)le * D * DE + (size_t)kb * 64 * DE + n0;
        const int dr = (n0 >> 7) * 256 + (up ? 128 : 0) + (n0 & 127);
        cvt_tile(src, DE, (bf16*)(F.ws + WS_WT_E1) + (size_t)le * D * D + (size_t)dr * D + kb * 64, D, 1.f, scr, lane); }
    else { t -= 16384; const int le = l * NE + t / 512, q = t % 512, kb = q / 32, n0 = (q % 32) * 64;
        cvt_tile(F.in[I_EWD] + (size_t)le * DE * D + (size_t)kb * 64 * D + n0, D, (bf16*)(F.ws + WS_WT_E2) + (size_t)le * D * DE + (size_t)n0 * DE + kb * 64, DE, 1.f, scr, lane); }
}
constexpr int Q_E0 = 3072, Q_GV1 = Q_E0 + 384, Q_ML = Q_GV1 + 512, Q_END = Q_ML + 3072;
constexpr int CW_QHEAD = 8192;
__device__ __forceinline__ void bg_item(Frame& F, int it, int tid, int lane, int wave) {
    LAS float* scr = (LAS float*)(F.lds + wave * 16640);
    if (it < Q_E0) exp_tile(F, 0, it * 8 + wave, scr, lane);
    else if (it < Q_GV1) gemv_item(F, 1, it - Q_E0, tid, lane, wave);
    else if (it < Q_ML) ml_tile(F, (it - Q_GV1) * 8 + wave, scr, lane);
    else exp_tile(F, 1, (it - Q_ML) * 8 + wave, scr, lane);
}
__device__ __forceinline__ void bg_pull(Frame& F, int floor, int phase, unsigned target) {
    PHASE_IDS();
    unsigned* ctl = (unsigned*)(F.ws + WS_CTL);
    LAS unsigned* bc = (LAS unsigned*)(F.lds + LDS_MISC + 128);
    unsigned nxt = 0xffffffffu;
#define BG_CLAIM() do { nxt = 0xffffffffu; \
        if (__hip_atomic_load(ctl + CW_QHEAD + 64 * (1 + phase), __ATOMIC_RELAXED, __HIP_MEMORY_SCOPE_AGENT) < target) { \
            nxt = __hip_atomic_fetch_add(ctl + CW_QHEAD, 1u, __ATOMIC_RELAXED, __HIP_MEMORY_SCOPE_AGENT); if (nxt >= (unsigned)Q_END) nxt = 0xffffffffu; } } while (0)
    if (tid == 0) { if (floor > 0) __hip_atomic_fetch_max(ctl + CW_QHEAD, (unsigned)floor, __ATOMIC_RELAXED, __HIP_MEMORY_SCOPE_AGENT); BG_CLAIM(); }
    for (;;) {
        __syncthreads();
        if (tid == 0) *bc = nxt;
        __syncthreads();
        const unsigned it = *bc;
        if (it == 0xffffffffu) break;
        if (tid == 0) BG_CLAIM();
        bg_item(F, (int)it, tid, lane, wave);
    }
#undef BG_CLAIM
}
__device__ __forceinline__ void bg_drain(Frame& F, int limit) {
    PHASE_IDS();
    const int h = (int)__hip_atomic_load((unsigned*)(F.ws + WS_CTL) + CW_QHEAD, __ATOMIC_RELAXED, __HIP_MEMORY_SCOPE_AGENT);
    if (h >= limit) return;
    LAS float* scr = (LAS float*)(F.lds + wave * 16640);
    const int gw = F.bid * NWAVES + wave, NGW = F.G * NWAVES;
    __syncthreads();
    { const int lo = h, hi = limit < Q_E0 ? limit : Q_E0; for (int t = lo * 8 + gw; t < hi * 8; t += NGW) exp_tile(F, 0, t, scr, lane); }
    { const int lo = h > Q_GV1 ? h : Q_GV1, hi = limit < Q_ML ? limit : Q_ML; for (int t = (lo - Q_GV1) * 8 + gw; t < (hi - Q_GV1) * 8; t += NGW) ml_tile(F, t, scr, lane); }
    { const int lo = h > Q_ML ? h : Q_ML, hi = limit < Q_END ? limit : Q_END; for (int t = (lo - Q_ML) * 8 + gw; t < (hi - Q_ML) * 8; t += NGW) exp_tile(F, 1, t, scr, lane); }
    __syncthreads();
    { const int lo = h > Q_E0 ? h : Q_E0, hi = limit < Q_GV1 ? limit : Q_GV1; for (int it = lo + F.bid; it < hi; it += F.G) gemv_item(F, 1, it - Q_E0, tid, lane, wave); }
}
__device__ __forceinline__ void bg_signal_done(Frame& F, int phase) {
    if (threadIdx.x == 0) __hip_atomic_fetch_add((unsigned*)(F.ws + WS_CTL) + CW_QHEAD + 64 * (1 + phase), 1u, __ATOMIC_RELAXED, __HIP_MEMORY_SCOPE_AGENT);
}
__device__ __forceinline__ void p0_prologue(Frame& F) {
    PHASE_IDS();
    for (int it = F.bid; it < 384; it += F.G) gemv_item(F, 0, it, tid, lane, wave);
    LAS float* scr = (LAS float*)(F.lds + wave * 16640);
    const int gw = F.bid * NWAVES + wave, NGW = F.G * NWAVES;
    for (int t = gw; t < 4096; t += NGW) conv_tile(F, t, scr, lane);
    { bf16* wt = (bf16*)(F.ws + WS_WT_MIN) + (size_t)MLW * D; const float* wg = F.in[I_MWG];
      for (int idx = F.bid * NTHR + tid; idx < 256 * D; idx += F.G * NTHR) { const int n = idx / D, k = idx % D; const float v = n < 32 ? wg[k * 32 + n] : 0.f; wt[idx] = (bf16)(cvt_pk_bf16(v, 0.f) & 0xffffu); } }
}

#define SCHED_FENCE() __builtin_amdgcn_sched_barrier(0)
__device__ __forceinline__ void p1_modulate(Frame& F) {
    PHASE_IDS();
    const int gw = F.bid * NWAVES + wave;
    bf16* HA = (bf16*)(F.ws + WS_HA);
    f32x4 a[8], b[8], x[8], xn[8];
    { const int r = (8 * gw) >> 12; const float* sh = mod_vec(F, 0, r, 0); const float* scv = mod_vec(F, 0, r, 1);
#pragma unroll
      for (int j = 0; j < 8; ++j) { const int c = 256 * j + 4 * lane; a[j] = *(const f32x4*)(scv + c) + 1.0f; b[j] = *(const f32x4*)(sh + c); xn[j] = *(const f32x4*)(F.in[I_X] + (size_t)(8 * gw) * D + c); } }
    for (int i = 0; i < 8; ++i) { const int row = 8 * gw + i;
#pragma unroll
        for (int j = 0; j < 8; ++j) x[j] = xn[j];
        if (i < 7) {
#pragma unroll
            for (int j = 0; j < 8; ++j) xn[j] = *(const f32x4*)(F.in[I_X] + (size_t)(row + 1) * D + 256 * j + 4 * lane); }
        SCHED_FENCE();
#pragma unroll
        for (int j = 0; j < 8; ++j) { const f32x4 h = x[j] * a[j] + b[j]; u32x2 o; o.x = cvt_pk_bf16(h[0], h[1]); o.y = cvt_pk_bf16(h[2], h[3]); *(u32x2*)(HA + (size_t)row * D + 256 * j + 4 * lane) = o; }
    }
    if (gw < NCTX) { const float* sh = mod_vec(F, 0, 4, 0); const float* scv = mod_vec(F, 0, 4, 1);
#pragma unroll
        for (int j = 0; j < 8; ++j) { const int c = 256 * j + 4 * lane; a[j] = *(const f32x4*)(scv + c) + 1.0f; b[j] = *(const f32x4*)(sh + c); x[j] = *(const f32x4*)(F.in[I_CTX] + (size_t)gw * D + c); }
        SCHED_FENCE();
#pragma unroll
        for (int j = 0; j < 8; ++j) { const f32x4 h = x[j] * a[j] + b[j]; u32x2 o; o.x = cvt_pk_bf16(h[0], h[1]); o.y = cvt_pk_bf16(h[2], h[3]); *(u32x2*)(HA + (size_t)(NLAT + gw) * D + 256 * j + 4 * lane) = o; } }
}

__device__ __forceinline__ void p3_conv(Frame& F) {
    PHASE_IDS();
    const int gw = F.bid * NWAVES + wave, NGW = F.G * NWAVES;
    const bf16* BG = (const bf16*)(F.ws + WS_RB); const bf16* Z = (const bf16*)(F.ws + WS_RC); bf16* U = (bf16*)(F.ws + WS_HA);
    const float* cw = F.in[I_CW];
    f32x4 wt[4][3][2];
#pragma unroll
    for (int j = 0; j < 4; ++j)
#pragma unroll
        for (int t = 0; t < 3; ++t) { wt[j][t][0] = *(const f32x4*)(cw + t * D + 512 * j + 8 * lane); wt[j][t][1] = *(const f32x4*)(cw + t * D + 512 * j + 8 * lane + 4); }
    for (int row = gw; row < NTOK; row += NGW) {
        u32x4 zc[4], bg[4], zp[4], zn[4];
        int dpa, dna, dpb, dnb; bool vpa, vna, vpb, vnb;
        if (row < NLAT) { const int s = row & (SEQ - 1), gc = s & 63, gr = s >> 6; vpa = gc > 0; vna = gc < 63; dpa = -1; dna = 1; vpb = gr > 0; vnb = gr < 63; dpb = -64; dnb = 64; }
        else { const int t = (row - NLAT) & (CTXL - 1); vpa = vpb = t > 0; vna = vnb = t < CTXL - 1; dpa = dpb = -1; dna = dnb = 1; }
#pragma unroll
        for (int j = 0; j < 4; ++j) { const int c = 512 * j + 8 * lane; const bool vp = j < 2 ? vpa : vpb, vn = j < 2 ? vna : vnb; const int dp = j < 2 ? dpa : dpb, dn = j < 2 ? dna : dnb;
            zc[j] = *(const u32x4*)(Z + (size_t)row * D + c); bg[j] = *(const u32x4*)(BG + (size_t)row * D + c);
            zp[j] = *(const u32x4*)(Z + (size_t)(vp ? row + dp : row) * D + c); zn[j] = *(const u32x4*)(Z + (size_t)(vn ? row + dn : row) * D + c);
            if (!vp) zp[j] = (u32x4){0u, 0u, 0u, 0u}; if (!vn) zn[j] = (u32x4){0u, 0u, 0u, 0u}; }
        SCHED_FENCE();
#pragma unroll
        for (int j = 0; j < 4; ++j) { float o[8];
#pragma unroll
            for (int q = 0; q < 4; ++q) {
                const float w0l = wt[j][0][q >> 1][2 * (q & 1)], w0h = wt[j][0][q >> 1][2 * (q & 1) + 1], w1l = wt[j][1][q >> 1][2 * (q & 1)], w1h = wt[j][1][q >> 1][2 * (q & 1) + 1], w2l = wt[j][2][q >> 1][2 * (q & 1)], w2h = wt[j][2][q >> 1][2 * (q & 1) + 1];
                o[2 * q] = bf_lo(bg[j][q]) * (w0l * bf_lo(zp[j][q]) + w1l * bf_lo(zc[j][q]) + w2l * bf_lo(zn[j][q]));
                o[2 * q + 1] = bf_hi(bg[j][q]) * (w0h * bf_hi(zp[j][q]) + w1h * bf_hi(zc[j][q]) + w2h * bf_hi(zn[j][q])); }
            u32x4 w; w.x = cvt_pk_bf16(o[0], o[1]); w.y = cvt_pk_bf16(o[2], o[3]); w.z = cvt_pk_bf16(o[4], o[5]); w.w = cvt_pk_bf16(o[6], o[7]);
            *(u32x4*)(U + (size_t)row * D + 512 * j + 8 * lane) = w; }
    }
}

__device__ __forceinline__ void lnB_phase(Frame& F, int layer) {
    PHASE_IDS();
    const int nrows = layer == 0 ? 68 : 64;
    const float* lg = F.in[I_LNG] + (layer * 2 + 1) * D; const float* lb = F.in[I_LNB] + (layer * 2 + 1) * D;
    const bf16* EX = (const bf16*)(F.ws + WS_REX);
#define LNB_ROW(li) ((li) < 64 ? F.bid * 64 + (li) : NLAT + F.bid * 4 + ((li) - 64))
#define LNB_XP(li) ((li) < 64 ? F.out + (size_t)(F.bid * 64 + (li)) * D : (float*)(F.ws + WS_CTXRES) + (size_t)(F.bid * 4 + ((li) - 64)) * D)
#define LNB_LOAD(li, X, E0, E1) do { const float* xp_ = LNB_XP(li); const bf16* ep_ = EX + (size_t)LNB_ROW(li) * D; \
        _Pragma("unroll") for (int j = 0; j < 8; ++j) { X[j] = *(const f32x4*)(xp_ + 256 * j + 4 * lane); E0[j] = *(const u32x2*)(ep_ + 256 * j + 4 * lane); E1[j] = *(const u32x2*)(ep_ + (size_t)NTOK * D + 256 * j + 4 * lane); } } while (0)
    f32x4 xn_[8]; u32x2 e0_[8], e1_[8];
    if (wave < nrows) LNB_LOAD(wave, xn_, e0_, e1_);
    for (int li = wave; li < nrows; li += NWAVES) {
        const int row = LNB_ROW(li); const int mr = mod_row(row);
        float* xout = LNB_XP(li);
        const float* gv = mod_vec(F, layer, mr, 5);
        f32x4 v[8]; float s = 0.f;
#pragma unroll
        for (int j = 0; j < 8; ++j) { const f32x4 g = *(const f32x4*)(gv + 256 * j + 4 * lane);
            const f32x4 m = (f32x4){bf_lo(e0_[j].x) + bf_lo(e1_[j].x), bf_hi(e0_[j].x) + bf_hi(e1_[j].x), bf_lo(e0_[j].y) + bf_lo(e1_[j].y), bf_hi(e0_[j].y) + bf_hi(e1_[j].y)};
            v[j] = xn_[j] * ALPHA + g * m; s += (v[j][0] + v[j][1]) + (v[j][2] + v[j][3]); }
        if (li + NWAVES < nrows) LNB_LOAD(li + NWAVES, xn_, e0_, e1_);
        f32x4 L[8], B[8];
#pragma unroll
        for (int j = 0; j < 8; ++j) { const int c = 256 * j + 4 * lane; L[j] = *(const f32x4*)(lg + c); B[j] = *(const f32x4*)(lb + c); }
        SCHED_FENCE();
        const float mean = wave_sum(s) * (1.f / D); float s2 = 0.f;
#pragma unroll
        for (int j = 0; j < 8; ++j) { v[j] = v[j] - mean; s2 += (v[j][0] * v[j][0] + v[j][1] * v[j][1]) + (v[j][2] * v[j][2] + v[j][3] * v[j][3]); }
        const float rstd = 1.0f / sqrtf(wave_sum(s2) * (1.f / D) + LN_EPS);
#pragma unroll
        for (int j = 0; j < 8; ++j) { const int c = 256 * j + 4 * lane; v[j] = v[j] * rstd * L[j] + B[j]; *(f32x4*)(xout + c) = v[j]; }
        if (layer == 0) {
            const float* sh = mod_vec(F, 1, mr, 0); const float* scv = mod_vec(F, 1, mr, 1);
#pragma unroll
            for (int j = 0; j < 8; ++j) { const int c = 256 * j + 4 * lane; L[j] = *(const f32x4*)(scv + c); B[j] = *(const f32x4*)(sh + c); }
            SCHED_FENCE();
            bf16* HA = (bf16*)(F.ws + WS_HA) + (size_t)row * D;
#pragma unroll
            for (int j = 0; j < 8; ++j) { const int c = 256 * j + 4 * lane; const f32x4 h = v[j] * (L[j] + 1.0f) + B[j]; u32x2 o; o.x = cvt_pk_bf16(h[0], h[1]); o.y = cvt_pk_bf16(h[2], h[3]); *(u32x2*)(HA + c) = o; }
        }
    }
#undef LNB_ROW
#undef LNB_XP
#undef LNB_LOAD
}

constexpr int LDS_LOGITS = RING_BYTES;
__device__ __forceinline__ void lnA_phase(Frame& F, int layer) {
    PHASE_IDS();
    LAS float* RwL = (LAS float*)F.lds;
    LAS float* LG = (LAS float*)(F.lds + LDS_LOGITS);
    LAS int* cnt = (LAS int*)(F.lds + LDS_MISC + 64);
    for (int idx = tid; idx < D * 4; idx += NTHR) { const int c = idx >> 2, e4 = (idx & 3) * 4; const f32x4 w = *(const f32x4*)(F.in[I_RW] + c * 16 + e4);
        RwL[(e4 + 0) * D + c] = w[0]; RwL[(e4 + 1) * D + c] = w[1]; RwL[(e4 + 2) * D + c] = w[2]; RwL[(e4 + 3) * D + c] = w[3]; }
    if (tid < 16) cnt[tid] = 0;
    __syncthreads();
    const int nrows = layer == 0 ? 68 : 64;
    const float* lg = F.in[I_LNG] + (layer * 2) * D; const float* lb = F.in[I_LNB] + (layer * 2) * D;
    const bf16* MX = (const bf16*)(F.ws + WS_RB);
#define LNA_ROW(li) ((li) < 64 ? F.bid * 64 + (li) : NLAT + F.bid * 4 + ((li) - 64))
#define LNA_XIN(li) ((li) < 64 ? (layer == 0 ? F.in[I_X] + (size_t)(F.bid * 64 + (li)) * D : F.out + (size_t)(F.bid * 64 + (li)) * D) : F.in[I_CTX] + (size_t)(F.bid * 4 + ((li) - 64)) * D)
#define LNA_LOAD(li, X, M) do { const float* xp_ = LNA_XIN(li); const bf16* mp_ = MX + (size_t)LNA_ROW(li) * D; \
        _Pragma("unroll") for (int j = 0; j < 8; ++j) { X[j] = *(const f32x4*)(xp_ + 256 * j + 4 * lane); M[j] = *(const u32x2*)(mp_ + 256 * j + 4 * lane); } } while (0)
    f32x4 xn_[8]; u32x2 mn_[8];
    if (wave < nrows) LNA_LOAD(wave, xn_, mn_);
    for (int li = wave; li < nrows; li += NWAVES) {
        const int row = LNA_ROW(li); const int mr = mod_row(row);
        float* xout = li < 64 ? F.out + (size_t)row * D : (float*)(F.ws + WS_CTXRES) + (size_t)(row - NLAT) * D;
        const float* gv = mod_vec(F, layer, mr, 2); const float* sh = mod_vec(F, layer, mr, 3); const float* scv = mod_vec(F, layer, mr, 4);
        f32x4 v[8]; float s = 0.f;
#pragma unroll
        for (int j = 0; j < 8; ++j) { const f32x4 g = *(const f32x4*)(gv + 256 * j + 4 * lane); const f32x4 m = (f32x4){bf_lo(mn_[j].x), bf_hi(mn_[j].x), bf_lo(mn_[j].y), bf_hi(mn_[j].y)};
            v[j] = xn_[j] * ALPHA + g * m; s += (v[j][0] + v[j][1]) + (v[j][2] + v[j][3]); }
        if (li + NWAVES < nrows) LNA_LOAD(li + NWAVES, xn_, mn_);
        f32x4 L[8], B[8], S[8], H[8];
#pragma unroll
        for (int j = 0; j < 8; ++j) { const int c = 256 * j + 4 * lane; L[j] = *(const f32x4*)(lg + c); B[j] = *(const f32x4*)(lb + c); S[j] = *(const f32x4*)(scv + c); H[j] = *(const f32x4*)(sh + c); }
        SCHED_FENCE();
        const float mean = wave_sum(s) * (1.f / D); float s2 = 0.f;
#pragma unroll
        for (int j = 0; j < 8; ++j) { v[j] = v[j] - mean; s2 += (v[j][0] * v[j][0] + v[j][1] * v[j][1]) + (v[j][2] * v[j][2] + v[j][3] * v[j][3]); }
        const float rstd = 1.0f / sqrtf(wave_sum(s2) * (1.f / D) + LN_EPS);
        bf16* HA = (bf16*)(F.ws + WS_HA) + (size_t)row * D;
#pragma unroll
        for (int j = 0; j < 8; ++j) { const int c = 256 * j + 4 * lane; v[j] = v[j] * rstd * L[j] + B[j]; *(f32x4*)(xout + c) = v[j];
            v[j] = v[j] * (S[j] + 1.0f) + H[j];
            u32x2 o; o.x = cvt_pk_bf16(v[j][0], v[j][1]); o.y = cvt_pk_bf16(v[j][2], v[j][3]); *(u32x2*)(HA + c) = o; }
        float p[16]; f32x4 wA[8], wB[8];
#pragma unroll
        for (int j = 0; j < 8; ++j) wA[j] = *(const LAS f32x4*)(RwL + 256 * j + 4 * lane);
#pragma unroll
        for (int e = 0; e < 16; ++e) {
            if (e + 1 < 16) {
#pragma unroll
                for (int j = 0; j < 8; ++j) { const f32x4 t = *(const LAS f32x4*)(RwL + (e + 1) * D + 256 * j + 4 * lane); if (e & 1) wA[j] = t; else wB[j] = t; } }
            SCHED_FENCE();
            f32x4 a4 = (f32x4){0.f, 0.f, 0.f, 0.f};
#pragma unroll
            for (int j = 0; j < 8; ++j) a4 += v[j] * ((e & 1) ? wB[j] : wA[j]);
            p[e] = (a4[0] + a4[1]) + (a4[2] + a4[3]);
            SCHED_FENCE();
        }
        float q8[8], q4[4], q2[2], q1;
        { const bool hi = (lane & 32) != 0;
#pragma unroll
          for (int i = 0; i < 8; ++i) { const float keep = hi ? p[8 + i] : p[i], give = hi ? p[i] : p[8 + i]; q8[i] = keep + __shfl_xor(give, 32); } }
        { const bool hi = (lane & 16) != 0;
#pragma unroll
          for (int i = 0; i < 4; ++i) { const float keep = hi ? q8[4 + i] : q8[i], give = hi ? q8[i] : q8[4 + i]; q4[i] = keep + __shfl_xor(give, 16); } }
        { const bool hi = (lane & 8) != 0;
#pragma unroll
          for (int i = 0; i < 2; ++i) { const float keep = hi ? q4[2 + i] : q4[i], give = hi ? q4[i] : q4[2 + i]; q2[i] = keep + __shfl_xor(give, 8); } }
        { const bool hi = (lane & 4) != 0; const float keep = hi ? q2[1] : q2[0], give = hi ? q2[0] : q2[1]; q1 = keep + __shfl_xor(give, 4); }
        q1 += __shfl_xor(q1, 1); q1 += __shfl_xor(q1, 2);
        if ((lane & 3) == 0) LG[li * 16 + (lane >> 2)] = q1;
    }
    __syncthreads();
    if (tid < nrows) {
        const int row = LNA_ROW(tid);
        float sg[16], sel[16];
#pragma unroll
        for (int e4 = 0; e4 < 4; ++e4) { const f32x4 l4 = *(const LAS f32x4*)(LG + tid * 16 + 4 * e4); const f32x4 rb4 = *(const f32x4*)(F.in[I_RB] + 4 * e4);
#pragma unroll
            for (int i = 0; i < 4; ++i) { sg[4 * e4 + i] = 1.0f / (1.0f + expf(-l4[i])); sel[4 * e4 + i] = sg[4 * e4 + i] + rb4[i]; } }
        float grp[4];
#pragma unroll
        for (int g = 0; g < 4; ++g) { const float a = sel[4 * g], b = sel[4 * g + 1], c = sel[4 * g + 2], d = sel[4 * g + 3];
            const float h1 = fmaxf(a, b), l1 = fminf(a, b), h2 = fmaxf(c, d), l2 = fminf(c, d); grp[g] = fmaxf(h1, h2) + fmaxf(fminf(h1, h2), fmaxf(l1, l2)); }
        int gb = 0; float best = grp[0];
#pragma unroll
        for (int g = 1; g < 4; ++g) if (grp[g] > best) { best = grp[g]; gb = g; }
        float cs[4], cg[4];
#pragma unroll
        for (int i = 0; i < 4; ++i) { cs[i] = gb == 0 ? sel[i] : gb == 1 ? sel[4 + i] : gb == 2 ? sel[8 + i] : sel[12 + i]; cg[i] = gb == 0 ? sg[i] : gb == 1 ? sg[4 + i] : gb == 2 ? sg[8 + i] : sg[12 + i]; }
        int i0 = 0; float b0 = cs[0];
#pragma unroll
        for (int i = 1; i < 4; ++i) if (cs[i] > b0) { b0 = cs[i]; i0 = i; }
        int i1 = -1; float b1 = 0.f;
#pragma unroll
        for (int i = 0; i < 4; ++i) if (i != i0 && (i1 < 0 || cs[i] > b1)) { b1 = cs[i]; i1 = i; }
        const float s0 = i0 == 0 ? cg[0] : i0 == 1 ? cg[1] : i0 == 2 ? cg[2] : cg[3], s1 = i1 == 0 ? cg[0] : i1 == 1 ? cg[1] : i1 == 2 ? cg[2] : cg[3];
        const float den = s0 + s1; const int e0 = 4 * gb + i0, e1 = 4 * gb + i1;
        int* rt = (int*)(F.ws + WS_ROUTE) + (size_t)row * 4; rt[0] = e0; rt[1] = e1; ((float*)rt)[2] = s0 / den; ((float*)rt)[3] = s1 / den;
        __hip_atomic_fetch_add(cnt + e0, 1, __ATOMIC_RELAXED, __HIP_MEMORY_SCOPE_WORKGROUP); __hip_atomic_fetch_add(cnt + e1, 1, __ATOMIC_RELAXED, __HIP_MEMORY_SCOPE_WORKGROUP);
    }
    __syncthreads();
    if (tid < 16) ((int*)(F.ws + WS_BLKCNT))[F.bid * 16 + tid] = cnt[tid];
#undef LNA_ROW
#undef LNA_XIN
#undef LNA_LOAD
}

__device__ __forceinline__ void list_phase(Frame& F, int layer) {
    PHASE_IDS();
    LAS int* bc = (LAS int*)F.lds;
    LAS int* base = bc + 4096;
    LAS int* tot = base + 16;
    LAS int* tpre = tot + 16;
    const int* blk = (const int*)(F.ws + WS_BLKCNT);
    for (int idx = tid; idx < 4096; idx += NTHR) bc[idx] = blk[idx];
    __syncthreads();
    if (tid < 16) { int s = 0, b0 = 0; for (int b = 0; b < 256; ++b) { if (b == F.bid) b0 = s; s += bc[b * 16 + tid]; } base[tid] = b0; tot[tid] = s; }
    __syncthreads();
    if (tid == 0) { int t = 0; for (int e = 0; e < 16; ++e) { tpre[e] = t; t += (tot[e] + 255) >> 8; } tpre[16] = t; }
    __syncthreads();
    int* srow = (int*)(F.ws + WS_SROW); float* swt = (float*)(F.ws + WS_SWT);
    if (tid < 16) { const int e = tid; int pos = tpre[e] * 256 + base[e];
        const int nrows = (layer == 0) ? 68 : 64;
        for (int i = 0; i < nrows; ++i) { const int row = i < 64 ? F.bid * 64 + i : NLAT + F.bid * 4 + (i - 64);
            const int* rt = (const int*)(F.ws + WS_ROUTE) + (size_t)row * 4; const int e0 = rt[0], e1 = rt[1];
            if (e0 == e) { srow[pos] = row * 2; swt[pos] = ((const float*)rt)[2]; ++pos; }
            if (e1 == e) { srow[pos] = row * 2 + 1; swt[pos] = ((const float*)rt)[3]; ++pos; } } }
    if (F.bid < 16) { const int e = F.bid, lo = tpre[e] * 256 + tot[e], hi = tpre[e + 1] * 256; for (int p = lo + tid; p < hi; p += NTHR) { srow[p] = -1; swt[p] = 0.f; } }
    if (F.bid == 0) { int* te = (int*)(F.ws + WS_TILEE); for (int t = tid; t < tpre[16]; t += NTHR) { int e = 0; for (int q = 1; q < 16; ++q) if (t >= tpre[q]) e = q; te[t] = e; } if (tid == 0) *(int*)(F.ws + WS_TTOT) = tpre[16]; }
}

__device__ __forceinline__ void moe_gemm1(Frame& F, int layer, int phase) {
    PHASE_IDS();
    LAS int* te = (LAS int*)(F.lds + LDS_TILEE);
    const int T = *(const int*)(F.ws + WS_TTOT);
    for (int t = tid; t < T && t < 160; t += NTHR) te[t] = ((const int*)(F.ws + WS_TILEE))[t];
    __syncthreads();
    pg8::SchedMoe S; S.A = (const char*)(F.ws + WS_HA); S.Bt = (const char*)(F.ws + WS_WT_E1) + (size_t)layer * NE * D * D * 2; S.srow = (const int*)(F.ws + WS_SROW); S.tile_e = te;
    const int rounds = (8 * T + F.G - 1) / F.G, NG = (8 * T + rounds - 1) / rounds;
    S.nM = T; S.nN = 8; S.G = NG; S.c = F.bid; S.tstepA = 0; S.tstepB = (size_t)256 * D * 2; S.estepB = (size_t)D * D * 2;
    if (F.bid < NG) { pg8::EpiMoe1 E{(bf16*)(F.ws + WS_RH)};
        pg8::gemm_phase<pg8::EpiMoe1, pg8::SchedMoe, true>(F.lds, F.wave0, D, S, E); bg_signal_done(F, phase); }
    if (layer == 0) bg_pull(F, Q_GV1, phase, (unsigned)(NG - 8));
}
__device__ __forceinline__ void moe_gemm2(Frame& F, int layer, int phase) {
    PHASE_IDS();
    LAS int* te = (LAS int*)(F.lds + LDS_TILEE);
    const int T = *(const int*)(F.ws + WS_TTOT);
    for (int t = tid; t < T && t < 160; t += NTHR) te[t] = ((const int*)(F.ws + WS_TILEE))[t];
    __syncthreads();
    pg8::SchedMoe S; S.A = (const char*)(F.ws + WS_RH); S.Bt = (const char*)(F.ws + WS_WT_E2) + (size_t)layer * NE * D * DE * 2; S.srow = nullptr; S.tile_e = te;
    const int rounds = (8 * T + F.G - 1) / F.G, NG = (8 * T + rounds - 1) / rounds;
    S.nM = T; S.nN = 8; S.G = NG; S.c = F.bid; S.tstepA = (size_t)256 * DE * 2; S.tstepB = (size_t)256 * DE * 2; S.estepB = (size_t)D * DE * 2;
    if (F.bid < NG) { pg8::EpiMoe2 E{(bf16*)(F.ws + WS_REX), (const int*)(F.ws + WS_SROW), (const float*)(F.ws + WS_SWT)};
        pg8::gemm_phase<pg8::EpiMoe2, pg8::SchedMoe, false>(F.lds, F.wave0, DE, S, E); bg_signal_done(F, phase); }
    if (layer == 0) bg_pull(F, Q_GV1, phase, (unsigned)(NG - 8));
}

constexpr int SC_QS = 0, SC_KS = 17408, SC_VS = 34816, SC_VW = 46080, SC_PS = 57344, SC_CB0 = 66560, SC_CB1 = 88320, SC_GA = 110080;
constexpr int QP = 136, VP = 88, PP = 72;
__device__ __forceinline__ bf16x8 lds_row8(const LAS unsigned char* base, int row, int pitch, int col) { return *(const LAS bf16x8*)(base + (row * pitch + col) * 2); }
typedef short v4i16_t __attribute__((ext_vector_type(4)));
__device__ __forceinline__ bf16x8 lds_tr8(const LAS unsigned char* base, int pitch, int k0, int x0, int lane) {
    const int g = lane >> 4, q = (lane & 15) >> 2, p = lane & 3;
    const LAS unsigned char* a = base + ((k0 + 8 * g + q) * pitch + x0 + 4 * p) * 2;
    const s16x4 lo = __builtin_bit_cast(s16x4, __builtin_amdgcn_ds_read_tr16_b64_v4i16((LAS v4i16_t*)a));
    const s16x4 hi = __builtin_bit_cast(s16x4, __builtin_amdgcn_ds_read_tr16_b64_v4i16((LAS v4i16_t*)(a + 4 * pitch * 2)));
    return (bf16x8){lo[0], lo[1], lo[2], lo[3], hi[0], hi[1], hi[2], hi[3]};
}
constexpr size_t WS_GSCR = 810 * MiB;
__device__ __forceinline__ float fexp(float x) { return __builtin_amdgcn_exp2f(x * 1.44269504088896f); }
__device__ __forceinline__ void scan_phase(Frame& F) {
    PHASE_IDS();
    const int x8 = F.bid & 7, y = F.bid >> 3, vs = y & 3, grp = x8 * 8 + (y >> 2), dir = grp & 1, hh = (grp >> 1) & 7, bb = grp >> 4;
    const int w = wave, i16 = lane & 15, g = lane >> 4;
    const bf16* QKVO = (const bf16*)(F.ws + WS_RC); const float* GT = (const float*)(F.ws + WS_GATES);
    bf16* HOUT = dir == 0 ? (bf16*)(F.ws + WS_RB) : (bf16*)(F.ws + WS_HB2);
    float* GS = (float*)(F.ws + WS_GSCR) + (size_t)F.bid * (68 * 192);
    LAS unsigned char* L = F.lds;
    LAS float* SE = (LAS float*)(L + SC_GA + 2560);
#define SCAN_TOK(step, r) ((step) < 4 ? (NLAT + bb * CTXL + (dir ? (CTXL - 1 - ((step) * 64 + (r))) : ((step) * 64 + (r)))) : (bb * SEQ + (dir ? (SEQ - 1 - (((step) - 4) * 64 + (r))) : (((step) - 4) * 64 + (r)))))
    for (int idx = tid; idx < 64 * 24; idx += NTHR) { const int r = idx / 24, c = 64 + idx % 24; ((LAS bf16*)(L + SC_VS))[r * VP + c] = (c == 64) ? (bf16)0x3F80 : (bf16)0; ((LAS bf16*)(L + SC_VW))[r * VP + c] = 0; }
    { const float big = F.in[I_MBG][(dir * 2) * 8 + hh], bfg = F.in[I_MBG][(dir * 2 + 1) * 8 + hh];
      for (int step = w; step < 68; step += NWAVES) {
        const size_t tg = (size_t)SCAN_TOK(step, lane); const float gi = GT[tg * 32 + (dir * 2) * 8 + hh] + big, gf = GT[tg * 32 + (dir * 2 + 1) * 8 + hh] + bfg;
        const float lf = fminf(gf, 0.f) - log1pf(expf(-fabsf(gf)));
        float bc = lf;
#pragma unroll
        for (int o = 1; o < 64; o <<= 1) { const float t = __shfl_up(bc, o); if (lane >= o) bc += t; }
        const float a = gi - bc; float cm = a;
#pragma unroll
        for (int o = 1; o < 64; o <<= 1) { const float t = __shfl_up(cm, o); if (lane >= o) cm = fmaxf(cm, t); }
        GS[step * 192 + lane] = a; GS[step * 192 + 64 + lane] = bc; GS[step * 192 + 128 + lane] = cm;
        if (lane == 63) { SE[step] = bc; SE[68 + step] = cm; } } }
    __syncthreads();
    if (tid == 0) { float m = 0.f; for (int st = 0; st < 68; ++st) { SE[136 + st] = m; m = SE[st] + fmaxf(m, SE[68 + st]); } }
    f32x4 accc[5];
#pragma unroll
    for (int i = 0; i < 5; ++i) accc[i] = (f32x4){0.f, 0.f, 0.f, 0.f};
    const int qr0 = tid >> 4, qc = (tid & 15) * 8;
    const int vr = tid >> 3, vc = (tid & 7) * 8;
    u32x4 rq0, rq1, rk0, rk1, rv; float ga = 0.f, gb = 0.f, gc = 0.f, av = 0.f;
#define SCAN_LOAD(step) do { const size_t t0_ = (size_t)SCAN_TOK(step, qr0), t1_ = (size_t)SCAN_TOK(step, qr0 + 32), tv_ = (size_t)SCAN_TOK(step, vr); \
        if ((step) >= 4) { rq0 = *(const u32x4*)(QKVO + t0_ * MLW + hh * DQK + qc); rq1 = *(const u32x4*)(QKVO + t1_ * MLW + hh * DQK + qc); } \
        rk0 = *(const u32x4*)(QKVO + t0_ * MLW + 1024 + hh * DQK + qc); rk1 = *(const u32x4*)(QKVO + t1_ * MLW + 1024 + hh * DQK + qc); \
        rv = *(const u32x4*)(QKVO + tv_ * MLW + 2048 + hh * DV + vs * 64 + vc); av = GS[(step) * 192 + vr]; \
        if (w == 0) { ga = GS[(step) * 192 + lane]; gb = GS[(step) * 192 + 64 + lane]; gc = GS[(step) * 192 + 128 + lane]; } } while (0)
    __syncthreads();
    SCAN_LOAD(0);
    for (int step = 0; step < 68; ++step) {
        const bool outp = step >= 4;
        LAS float* GA = (LAS float*)(L + SC_GA) + (step & 1) * 320;
        LAS unsigned char* CBc = L + ((step & 1) ? SC_CB1 : SC_CB0); LAS unsigned char* CBn = L + ((step & 1) ? SC_CB0 : SC_CB1);
        const float m_st = SE[136 + step], Mend = fmaxf(m_st, SE[68 + step]), decay = fexp(m_st - Mend);
        __syncthreads();
        if (w == 0) { const float M = fmaxf(m_st, gc); GA[lane] = ga; GA[64 + lane] = M; GA[128 + lane] = fexp(m_st - M); GA[192 + lane] = fexp(-(gb + M)); }
        if (outp) { *(LAS u32x4*)(L + SC_QS + (qr0 * QP + qc) * 2) = rq0; *(LAS u32x4*)(L + SC_QS + ((qr0 + 32) * QP + qc) * 2) = rq1; }
        *(LAS u32x4*)(L + SC_KS + (qr0 * QP + qc) * 2) = rk0; *(LAS u32x4*)(L + SC_KS + ((qr0 + 32) * QP + qc) * 2) = rk1;
        *(LAS u32x4*)(L + SC_VS + (vr * VP + vc) * 2) = rv;
        { const float wr_ = fexp(av - Mend); u32x4 o; o.x = cvt_pk_bf16(bf_lo(rv.x) * wr_, bf_hi(rv.x) * wr_); o.y = cvt_pk_bf16(bf_lo(rv.y) * wr_, bf_hi(rv.y) * wr_); o.z = cvt_pk_bf16(bf_lo(rv.z) * wr_, bf_hi(rv.z) * wr_); o.w = cvt_pk_bf16(bf_lo(rv.w) * wr_, bf_hi(rv.w) * wr_);
          *(LAS u32x4*)(L + SC_VW + (vr * VP + vc) * 2) = o;
          if (vc == 0) ((LAS bf16*)(L + SC_VW))[vr * VP + 64] = (bf16)(cvt_pk_bf16(wr_, 0.f) & 0xffffu); }
        if (step + 1 < 68) SCAN_LOAD(step + 1);
        __syncthreads();
        const int tb = w & 3;
        if (outp) {
            const int sb0 = 2 * (w >> 2);
            f32x4 sa[2] = {(f32x4){0.f, 0.f, 0.f, 0.f}, (f32x4){0.f, 0.f, 0.f, 0.f}};
#pragma unroll
            for (int ks = 0; ks < 4; ++ks) { const bf16x8 bq = lds_row8(L + SC_QS, 16 * tb + i16, QP, 32 * ks + 8 * g);
#pragma unroll
                for (int j = 0; j < 2; ++j) { const bf16x8 ak = lds_row8(L + SC_KS, 16 * (sb0 + j) + i16, QP, 32 * ks + 8 * g); sa[j] = __builtin_amdgcn_mfma_f32_16x16x32_bf16(ak, bq, sa[j], 0, 0, 0); } }
            const int t = 16 * tb + i16; const float Mt = GA[64 + t];
#pragma unroll
            for (int j = 0; j < 2; ++j) { const int s0 = 16 * (sb0 + j) + 4 * g; const f32x4 a4 = *(const LAS f32x4*)(GA + s0); float p[4];
#pragma unroll
                for (int r = 0; r < 4; ++r) p[r] = (s0 + r <= t) ? fexp(a4[r] - Mt) * sa[j][r] : 0.f;
                u32x2 o; o.x = cvt_pk_bf16(p[0], p[1]); o.y = cvt_pk_bf16(p[2], p[3]); *(LAS u32x2*)(L + SC_PS + (t * PP + s0) * 2) = o; }
        }
#pragma unroll
        for (int i = 0; i < 5; ++i) accc[i] = accc[i] * decay;
#pragma unroll
        for (int ks = 0; ks < 2; ++ks) { const bf16x8 ak = lds_tr8(L + SC_KS, QP, 32 * ks, 16 * w, lane);
#pragma unroll
            for (int i = 0; i < 5; ++i) { const bf16x8 bv = lds_tr8(L + SC_VW, VP, 32 * ks, 16 * i, lane); accc[i] = __builtin_amdgcn_mfma_f32_16x16x32_bf16(ak, bv, accc[i], 0, 0, 0); } }
#pragma unroll
        for (int i = 0; i < 5; ++i) { u32x2 o; o.x = cvt_pk_bf16(accc[i][0], accc[i][1]); o.y = cvt_pk_bf16(accc[i][2], accc[i][3]); *(LAS u32x2*)(CBn + ((16 * i + i16) * QP + 16 * w + 4 * g) * 2) = o; }
        if (outp) {
            __syncthreads();
            const int half = w >> 2; const int vb[3] = {2 * half, 2 * half + 1, 4};
            f32x4 oa[3] = {(f32x4){0.f, 0.f, 0.f, 0.f}, (f32x4){0.f, 0.f, 0.f, 0.f}, (f32x4){0.f, 0.f, 0.f, 0.f}};
#pragma unroll
            for (int ks = 0; ks < 4; ++ks) { const bf16x8 bq = lds_row8(L + SC_QS, 16 * tb + i16, QP, 32 * ks + 8 * g);
#pragma unroll
                for (int j = 0; j < 3; ++j) { const bf16x8 ac = lds_row8(CBc, 16 * vb[j] + i16, QP, 32 * ks + 8 * g); oa[j] = __builtin_amdgcn_mfma_f32_16x16x32_bf16(ac, bq, oa[j], 0, 0, 0); } }
            const int t = 16 * tb + i16; const float it = GA[128 + t];
#pragma unroll
            for (int j = 0; j < 3; ++j) oa[j] = oa[j] * it;
#pragma unroll
            for (int ks = 0; ks < 2; ++ks) { const bf16x8 bp = lds_row8(L + SC_PS, 16 * tb + i16, PP, 32 * ks + 8 * g);
#pragma unroll
                for (int j = 0; j < 3; ++j) { const bf16x8 av8 = lds_tr8(L + SC_VS, VP, 32 * ks, 16 * vb[j], lane); oa[j] = __builtin_amdgcn_mfma_f32_16x16x32_bf16(av8, bp, oa[j], 0, 0, 0); } }
            const float den = __shfl(oa[2][0], i16);
            const float inv = __builtin_amdgcn_rcpf(fmaxf(fabsf(den), GA[192 + t]));
            const size_t tok = (size_t)SCAN_TOK(step, t);
#pragma unroll
            for (int j = 0; j < 2; ++j) { u32x2 o; o.x = cvt_pk_bf16(oa[j][0] * inv, oa[j][1] * inv); o.y = cvt_pk_bf16(oa[j][2] * inv, oa[j][3] * inv);
                *(u32x2*)(HOUT + tok * D + hh * DV + vs * 64 + 16 * vb[j] + 4 * g) = o; }
        }
    }
    __syncthreads();
#undef SCAN_TOK
#undef SCAN_LOAD
}

__device__ __forceinline__ void headnorm_phase(Frame& F) {
    PHASE_IDS();
    const int gw = F.bid * NWAVES + wave, NGW = F.G * NWAVES;
    const bf16* HF = (const bf16*)(F.ws + WS_RB); const bf16* HB = (const bf16*)(F.ws + WS_HB2); const bf16* QKVO = (const bf16*)(F.ws + WS_RC); bf16* Y = (bf16*)(F.ws + WS_HA);
    const float* ng = F.in[I_MNG];
    f32x4 gn[4][2];
#pragma unroll
    for (int j = 0; j < 4; ++j) { gn[j][0] = *(const f32x4*)(ng + 512 * j + 8 * lane); gn[j][1] = *(const f32x4*)(ng + 512 * j + 8 * lane + 4); }
    u32x4 an[4], bn[4], on[4];
#define HN_LOAD(row) do { _Pragma("unroll") for (int j = 0; j < 4; ++j) { const int c = 512 * j + 8 * lane; an[j] = *(const u32x4*)(HF + (size_t)(row) * D + c); bn[j] = *(const u32x4*)(HB + (size_t)(row) * D + c); on[j] = *(const u32x4*)(QKVO + (size_t)(row) * MLW + 4096 + c); } } while (0)
    if (gw < NLAT) HN_LOAD(gw);
    for (int row = gw; row < NLAT; row += NGW) {
        u32x4 a[4], b[4], o[4];
#pragma unroll
        for (int j = 0; j < 4; ++j) { a[j] = an[j]; b[j] = bn[j]; o[j] = on[j]; }
        if (row + NGW < NLAT) HN_LOAD(row + NGW);
        SCHED_FENCE();
#pragma unroll
        for (int j = 0; j < 4; ++j) {
            float h[8]; float s = 0.f;
#pragma unroll
            for (int q = 0; q < 4; ++q) { h[2 * q] = bf_lo(a[j][q]) + bf_lo(b[j][q]); h[2 * q + 1] = bf_hi(a[j][q]) + bf_hi(b[j][q]); s += h[2 * q] + h[2 * q + 1]; }
#pragma unroll
            for (int o2 = 1; o2 < 32; o2 <<= 1) s += __shfl_xor(s, o2);
            const float mean = s * (1.f / DV); float s2 = 0.f;
#pragma unroll
            for (int q = 0; q < 8; ++q) { h[q] -= mean; s2 += h[q] * h[q]; }
#pragma unroll
            for (int o2 = 1; o2 < 32; o2 <<= 1) s2 += __shfl_xor(s2, o2);
            const float rstd = 1.0f / sqrtf(s2 * (1.f / DV) + HN_EPS);
            float yv[8];
#pragma unroll
            for (int q = 0; q < 4; ++q) { const float o0 = bf_lo(o[j][q]), o1 = bf_hi(o[j][q]); const float n0 = gn[j][q >> 1][2 * (q & 1)], n1 = gn[j][q >> 1][2 * (q & 1) + 1];
                yv[2 * q] = h[2 * q] * rstd * n0 * __builtin_amdgcn_rcpf(1.0f + __expf(-o0)); yv[2 * q + 1] = h[2 * q + 1] * rstd * n1 * __builtin_amdgcn_rcpf(1.0f + __expf(-o1)); }
            u32x4 wv; wv.x = cvt_pk_bf16(yv[0], yv[1]); wv.y = cvt_pk_bf16(yv[2], yv[3]); wv.z = cvt_pk_bf16(yv[4], yv[5]); wv.w = cvt_pk_bf16(yv[6], yv[7]);
            *(u32x4*)(Y + (size_t)row * D + 512 * j + 8 * lane) = wv;
        }
    }
#undef HN_LOAD
}

constexpr int NPH = 19;
__global__ void __launch_bounds__(NTHR, 2) fwd_kernel(Args args) {
    extern __shared__ __attribute__((aligned(16))) unsigned char lds_raw[];
    Frame F;
    F.lds = (LAS unsigned char*)lds_raw;
    F.G = gridDim.x; F.bid = blockIdx.x; F.wave0 = __builtin_amdgcn_readfirstlane(threadIdx.x >> 6);
#pragma unroll
    for (int i = 0; i < 21; ++i) F.in[i] = args.in[i];
    F.out = args.out; F.ws = args.ws;
    for (int u = threadIdx.x; u < (LDS_BYTES - LDSCTL_OFF) / 4; u += NTHR) ((LAS unsigned*)(F.lds + LDSCTL_OFF))[u] = 0u;
    __syncthreads();
#if MK_N_LAUNCHES == 1
    XcdBarrier bar = xcd_barrier_post((unsigned*)(F.ws + WS_CTL) + CW_BAR, (volatile LAS unsigned*)(F.lds + LDS_MISC));
#define GRID_BAR() xcd_barrier(bar)
#else
#define GRID_BAR() do { } while (0)
#endif
    const int lo = args.ph_lo, hi = args.ph_hi;
#ifndef PHASE_MASK
#define PHASE_MASK 0x7ffff
#endif
#define IN(k) (((PHASE_MASK >> (k)) & 1) && lo <= (k) && (k) < hi)
#define SEAM(k) do { if (IN(k) && IN((k) + 1)) GRID_BAR(); } while (0)

#ifndef DUP_MASK
#define DUP_MASK 0x0
#endif
#define PHASE(k, body) do { if (IN(k)) { body; if ((DUP_MASK >> (k)) & 1) { GRID_BAR(); body; } } SEAM(k); } while (0)
    PHASE(0, p0_prologue(F));
    PHASE(1, p1_modulate(F));
    PHASE(2, ({
        constexpr int NG = 234;
        if (F.bid < NG) { pg8::SchedPlain S; S.init((const bf16*)(F.ws + WS_HA), (const bf16*)(F.ws + WS_WT_CIN), NTOK, 6144, D, NG, F.bid);
            pg8::EpiConv1 E{(bf16*)(F.ws + WS_RB), (bf16*)(F.ws + WS_RC)};
            pg8::gemm_phase<pg8::EpiConv1, pg8::SchedPlain, false>(F.lds, F.wave0, D, S, E); bg_signal_done(F, 2); }
        bg_pull(F, 0, 2, NG - 8); }));
    PHASE(3, p3_conv(F));
    PHASE(4, ({
        constexpr int NG = 182;
        if (F.bid < NG) { pg8::SchedPlain S; S.init((const bf16*)(F.ws + WS_HA), (const bf16*)(F.ws + WS_WT_COUT), NTOK, D, D, NG, F.bid);
            pg8::EpiBf16 E{(bf16*)(F.ws + WS_RB), D};
            pg8::gemm_phase<pg8::EpiBf16, pg8::SchedPlain, false>(F.lds, F.wave0, D, S, E); bg_signal_done(F, 4); }
        bg_pull(F, 0, 4, NG - 8); }));
    PHASE(5, lnA_phase(F, 0));
    PHASE(6, ({ list_phase(F, 0); bg_drain(F, Q_GV1); }));
    PHASE(7, moe_gemm1(F, 0, 7));
    PHASE(8, moe_gemm2(F, 0, 8));
    PHASE(9, ({ lnB_phase(F, 0); bg_drain(F, Q_ML); }));
    PHASE(10, ({
        constexpr int NG = 243;
        if (F.bid < NG) { pg8::SchedPlain S; S.init((const bf16*)(F.ws + WS_HA), (const bf16*)(F.ws + WS_WT_MIN), NTOK, MLN, D, NG, F.bid);
            pg8::EpiMlIn E{(bf16*)(F.ws + WS_RC), (float*)(F.ws + WS_GATES)};
            pg8::gemm_phase<pg8::EpiMlIn, pg8::SchedPlain, false>(F.lds, F.wave0, D, S, E); bg_signal_done(F, 10); }
        bg_pull(F, Q_ML, 10, NG - 8); }));
    PHASE(11, scan_phase(F));
    PHASE(12, headnorm_phase(F));
    PHASE(13, ({
        pg8::SchedPlain S; S.init((const bf16*)(F.ws + WS_HA), (const bf16*)(F.ws + WS_WT_MOUT), NLAT, D, D, F.G, F.bid);
        pg8::EpiBf16 E{(bf16*)(F.ws + WS_RB), D};
        pg8::gemm_phase<pg8::EpiBf16, pg8::SchedPlain, false>(F.lds, F.wave0, D, S, E); }));
    PHASE(14, lnA_phase(F, 1));
    PHASE(15, ({ list_phase(F, 1); bg_drain(F, Q_END); }));
    PHASE(16, moe_gemm1(F, 1, 16));
    PHASE(17, moe_gemm2(F, 1, 17));
    PHASE(18, lnB_phase(F, 1));
#undef PHASE
#undef IN
#undef SEAM
}

extern "C" void kernel_launch(void* const* d_in, const int* in_sizes, int n_in, void* d_out, int out_size, void* d_ws, size_t ws_size, hipStream_t stream) {
    static int grid = 0;
    if (grid == 0) {
        if (n_in != 21 || out_size != NLAT * D || ws_size < WS_END) { fprintf(stderr, "kernel_launch: unexpected problem (n_in %d, out %d, ws %zu; need ws >= %zu)\n", n_in, out_size, ws_size, (size_t)WS_END); grid = -1; return; }
        int dev = 0, cus = 0, per_cu = 0;
        if (hipGetDevice(&dev) != hipSuccess || hipDeviceGetAttribute(&cus, hipDeviceAttributeMultiprocessorCount, dev) != hipSuccess) { grid = -1; return; }
        if (hipFuncSetAttribute((const void*)fwd_kernel, hipFuncAttributeMaxDynamicSharedMemorySize, LDS_BYTES) != hipSuccess) { fprintf(stderr, "kernel_launch: hipFuncSetAttribute failed\n"); grid = -1; return; }
        if (hipOccupancyMaxActiveBlocksPerMultiprocessor(&per_cu, (const void*)fwd_kernel, NTHR, LDS_BYTES) != hipSuccess || per_cu < 1) fprintf(stderr, "kernel_launch: occupancy query reports %d\n", per_cu);
        (void)hipGetLastError();
        if (cus < GRID) { fprintf(stderr, "kernel_launch: needs %d CUs, device has %d\n", GRID, cus); grid = -1; return; }
        grid = GRID;
    }
    if (grid < 0) return;
    (void)in_sizes;
    if (hipMemsetAsync((char*)d_ws + WS_CTL, 0, CTL_ZERO_BYTES, stream) != hipSuccess) return;
    Args a{};
    for (int i = 0; i < 21; ++i) a.in[i] = (const float*)d_in[i];
    a.out = (float*)d_out; a.ws = (unsigned char*)d_ws;
#if MK_N_LAUNCHES == 1
    a.ph_lo = 0; a.ph_hi = NPH;
    hipLaunchKernelGGL(fwd_kernel, dim3(grid), dim3(NTHR), LDS_BYTES, stream, a);
#else
    for (int p = 0; p < NPH; ++p) { a.ph_lo = p; a.ph_hi = p + 1; hipLaunchKernelGGL(fwd_kernel, dim3(grid), dim3(NTHR), LDS_BYTES, stream, a); }
#endif
}
```

```cpp
#include <hip/hip_runtime.h>
#include <cstdio>
#include <cstdint>

#ifndef MK_N_LAUNCHES
#define MK_N_LAUNCHES 1
#endif

#define LAS __attribute__((address_space(3)))
typedef unsigned short bf16;
typedef short bf16x8 __attribute__((ext_vector_type(8)));
typedef short s16x4 __attribute__((ext_vector_type(4)));
typedef float f32x4 __attribute__((ext_vector_type(4)));
typedef unsigned u32x4 __attribute__((ext_vector_type(4)));
typedef unsigned u32x2 __attribute__((ext_vector_type(2)));

constexpr int D = 2048, NB = 4, SEQ = 4096, NLAT = NB * SEQ, CTXL = 256, NCTX = NB * CTXL, NTOK = NLAT + NCTX;
constexpr int NE = 16, DE = 1024, NH = 8, DQK = 128, DV = 256;
constexpr int MLW = 6144, MLN = 6400;
constexpr int NWAVES = 8, NTHR = 512, GRID = 256;
constexpr float ALPHA = 1.41421356237f, LN_EPS = 1e-5f, HN_EPS = 1e-6f;
constexpr int MAXTILES = 153;

constexpr size_t MiB = 1u << 20;
constexpr size_t WS_CTL = 0, CTL_ZERO_BYTES = 1 * MiB;
constexpr size_t WS_MOD = 1 * MiB;
constexpr size_t WS_MISC = 2 * MiB;
constexpr size_t WS_ROUTE = WS_MISC + 0, WS_BLKCNT = WS_MISC + 0x48000, WS_SROW = WS_MISC + 0x50000, WS_SWT = WS_MISC + 0x80000, WS_TILEE = WS_MISC + 0xB0000, WS_TTOT = WS_MISC + 0xB0400;
constexpr size_t WS_CTXRES = 6 * MiB;
constexpr size_t WS_GATES = 14 * MiB;
constexpr size_t WS_WT_CIN = 17 * MiB, WS_WT_COUT = 41 * MiB, WS_WT_MIN = 49 * MiB, WS_WT_MOUT = 74 * MiB, WS_WT_E1 = 82 * MiB, WS_WT_E2 = 338 * MiB;
constexpr size_t WS_HA = 466 * MiB, WS_RB = 534 * MiB, WS_RC = 602 * MiB, WS_RH = 670 * MiB, WS_REX = 747 * MiB, WS_HB2 = 883 * MiB, WS_END = 947 * MiB;
constexpr int CW_BAR = 4096;

constexpr int RING_BYTES = 131072, LDSCTL_OFF = 139264, LDS_TILEE = LDSCTL_OFF, LDS_MISC = LDSCTL_OFF + 1024, LDS_BYTES = 147456;

__device__ __forceinline__ unsigned cvt_pk_bf16(float lo, float hi) { unsigned r; asm volatile("v_cvt_pk_bf16_f32 %0, %1, %2" : "=v"(r) : "v"(lo), "v"(hi)); return r; }
__device__ __forceinline__ float bf_lo(unsigned u) { return __uint_as_float(u << 16); }
__device__ __forceinline__ float bf_hi(unsigned u) { return __uint_as_float(u & 0xffff0000u); }
__device__ __forceinline__ float wave_sum(float v) {
#pragma unroll
    for (int o = 1; o < 64; o <<= 1) v += __shfl_xor(v, o);
    return v;
}
#define LDS_WAIT() asm volatile("s_waitcnt lgkmcnt(0)" ::: "memory")
#define VM_WAIT() asm volatile("s_waitcnt vmcnt(0)" ::: "memory")

#define XB_TMO      128
#define XB_XCNT(j)  (256  + 64 * (j))
#define XB_XSUB(j)  (1280 + 64 * (j))
#define XB_XGEN(j)  (2304 + 64 * (j))
#define XB_TOP      3328
#define XB_TOPGEN   3392
#define XCD_BAR_WORDS 3456
#define XB_SPIN_CAP (1u << 18)
__device__ __forceinline__ unsigned xb_ld(unsigned* p)              { return __hip_atomic_load(p, __ATOMIC_RELAXED, __HIP_MEMORY_SCOPE_AGENT); }
__device__ __forceinline__ unsigned xb_add(unsigned* p, unsigned v) { return __hip_atomic_fetch_add(p, v, __ATOMIC_RELAXED, __HIP_MEMORY_SCOPE_AGENT); }
__device__ __forceinline__ unsigned xb_xcc_id() { return (unsigned)__builtin_amdgcn_s_getreg((3 << 11) | 20) & 0xFu; }
#define XB_SPIN(cond, bar) do { unsigned _sp = 0; while (cond) { __builtin_amdgcn_s_sleep(1); \
    if ((++_sp & 255u) == 0u) { if (xb_ld(&(bar)[XB_TMO])) break; if (_sp > XB_SPIN_CAP) { atomicAdd(&(bar)[XB_TMO], 1u); break; } } } } while (0)
struct XcdBarrier { unsigned* bar; unsigned x; volatile LAS unsigned* st; };
__device__ __forceinline__ XcdBarrier xcd_barrier_post(unsigned* bar, volatile LAS unsigned* st) {
    XcdBarrier b; b.bar = bar; b.x = xb_xcc_id(); b.st = st;
    if (threadIdx.x == 0) (void)xb_add(&bar[XB_XCNT(b.x)], 1u);
    return b;
}
__device__ __forceinline__ void xcd_barrier_complete(unsigned* bar, unsigned x, unsigned& nloc, unsigned& nx) {
    const unsigned G = gridDim.x * gridDim.y * gridDim.z;
    unsigned sum, cnt, mine, sp = 0u;
    for (;;) {
        sum = 0u; cnt = 0u; mine = 0u;
#pragma unroll
        for (unsigned j = 0; j < 16; ++j) { const unsigned c = xb_ld(&bar[XB_XCNT(j)]); sum += c; cnt += (c > 0u) ? 1u : 0u; mine = (j == x) ? c : mine; }
        if (sum == G) break;
        __builtin_amdgcn_s_sleep(1);
        if ((++sp & 255u) == 0u) { if (xb_ld(&bar[XB_TMO])) break; if (sp > XB_SPIN_CAP) { atomicAdd(&bar[XB_TMO], 1u); break; } }
    }
    nloc = mine > 0u ? mine : 1u; nx = cnt > 0u ? cnt : 1u;
}
__device__ __forceinline__ void xcd_barrier(const XcdBarrier& b) {
    asm volatile("s_waitcnt vmcnt(0)" ::: "memory");
    __syncthreads();
    if (threadIdx.x == 0) {
        unsigned* bar = b.bar;
        __builtin_amdgcn_s_waitcnt(0);
        unsigned nloc = b.st[0], nx = b.st[1];
        if (nloc == 0u) { xcd_barrier_complete(bar, b.x, nloc, nx); b.st[0] = nloc; b.st[1] = nx; }
        const unsigned old = xb_add(&bar[XB_XSUB(b.x)], 1u);
        const unsigned gen = old / nloc;
        if (old + 1u == (gen + 1u) * nloc) {
            __builtin_amdgcn_fence(__ATOMIC_RELEASE, "agent");
            asm volatile("s_waitcnt vmcnt(0)" ::: "memory");
            const unsigned og = xb_add(&bar[XB_TOP], 1u);
            const unsigned tg = og / nx;
            if (og + 1u == (tg + 1u) * nx) xb_add(&bar[XB_TOPGEN], 1u);
            else XB_SPIN(xb_ld(&bar[XB_TOPGEN]) == tg, bar);
            __builtin_amdgcn_fence(__ATOMIC_ACQUIRE, "agent");
            xb_add(&bar[XB_XGEN(b.x)], 1u);
            asm volatile("s_waitcnt vmcnt(0)" ::: "memory");
        } else {
            XB_SPIN(xb_ld(&bar[XB_XGEN(b.x)]) == gen, bar);
            __builtin_amdgcn_fence(__ATOMIC_ACQUIRE, "agent");
            asm volatile("s_waitcnt vmcnt(0)" ::: "memory");
        }
    }
    __syncthreads();
}

namespace pg8 {
constexpr int BM = 256, BK = 64, HALF = 128, HTB = HALF * BK * 2, NXCD = 8, WGM = 8;
__device__ __forceinline__ int lds_byte(int r, int c) { const int st = (r >> 4) * 2 + (c >> 5), rr = r & 15, cc = c & 31, ob = rr * 64 + cc * 2; return st * 1024 + (ob ^ (((ob >> 9) & 1) << 5)); }
__device__ __forceinline__ void stage_rc(int b, int& R, int& C) { const int st = b / 1024, sb = b % 1024, swz = sb ^ (((sb >> 9) & 1) << 5); R = (st >> 1) * 16 + swz / 64; C = (st & 1) * 32 + (swz % 64) / 2; }
__device__ __forceinline__ int perm32(int rho) { const int n = rho >> 4, i = rho & 15; return 8 * (i >> 2) + 4 * n + (i & 3); }

struct Unit { int pm, pn; const char* a; const char* b; };

__device__ __forceinline__ bool order_next(int i, int G, int c, int nM, int nN, int& pm, int& pn) {
    const int nwg = nM * nN; const long L = (long)i * G + c; if (L >= nwg) return false;
    int wgid = (int)L; { const int q = nwg / NXCD, r = nwg % NXCD, xcd = wgid % NXCD, off = wgid / NXCD; wgid = (xcd < r ? xcd * (q + 1) : r * (q + 1) + (xcd - r) * q) + off; }
    const int nig = WGM * nN, gid = wgid / nig, fm = gid * WGM, gsz = (nM - fm) < WGM ? (nM - fm) : WGM;
    pm = fm + ((wgid % nig) % gsz); pn = (wgid % nig) / gsz; return true;
}
struct SchedPlain {
    const char* A; const char* Bt; int nM, nN, G, c; size_t tstep;
    __device__ __forceinline__ void init(const bf16* A_, const bf16* Bt_, int M, int N, int K, int G_, int c_) { A = (const char*)A_; Bt = (const char*)Bt_; nM = M / BM; nN = N / BM; G = G_; c = c_; tstep = (size_t)BM * K * 2; }
    __device__ __forceinline__ bool next(int i, Unit& u) const { if (!order_next(i, G, c, nM, nN, u.pm, u.pn)) return false; u.a = A + (size_t)u.pm * tstep; u.b = Bt + (size_t)u.pn * tstep; return true; }
};
struct SchedMoe {
    const char* A; const char* Bt; const int* srow; const LAS int* tile_e; int nM, nN, G, c; size_t tstepA, tstepB, estepB;
    __device__ __forceinline__ bool next(int i, Unit& u) const { if (!order_next(i, G, c, nM, nN, u.pm, u.pn)) return false;
        const int e = tile_e[u.pm]; u.a = A + (size_t)u.pm * tstepA; u.b = Bt + (size_t)e * estepB + (size_t)u.pn * tstepB; return true; }
};

template <class Epi, class Sched, bool GATHER>
__device__ __forceinline__ void gemm_phase(LAS unsigned char* lds, const int wid, const int K, const Sched& S, const Epi& E, unsigned* last_word = nullptr) {
    int lane_ = (int)__builtin_amdgcn_mbcnt_hi(~0u, __builtin_amdgcn_mbcnt_lo(~0u, 0u)); asm volatile("" : "+v"(lane_));
    const int lane = lane_, tid = wid * 64 + lane, wr = wid >> 2, wc = wid & 3, fr = lane & 15, fq = lane >> 4;
    const int nt = K / BK;
    int R0, C0, R1, C1; stage_rc(tid * 16, R0, C0); stage_rc(tid * 16 + 8192, R1, C1);
    unsigned voffB[2]; voffB[0] = (unsigned)(((R0 & ~31) + perm32(R0 & 31)) * K + C0) * 2u; voffB[1] = (unsigned)(((R1 & ~31) + perm32(R1 & 31)) * K + C1) * 2u;
    unsigned cv[4], nv[4];
    const size_t kstep = (size_t)(BK * 2);
    const size_t hstep = (size_t)HALF * K * 2;
    const unsigned ldsw = (unsigned)wid * 1024u;
    const int aoff = lds_byte(wr * 64 + fr, fq * 8), boff = lds_byte(wc * 32 + fr, fq * 8);
#define PG8_SA(b, h) (((b) * 2 + (h)) * HTB)
#define PG8_SB(b, h) ((4 + (b) * 2 + (h)) * HTB)
#define PG8_STG(bufoff, ptr, o0, o1) do { const char* p_ = (const char*)(ptr); asm volatile("" : "+s"(p_));     \
        __builtin_amdgcn_global_load_lds((const unsigned*)(p_ + (o0)), (LAS unsigned*)(lds + (bufoff) + ldsw), 16, 0, 0); \
        __builtin_amdgcn_global_load_lds((const unsigned*)(p_ + (o1)), (LAS unsigned*)(lds + (bufoff) + ldsw + 8192), 16, 0, 0); } while (0)
#define PG8_STGB(bufoff, ptr) PG8_STG(bufoff, ptr, voffB[0], voffB[1])
#define PG8_STGA(bufoff, ptr, h, V) do { if constexpr (GATHER) { PG8_STG(bufoff, ptr, (V)[2 * (h)], (V)[2 * (h) + 1]); } else { PG8_STG(bufoff, (ptr) + (h) * hstep, (V)[0], (V)[1]); } } while (0)
#define PG8_LDA(dst, b, h) do { _Pragma("unroll") for (int m = 0; m < 4; ++m) _Pragma("unroll") for (int k = 0; k < 2; ++k) dst[m][k] = *(const LAS bf16x8*)(lds + PG8_SA(b, h) + aoff + m * 2048 + k * 1024); } while (0)
#define PG8_LDB(dst, b, h) do { _Pragma("unroll") for (int n = 0; n < 2; ++n) _Pragma("unroll") for (int k = 0; k < 2; ++k) dst[n][k] = *(const LAS bf16x8*)(lds + PG8_SB(b, h) + boff + n * 2048 + k * 1024); } while (0)
#define PG8_MMA(ai, bj, At, Bt) do { __builtin_amdgcn_s_setprio(1); _Pragma("unroll") for (int m = 0; m < 4; ++m) _Pragma("unroll") for (int n = 0; n < 2; ++n) _Pragma("unroll") for (int k = 0; k < 2; ++k) \
        acc[ai][bj][m][n] = __builtin_amdgcn_mfma_f32_16x16x32_bf16(Bt[n][k], At[m][k], acc[ai][bj][m][n], 0, 0, 0); __builtin_amdgcn_s_setprio(0); } while (0)
#define PG8_WAIT_V(n) asm volatile("s_waitcnt vmcnt(" #n ")" ::: "memory")
#define PG8_WAIT_L(n) asm volatile("s_waitcnt lgkmcnt(" #n ")" ::: "memory")
#define PG8_BAR __builtin_amdgcn_s_barrier()
#define PG8_SCHED __builtin_amdgcn_sched_barrier(0)
#define PG8_TRIP(A1, A2, B2, V2) do { const char* a3_ = (A2) + kstep; const char* b3_ = (B2) + kstep; \
        PG8_LDB(B0, 0, 0); PG8_LDB(B1, 0, 1); PG8_SCHED; PG8_LDA(At, 0, 0); PG8_STGA(PG8_SA(1, 1), A1, 1, cv); \
        PG8_WAIT_V(8); PG8_WAIT_L(0); PG8_BAR; PG8_MMA(0, 0, At, B0); PG8_MMA(0, 1, At, B1); PG8_BAR; PG8_SCHED; \
        PG8_LDA(At, 0, 1); PG8_STGB(PG8_SB(0, 0), B2); PG8_STGB(PG8_SB(0, 1), (B2) + hstep); PG8_STGA(PG8_SA(0, 0), A2, 0, V2); \
        PG8_WAIT_V(8); PG8_WAIT_L(0); PG8_BAR; PG8_MMA(1, 0, At, B0); PG8_MMA(1, 1, At, B1); PG8_BAR; PG8_SCHED; \
        PG8_LDB(B0, 1, 0); PG8_LDB(B1, 1, 1); PG8_SCHED; PG8_LDA(At, 1, 0); PG8_STGA(PG8_SA(0, 1), A2, 1, V2); \
        PG8_WAIT_V(8); PG8_WAIT_L(0); PG8_BAR; PG8_MMA(0, 0, At, B0); PG8_MMA(0, 1, At, B1); PG8_BAR; PG8_SCHED; \
        PG8_LDA(At, 1, 1); PG8_STGB(PG8_SB(1, 0), b3_); PG8_STGB(PG8_SB(1, 1), b3_ + hstep); PG8_STGA(PG8_SA(1, 0), a3_, 0, V2); \
        PG8_WAIT_V(8); PG8_WAIT_L(0); PG8_BAR; PG8_MMA(1, 0, At, B0); PG8_MMA(1, 1, At, B1); PG8_BAR; PG8_SCHED; } while (0)
#define PG8_OFFS(u, v) do { if constexpr (GATHER) { const int* sr_ = S.srow + (u).pm * 256; int t0_ = sr_[R0], t1_ = sr_[R1], t2_ = sr_[128 + R0], t3_ = sr_[128 + R1]; \
        t0_ = t0_ < 0 ? 0 : (t0_ >> 1); t1_ = t1_ < 0 ? 0 : (t1_ >> 1); t2_ = t2_ < 0 ? 0 : (t2_ >> 1); t3_ = t3_ < 0 ? 0 : (t3_ >> 1); \
        (v)[0] = (unsigned)(t0_ * K + C0) * 2u; (v)[1] = (unsigned)(t1_ * K + C1) * 2u; (v)[2] = (unsigned)(t2_ * K + C0) * 2u; (v)[3] = (unsigned)(t3_ * K + C1) * 2u; } } while (0)
    Unit cur, nxt; int ui = 0;
    if (!S.next(0, cur)) return;
    f32x4 acc[2][2][4][2];
#pragma unroll
    for (int a = 0; a < 2; ++a)
#pragma unroll
        for (int b = 0; b < 2; ++b)
#pragma unroll
            for (int m = 0; m < 4; ++m)
#pragma unroll
                for (int n = 0; n < 2; ++n) acc[a][b][m][n] = (f32x4){0.f, 0.f, 0.f, 0.f};
    bf16x8 At[4][2], B0[2][2], B1[2][2];
    if constexpr (GATHER) { PG8_OFFS(cur, cv); }
    else { cv[0] = (unsigned)(R0 * K + C0) * 2u; cv[1] = (unsigned)(R1 * K + C1) * 2u; cv[2] = 0u; cv[3] = 0u; }
    const char* cA = cur.a; const char* cB = cur.b;
    PG8_STGB(PG8_SB(0, 0), cB); PG8_STGB(PG8_SB(0, 1), cB + hstep); PG8_STGA(PG8_SA(0, 0), cA, 0, cv); PG8_STGA(PG8_SA(0, 1), cA, 1, cv);
    if (wr == 1) PG8_BAR;
    PG8_WAIT_V(2); PG8_BAR;
    PG8_STGB(PG8_SB(1, 0), cB + kstep); PG8_STGA(PG8_SA(1, 0), cA + kstep, 0, cv); PG8_STGB(PG8_SB(1, 1), cB + hstep + kstep);
    PG8_WAIT_V(6); PG8_BAR;
    for (;;) {
        const bool has_next = S.next(ui + 1, nxt);
        if (!has_next && last_word != nullptr && tid == 0) __hip_atomic_fetch_add(last_word, 1u, __ATOMIC_RELAXED, __HIP_MEMORY_SCOPE_AGENT);
        const char* nA = has_next ? nxt.a : cA; const char* nB = has_next ? nxt.b : cB;
        if constexpr (GATHER) { if (has_next) { PG8_OFFS(nxt, nv); } else { nv[0] = cv[0]; nv[1] = cv[1]; nv[2] = cv[2]; nv[3] = cv[3]; } }
        for (int t = 0; t < nt - 2; t += 2) { const char* a1 = cA + (size_t)(t + 1) * kstep; const char* a2 = cA + (size_t)(t + 2) * kstep; const char* b2 = cB + (size_t)(t + 2) * kstep; PG8_TRIP(a1, a2, b2, cv); }
        { const char* a1 = cA + (size_t)(nt - 1) * kstep; if constexpr (GATHER) { PG8_TRIP(a1, nA, nB, nv); } else { PG8_TRIP(a1, nA, nB, cv); } }
        if (wr == 0) PG8_BAR;
        E(acc, cur, wr, wc, fr, fq);
        if (!has_next) break;
#pragma unroll
        for (int a = 0; a < 2; ++a)
#pragma unroll
            for (int b = 0; b < 2; ++b)
#pragma unroll
                for (int m = 0; m < 4; ++m)
#pragma unroll
                    for (int n = 0; n < 2; ++n) acc[a][b][m][n] = (f32x4){0.f, 0.f, 0.f, 0.f};
        cur = nxt; cA = nA; cB = nB; ++ui;
        if constexpr (GATHER) { cv[0] = nv[0]; cv[1] = nv[1]; cv[2] = nv[2]; cv[3] = nv[3]; }
        if (wr == 1) PG8_BAR;
    }
    PG8_WAIT_V(0);
    PG8_BAR;
#undef PG8_SA
#undef PG8_SB
#undef PG8_STG
#undef PG8_STGB
#undef PG8_STGA
#undef PG8_LDA
#undef PG8_LDB
#undef PG8_MMA
#undef PG8_WAIT_V
#undef PG8_WAIT_L
#undef PG8_BAR
#undef PG8_SCHED
#undef PG8_TRIP
#undef PG8_OFFS
}

__device__ __forceinline__ u32x4 pack8(const f32x4 v0, const f32x4 v1) { u32x4 w; w.x = cvt_pk_bf16(v0[0], v0[1]); w.y = cvt_pk_bf16(v0[2], v0[3]); w.z = cvt_pk_bf16(v1[0], v1[1]); w.w = cvt_pk_bf16(v1[2], v1[3]); return w; }
struct EpiBf16 {
    bf16* O; int ldc;
    __device__ __forceinline__ void operator()(const f32x4 (&acc)[2][2][4][2], const Unit& u, int wr, int wc, int fr, int fq) const {
        const int row0 = u.pm * BM + wr * 64 + fr, col0 = u.pn * BM + wc * 32 + 8 * fq;
#pragma unroll
        for (int ai = 0; ai < 2; ++ai)
#pragma unroll
            for (int m = 0; m < 4; ++m) { bf16* rowp = O + (size_t)(row0 + ai * HALF + m * 16) * ldc + col0;
#pragma unroll
                for (int bj = 0; bj < 2; ++bj) *(u32x4*)(rowp + bj * HALF) = pack8(acc[ai][bj][m][0], acc[ai][bj][m][1]); }
    }
};
struct EpiConv1 {
    bf16* BG; bf16* Z;
    __device__ __forceinline__ void operator()(const f32x4 (&acc)[2][2][4][2], const Unit& u, int wr, int wc, int fr, int fq) const {
        const int row0 = u.pm * BM + wr * 64 + fr;
        if (u.pn < 8) {
            const int col0 = u.pn * BM + wc * 32 + 8 * fq;
#pragma unroll
            for (int ai = 0; ai < 2; ++ai)
#pragma unroll
                for (int m = 0; m < 4; ++m) { bf16* rowp = BG + (size_t)(row0 + ai * HALF + m * 16) * D + col0;
#pragma unroll
                    for (int bj = 0; bj < 2; ++bj) *(u32x4*)(rowp + bj * HALF) = pack8(acc[ai][bj][m][0], acc[ai][bj][m][1]); }
        } else {
            const int col0 = (u.pn - 8) * HALF + wc * 32 + 8 * fq;
#pragma unroll
            for (int ai = 0; ai < 2; ++ai)
#pragma unroll
                for (int m = 0; m < 4; ++m) { bf16* rowp = Z + (size_t)(row0 + ai * HALF + m * 16) * D + col0;
                    *(u32x4*)rowp = pack8(acc[ai][0][m][0] * acc[ai][1][m][0], acc[ai][0][m][1] * acc[ai][1][m][1]); }
        }
    }
};
struct EpiMlIn {
    bf16* O; float* gates;
    __device__ __forceinline__ void operator()(const f32x4 (&acc)[2][2][4][2], const Unit& u, int wr, int wc, int fr, int fq) const {
        const int row0 = u.pm * BM + wr * 64 + fr;
        if (u.pn < 24) {
            const int col0 = u.pn * BM + wc * 32 + 8 * fq;
#pragma unroll
            for (int ai = 0; ai < 2; ++ai)
#pragma unroll
                for (int m = 0; m < 4; ++m) { bf16* rowp = O + (size_t)(row0 + ai * HALF + m * 16) * MLW + col0;
#pragma unroll
                    for (int bj = 0; bj < 2; ++bj) *(u32x4*)(rowp + bj * HALF) = pack8(acc[ai][bj][m][0], acc[ai][bj][m][1]); }
        } else if (wc == 0) {
#pragma unroll
            for (int ai = 0; ai < 2; ++ai)
#pragma unroll
                for (int m = 0; m < 4; ++m) { float* rowp = gates + (size_t)(row0 + ai * HALF + m * 16) * 32 + 8 * fq;
                    *(f32x4*)rowp = acc[ai][0][m][0]; *(f32x4*)(rowp + 4) = acc[ai][0][m][1]; }
        }
    }
};
__device__ __forceinline__ float silu_f(float g) { return g * __builtin_amdgcn_rcpf(1.0f + __expf(-g)); }
struct EpiMoe1 {
    bf16* H;
    __device__ __forceinline__ void operator()(const f32x4 (&acc)[2][2][4][2], const Unit& u, int wr, int wc, int fr, int fq) const {
        const int row0 = u.pm * BM + wr * 64 + fr, col0 = u.pn * HALF + wc * 32 + 8 * fq;
#pragma unroll
        for (int ai = 0; ai < 2; ++ai)
#pragma unroll
            for (int m = 0; m < 4; ++m) { bf16* rowp = H + (size_t)(row0 + ai * HALF + m * 16) * DE + col0; f32x4 h0, h1;
#pragma unroll
                for (int j = 0; j < 4; ++j) { h0[j] = silu_f(acc[ai][0][m][0][j]) * acc[ai][1][m][0][j]; h1[j] = silu_f(acc[ai][0][m][1][j]) * acc[ai][1][m][1][j]; }
                *(u32x4*)rowp = pack8(h0, h1); }
    }
};
struct EpiMoe2 {
    bf16* EX; const int* srow; const float* swt;
    __device__ __forceinline__ void operator()(const f32x4 (&acc)[2][2][4][2], const Unit& u, int wr, int wc, int fr, int fq) const {
        const int row0 = u.pm * BM + wr * 64 + fr, col0 = u.pn * BM + wc * 32 + 8 * fq;
#pragma unroll
        for (int ai = 0; ai < 2; ++ai)
#pragma unroll
            for (int m = 0; m < 4; ++m) { const int r = row0 + ai * HALF + m * 16; const int ent = srow[r]; const float w = swt[r];
                if (ent >= 0) { bf16* rowp = EX + ((size_t)(ent & 1) * NTOK + (size_t)(ent >> 1)) * D + col0;
#pragma unroll
                    for (int bj = 0; bj < 2; ++bj) *(u32x4*)(rowp + bj * HALF) = pack8(acc[ai][bj][m][0] * w, acc[ai][bj][m][1] * w); } }
    }
};
}

struct Args { const float* in[21]; float* out; unsigned char* ws; int ph_lo, ph_hi; };
struct Frame {
    LAS unsigned char* lds;
    int G, bid, wave0;
    const float* in[21]; float* out; unsigned char* ws;
};
enum { I_X = 0, I_C, I_CTX, I_CCTX, I_WADA, I_BADA, I_LNG, I_LNB, I_CWIN, I_CW, I_CWOUT, I_MWIN, I_MWG, I_MBG, I_MNG, I_MWOUT, I_RW, I_RB, I_EWG, I_EWU, I_EWD };

#define PHASE_IDS() int lane_ = (int)__builtin_amdgcn_mbcnt_hi(~0u, __builtin_amdgcn_mbcnt_lo(~0u, 0u)); asm volatile("" : "+v"(lane_)); const int lane = lane_; const int wave = F.wave0; const int tid = wave * 64 + lane; (void)tid
__device__ __forceinline__ int mod_row(int trow) { return trow < NLAT ? (trow >> 12) : 4; }
__device__ __forceinline__ const float* mod_vec(const Frame& F, int layer, int r, int j) { return (const float*)(F.ws + WS_MOD) + ((size_t)(layer * 5 + r) * 6 + j) * D; }

__device__ __forceinline__ void cvt_tile(const float* src, size_t src_pitch, bf16* dst, size_t dst_pitch, float scale, LAS float* scr, int lane) {
#pragma unroll 8
    for (int i = 0; i < 64; ++i) scr[i * 65 + lane] = __builtin_nontemporal_load(src + (size_t)i * src_pitch + lane);
    LDS_WAIT(); asm volatile("" ::: "memory");
    const int c = lane & 7;
#pragma unroll
    for (int j = 0; j < 8; ++j) { const int n = (lane >> 3) + 8 * j; const LAS float* s = scr + (8 * c) * 65 + n;
        u32x4 o; o.x = cvt_pk_bf16(s[0] * scale, s[65] * scale); o.y = cvt_pk_bf16(s[2 * 65] * scale, s[3 * 65] * scale); o.z = cvt_pk_bf16(s[4 * 65] * scale, s[5 * 65] * scale); o.w = cvt_pk_bf16(s[6 * 65] * scale, s[7 * 65] * scale);
        *(u32x4*)(dst + (size_t)n * dst_pitch + 8 * c) = o; }
    LDS_WAIT(); asm volatile("" ::: "memory");
}
__device__ __forceinline__ void gemv_item(Frame& F, int l, int chunk, int tid, int lane, int wave) {
    LAS float* sc = (LAS float*)F.lds;
    LAS float* red = (LAS float*)(F.lds + 40960);
    for (int idx = tid; idx < 5 * D; idx += NTHR) { const int r = idx / D, k = idx % D; const float cv = r < 4 ? F.in[I_C][r * D + k] : F.in[I_CCTX][k]; sc[idx] = cv / (1.0f + expf(-cv)); }
    __syncthreads();
    float* mod = (float*)(F.ws + WS_MOD);
    const int n0 = chunk * 32, col = lane & 31, kp = lane >> 5, kbase = wave * 256;
    const float* W = F.in[I_WADA] + (size_t)l * D * 12288 + n0 + col;
    float acc[5] = {0.f, 0.f, 0.f, 0.f, 0.f};
    for (int kk = 0; kk < 128; kk += 8) {
        float wv[8];
#pragma unroll
        for (int u = 0; u < 8; ++u) wv[u] = W[(size_t)(kbase + 2 * (kk + u) + kp) * 12288];
#pragma unroll
        for (int u = 0; u < 8; ++u) { const int k = kbase + 2 * (kk + u) + kp;
#pragma unroll
            for (int r = 0; r < 5; ++r) acc[r] += sc[r * D + k] * wv[u]; }
    }
#pragma unroll
    for (int r = 0; r < 5; ++r) { acc[r] += __shfl_xor(acc[r], 32); if (lane < 32) red[(wave * 5 + r) * 32 + lane] = acc[r]; }
    __syncthreads();
    if (tid < 160) { const int r = tid >> 5, cc = tid & 31; float s = 0.f;
#pragma unroll
        for (int w = 0; w < 8; ++w) s += red[(w * 5 + r) * 32 + cc];
        mod[(size_t)(l * 5 + r) * 12288 + n0 + cc] = s + F.in[I_BADA][l * 12288 + n0 + cc]; }
    __syncthreads();
}
__device__ __forceinline__ void conv_tile(Frame& F, int t, LAS float* scr, int lane) {
    if (t < 3072) { const int kb = t / 96, n0 = (t % 96) * 64; int dr; if (n0 < 2048) dr = n0; else if (n0 < 4096) { const int q = n0 - 2048; dr = 2048 + (q >> 7) * 256 + (q & 127); } else { const int q = n0 - 4096; dr = 2048 + (q >> 7) * 256 + 128 + (q & 127); }
        cvt_tile(F.in[I_CWIN] + (size_t)kb * 64 * 6144 + n0, 6144, (bf16*)(F.ws + WS_WT_CIN) + (size_t)dr * D + kb * 64, D, 1.f, scr, lane); }
    else { t -= 3072; const int kb = t / 32, n0 = (t % 32) * 64;
        cvt_tile(F.in[I_CWOUT] + (size_t)kb * 64 * D + n0, D, (bf16*)(F.ws + WS_WT_COUT) + (size_t)n0 * D + kb * 64, D, 1.f, scr, lane); }
}
__device__ __forceinline__ void ml_tile(Frame& F, int t, LAS float* scr, int lane) {
    const float QS = 0.08838834764831845f;
    if (t < 3072) { const int kb = t / 96, n0 = (t % 96) * 64;
        cvt_tile(F.in[I_MWIN] + (size_t)kb * 64 * MLW + n0, MLW, (bf16*)(F.ws + WS_WT_MIN) + (size_t)n0 * D + kb * 64, D, n0 < 1024 ? QS : 1.f, scr, lane); }
    else { t -= 3072; const int kb = t / 32, n0 = (t % 32) * 64;
        cvt_tile(F.in[I_MWOUT] + (size_t)kb * 64 * D + n0, D, (bf16*)(F.ws + WS_WT_MOUT) + (size_t)n0 * D + kb * 64, D, 1.f, scr, lane); }
}
__device__ __forceinline__ void exp_tile(Frame& F, int l, int t, LAS float* scr, int lane) {
    if (t < 16384) { const int up = t >= 8192; if (up) t -= 8192; const int le = l * NE + t / 512, q = t % 512, kb = q / 16, n0 = (q % 16) * 64;
        const float* src = (up ? F.in[I_EWU] : F.in[I_EWG]) + (size_t)le * D * DE + (size_t)kb * 64 * DE + n0;
        const int dr = (n0 >> 7) * 256 + (up ? 128 : 0) + (n0 & 127);
        cvt_tile(src, DE, (bf16*)(F.ws + WS_WT_E1) + (size_t)le * D * D + (size_t)dr * D + kb * 64, D, 1.f, scr, lane); }
    else { t -= 16384; const int le = l * NE + t / 512, q = t % 512, kb = q / 32, n0 = (q % 32) * 64;
        cvt_tile(F.in[I_EWD] + (size_t)le * DE * D + (size_t)kb * 64 * D + n0, D, (bf16*)(F.ws + WS_WT_E2) + (size_t)le * D * DE + (size_t)n0 * DE + kb * 64, DE, 1.f, scr, lane); }
}
constexpr int Q_E0 = 3072, Q_GV1 = Q_E0 + 384, Q_ML = Q_GV1 + 512, Q_END = Q_ML + 3072;
constexpr int CW_QHEAD = 8192;
__device__ __forceinline__ void bg_item(Frame& F, int it, int tid, int lane, int wave) {
    LAS float* scr = (LAS float*)(F.lds + wave * 16640);
    if (it < Q_E0) exp_tile(F, 0, it * 8 + wave, scr, lane);
    else if (it < Q_GV1) gemv_item(F, 1, it - Q_E0, tid, lane, wave);
    else if (it < Q_ML) ml_tile(F, (it - Q_GV1) * 8 + wave, scr, lane);
    else exp_tile(F, 1, (it - Q_ML) * 8 + wave, scr, lane);
}
#ifndef BG_STREAM
#define BG_STREAM 1
#endif
__device__ __forceinline__ void bg_pull(Frame& F, int floor, int phase, unsigned target) {
    if (!BG_STREAM) return;
    PHASE_IDS();
    unsigned* ctl = (unsigned*)(F.ws + WS_CTL);
    LAS unsigned* bc = (LAS unsigned*)(F.lds + LDS_MISC + 128);
    unsigned nxt = 0xffffffffu;
#define BG_CLAIM() do { nxt = 0xffffffffu; \
        if (__hip_atomic_load(ctl + CW_QHEAD + 64 * (1 + phase), __ATOMIC_RELAXED, __HIP_MEMORY_SCOPE_AGENT) < target) { \
            nxt = __hip_atomic_fetch_add(ctl + CW_QHEAD, 1u, __ATOMIC_RELAXED, __HIP_MEMORY_SCOPE_AGENT); if (nxt >= (unsigned)Q_END) nxt = 0xffffffffu; } } while (0)
    if (tid == 0) { if (floor > 0) __hip_atomic_fetch_max(ctl + CW_QHEAD, (unsigned)floor, __ATOMIC_RELAXED, __HIP_MEMORY_SCOPE_AGENT); BG_CLAIM(); }
    for (;;) {
        __syncthreads();
        if (tid == 0) *bc = nxt;
        __syncthreads();
        const unsigned it = *bc;
        if (it == 0xffffffffu) break;
        if (tid == 0) BG_CLAIM();
        bg_item(F, (int)it, tid, lane, wave);
    }
#undef BG_CLAIM
}
__device__ __forceinline__ void bg_drain(Frame& F, int limit, int prev_floor) {
    PHASE_IDS();
    int h = (int)__hip_atomic_load((unsigned*)(F.ws + WS_CTL) + CW_QHEAD, __ATOMIC_RELAXED, __HIP_MEMORY_SCOPE_AGENT); if (h < prev_floor) h = prev_floor;
    if (h >= limit) return;
    LAS float* scr = (LAS float*)(F.lds + wave * 16640);
    const int gw = F.bid * NWAVES + wave, NGW = F.G * NWAVES;
    __syncthreads();
    { const int lo = h, hi = limit < Q_E0 ? limit : Q_E0; for (int t = lo * 8 + gw; t < hi * 8; t += NGW) exp_tile(F, 0, t, scr, lane); }
    { const int lo = h > Q_GV1 ? h : Q_GV1, hi = limit < Q_ML ? limit : Q_ML; for (int t = (lo - Q_GV1) * 8 + gw; t < (hi - Q_GV1) * 8; t += NGW) ml_tile(F, t, scr, lane); }
    { const int lo = h > Q_ML ? h : Q_ML, hi = limit < Q_END ? limit : Q_END; for (int t = (lo - Q_ML) * 8 + gw; t < (hi - Q_ML) * 8; t += NGW) exp_tile(F, 1, t, scr, lane); }
    __syncthreads();
    { const int lo = h > Q_E0 ? h : Q_E0, hi = limit < Q_GV1 ? limit : Q_GV1; for (int it = lo + F.bid; it < hi; it += F.G) gemv_item(F, 1, it - Q_E0, tid, lane, wave); }
}
__device__ __forceinline__ unsigned* bg_word(Frame& F, int phase) { return (unsigned*)(F.ws + WS_CTL) + CW_QHEAD + 64 * (1 + phase); }
__device__ __forceinline__ void bg_signal_done(Frame& F, int phase) {
    if (threadIdx.x == 0) __hip_atomic_fetch_add((unsigned*)(F.ws + WS_CTL) + CW_QHEAD + 64 * (1 + phase), 1u, __ATOMIC_RELAXED, __HIP_MEMORY_SCOPE_AGENT);
}
__device__ __forceinline__ void p0_prologue(Frame& F) {
    PHASE_IDS();
    for (int it = F.bid; it < 384; it += F.G) gemv_item(F, 0, it, tid, lane, wave);
    LAS float* scr = (LAS float*)(F.lds + wave * 16640);
    const int gw = F.bid * NWAVES + wave, NGW = F.G * NWAVES;
    for (int t = gw; t < 4096; t += NGW) conv_tile(F, t, scr, lane);
    { bf16* wt = (bf16*)(F.ws + WS_WT_MIN) + (size_t)MLW * D; const float* wg = F.in[I_MWG];
      for (int idx = F.bid * NTHR + tid; idx < 256 * D; idx += F.G * NTHR) { const int n = idx / D, k = idx % D; const float v = n < 32 ? wg[k * 32 + n] : 0.f; wt[idx] = (bf16)(cvt_pk_bf16(v, 0.f) & 0xffffu); } }
}

#define SCHED_FENCE() __builtin_amdgcn_sched_barrier(0)
__device__ __forceinline__ void p1_modulate(Frame& F) {
    PHASE_IDS();
    const int gw = F.bid * NWAVES + wave;
    bf16* HA = (bf16*)(F.ws + WS_HA);
    f32x4 a[8], b[8], x[8], xn[8];
    { const int r = (8 * gw) >> 12; const float* sh = mod_vec(F, 0, r, 0); const float* scv = mod_vec(F, 0, r, 1);
#pragma unroll
      for (int j = 0; j < 8; ++j) { const int c = 256 * j + 4 * lane; a[j] = *(const f32x4*)(scv + c) + 1.0f; b[j] = *(const f32x4*)(sh + c); xn[j] = *(const f32x4*)(F.in[I_X] + (size_t)(8 * gw) * D + c); } }
    for (int i = 0; i < 8; ++i) { const int row = 8 * gw + i;
#pragma unroll
        for (int j = 0; j < 8; ++j) x[j] = xn[j];
        if (i < 7) {
#pragma unroll
            for (int j = 0; j < 8; ++j) xn[j] = *(const f32x4*)(F.in[I_X] + (size_t)(row + 1) * D + 256 * j + 4 * lane); }
        SCHED_FENCE();
#pragma unroll
        for (int j = 0; j < 8; ++j) { const f32x4 h = x[j] * a[j] + b[j]; u32x2 o; o.x = cvt_pk_bf16(h[0], h[1]); o.y = cvt_pk_bf16(h[2], h[3]); *(u32x2*)(HA + (size_t)row * D + 256 * j + 4 * lane) = o; }
    }
    if (gw < NCTX) { const float* sh = mod_vec(F, 0, 4, 0); const float* scv = mod_vec(F, 0, 4, 1);
#pragma unroll
        for (int j = 0; j < 8; ++j) { const int c = 256 * j + 4 * lane; a[j] = *(const f32x4*)(scv + c) + 1.0f; b[j] = *(const f32x4*)(sh + c); x[j] = *(const f32x4*)(F.in[I_CTX] + (size_t)gw * D + c); }
        SCHED_FENCE();
#pragma unroll
        for (int j = 0; j < 8; ++j) { const f32x4 h = x[j] * a[j] + b[j]; u32x2 o; o.x = cvt_pk_bf16(h[0], h[1]); o.y = cvt_pk_bf16(h[2], h[3]); *(u32x2*)(HA + (size_t)(NLAT + gw) * D + 256 * j + 4 * lane) = o; } }
}

__device__ __forceinline__ void p3_conv(Frame& F) {
    PHASE_IDS();
    const int gw = F.bid * NWAVES + wave, NGW = F.G * NWAVES;
    const bf16* BG = (const bf16*)(F.ws + WS_RB); const bf16* Z = (const bf16*)(F.ws + WS_RC); bf16* U = (bf16*)(F.ws + WS_HA);
    const float* cw = F.in[I_CW];
    f32x4 wt[4][3][2];
#pragma unroll
    for (int j = 0; j < 4; ++j)
#pragma unroll
        for (int t = 0; t < 3; ++t) { wt[j][t][0] = *(const f32x4*)(cw + t * D + 512 * j + 8 * lane); wt[j][t][1] = *(const f32x4*)(cw + t * D + 512 * j + 8 * lane + 4); }
    for (int row = gw; row < NTOK; row += NGW) {
        u32x4 zc[4], bg[4], zp[4], zn[4];
        int dpa, dna, dpb, dnb; bool vpa, vna, vpb, vnb;
        if (row < NLAT) { const int s = row & (SEQ - 1), gc = s & 63, gr = s >> 6; vpa = gc > 0; vna = gc < 63; dpa = -1; dna = 1; vpb = gr > 0; vnb = gr < 63; dpb = -64; dnb = 64; }
        else { const int t = (row - NLAT) & (CTXL - 1); vpa = vpb = t > 0; vna = vnb = t < CTXL - 1; dpa = dpb = -1; dna = dnb = 1; }
#pragma unroll
        for (int j = 0; j < 4; ++j) { const int c = 512 * j + 8 * lane; const bool vp = j < 2 ? vpa : vpb, vn = j < 2 ? vna : vnb; const int dp = j < 2 ? dpa : dpb, dn = j < 2 ? dna : dnb;
            zc[j] = *(const u32x4*)(Z + (size_t)row * D + c); bg[j] = *(const u32x4*)(BG + (size_t)row * D + c);
            zp[j] = *(const u32x4*)(Z + (size_t)(vp ? row + dp : row) * D + c); zn[j] = *(const u32x4*)(Z + (size_t)(vn ? row + dn : row) * D + c);
            if (!vp) zp[j] = (u32x4){0u, 0u, 0u, 0u}; if (!vn) zn[j] = (u32x4){0u, 0u, 0u, 0u}; }
        SCHED_FENCE();
#pragma unroll
        for (int j = 0; j < 4; ++j) { float o[8];
#pragma unroll
            for (int q = 0; q < 4; ++q) {
                const float w0l = wt[j][0][q >> 1][2 * (q & 1)], w0h = wt[j][0][q >> 1][2 * (q & 1) + 1], w1l = wt[j][1][q >> 1][2 * (q & 1)], w1h = wt[j][1][q >> 1][2 * (q & 1) + 1], w2l = wt[j][2][q >> 1][2 * (q & 1)], w2h = wt[j][2][q >> 1][2 * (q & 1) + 1];
                o[2 * q] = bf_lo(bg[j][q]) * (w0l * bf_lo(zp[j][q]) + w1l * bf_lo(zc[j][q]) + w2l * bf_lo(zn[j][q]));
                o[2 * q + 1] = bf_hi(bg[j][q]) * (w0h * bf_hi(zp[j][q]) + w1h * bf_hi(zc[j][q]) + w2h * bf_hi(zn[j][q])); }
            u32x4 w; w.x = cvt_pk_bf16(o[0], o[1]); w.y = cvt_pk_bf16(o[2], o[3]); w.z = cvt_pk_bf16(o[4], o[5]); w.w = cvt_pk_bf16(o[6], o[7]);
            *(u32x4*)(U + (size_t)row * D + 512 * j + 8 * lane) = w; }
    }
}

__device__ __forceinline__ void lnB_phase(Frame& F, int layer) {
    PHASE_IDS();
    const int nrows = layer == 0 ? 68 : 64;
    const float* lg = F.in[I_LNG] + (layer * 2 + 1) * D; const float* lb = F.in[I_LNB] + (layer * 2 + 1) * D;
    const bf16* EX = (const bf16*)(F.ws + WS_REX);
#define LNB_ROW(li) ((li) < 64 ? F.bid * 64 + (li) : NLAT + F.bid * 4 + ((li) - 64))
#define LNB_XP(li) ((li) < 64 ? F.out + (size_t)(F.bid * 64 + (li)) * D : (float*)(F.ws + WS_CTXRES) + (size_t)(F.bid * 4 + ((li) - 64)) * D)
#define LNB_LOAD(li, X, E0, E1) do { const float* xp_ = LNB_XP(li); const bf16* ep_ = EX + (size_t)LNB_ROW(li) * D; \
        _Pragma("unroll") for (int j = 0; j < 8; ++j) { X[j] = *(const f32x4*)(xp_ + 256 * j + 4 * lane); E0[j] = *(const u32x2*)(ep_ + 256 * j + 4 * lane); E1[j] = *(const u32x2*)(ep_ + (size_t)NTOK * D + 256 * j + 4 * lane); } } while (0)
    f32x4 xn_[8]; u32x2 e0_[8], e1_[8];
    if (wave < nrows) LNB_LOAD(wave, xn_, e0_, e1_);
    for (int li = wave; li < nrows; li += NWAVES) {
        const int row = LNB_ROW(li); const int mr = mod_row(row);
        float* xout = LNB_XP(li);
        const float* gv = mod_vec(F, layer, mr, 5);
        f32x4 v[8]; float s = 0.f;
#pragma unroll
        for (int j = 0; j < 8; ++j) { const f32x4 g = *(const f32x4*)(gv + 256 * j + 4 * lane);
            const f32x4 m = (f32x4){bf_lo(e0_[j].x) + bf_lo(e1_[j].x), bf_hi(e0_[j].x) + bf_hi(e1_[j].x), bf_lo(e0_[j].y) + bf_lo(e1_[j].y), bf_hi(e0_[j].y) + bf_hi(e1_[j].y)};
            v[j] = xn_[j] * ALPHA + g * m; s += (v[j][0] + v[j][1]) + (v[j][2] + v[j][3]); }
        if (li + NWAVES < nrows) LNB_LOAD(li + NWAVES, xn_, e0_, e1_);
        f32x4 L[8], B[8];
#pragma unroll
        for (int j = 0; j < 8; ++j) { const int c = 256 * j + 4 * lane; L[j] = *(const f32x4*)(lg + c); B[j] = *(const f32x4*)(lb + c); }
        SCHED_FENCE();
        const float mean = wave_sum(s) * (1.f / D); float s2 = 0.f;
#pragma unroll
        for (int j = 0; j < 8; ++j) { v[j] = v[j] - mean; s2 += (v[j][0] * v[j][0] + v[j][1] * v[j][1]) + (v[j][2] * v[j][2] + v[j][3] * v[j][3]); }
        const float rstd = 1.0f / sqrtf(wave_sum(s2) * (1.f / D) + LN_EPS);
#pragma unroll
        for (int j = 0; j < 8; ++j) { const int c = 256 * j + 4 * lane; v[j] = v[j] * rstd * L[j] + B[j]; *(f32x4*)(xout + c) = v[j]; }
        if (layer == 0) {
            const float* sh = mod_vec(F, 1, mr, 0); const float* scv = mod_vec(F, 1, mr, 1);
#pragma unroll
            for (int j = 0; j < 8; ++j) { const int c = 256 * j + 4 * lane; L[j] = *(const f32x4*)(scv + c); B[j] = *(const f32x4*)(sh + c); }
            SCHED_FENCE();
            bf16* HA = (bf16*)(F.ws + WS_HA) + (size_t)row * D;
#pragma unroll
            for (int j = 0; j < 8; ++j) { const int c = 256 * j + 4 * lane; const f32x4 h = v[j] * (L[j] + 1.0f) + B[j]; u32x2 o; o.x = cvt_pk_bf16(h[0], h[1]); o.y = cvt_pk_bf16(h[2], h[3]); *(u32x2*)(HA + c) = o; }
        }
    }
#undef LNB_ROW
#undef LNB_XP
#undef LNB_LOAD
}

constexpr int LDS_LOGITS = RING_BYTES;
__device__ __forceinline__ void lnA_phase(Frame& F, int layer) {
    PHASE_IDS();
    LAS float* RwL = (LAS float*)F.lds;
    LAS float* LG = (LAS float*)(F.lds + LDS_LOGITS);
    LAS int* cnt = (LAS int*)(F.lds + LDS_MISC + 64);
    for (int idx = tid; idx < D * 4; idx += NTHR) { const int c = idx >> 2, e4 = (idx & 3) * 4; const f32x4 w = *(const f32x4*)(F.in[I_RW] + c * 16 + e4);
        RwL[(e4 + 0) * D + c] = w[0]; RwL[(e4 + 1) * D + c] = w[1]; RwL[(e4 + 2) * D + c] = w[2]; RwL[(e4 + 3) * D + c] = w[3]; }
    if (tid < 16) cnt[tid] = 0;
    __syncthreads();
    const int nrows = layer == 0 ? 68 : 64;
    const float* lg = F.in[I_LNG] + (layer * 2) * D; const float* lb = F.in[I_LNB] + (layer * 2) * D;
    const bf16* MX = (const bf16*)(F.ws + WS_RB);
#define LNA_ROW(li) ((li) < 64 ? F.bid * 64 + (li) : NLAT + F.bid * 4 + ((li) - 64))
#define LNA_XIN(li) ((li) < 64 ? (layer == 0 ? F.in[I_X] + (size_t)(F.bid * 64 + (li)) * D : F.out + (size_t)(F.bid * 64 + (li)) * D) : F.in[I_CTX] + (size_t)(F.bid * 4 + ((li) - 64)) * D)
#define LNA_LOAD(li, X, M) do { const float* xp_ = LNA_XIN(li); const bf16* mp_ = MX + (size_t)LNA_ROW(li) * D; \
        _Pragma("unroll") for (int j = 0; j < 8; ++j) { X[j] = *(const f32x4*)(xp_ + 256 * j + 4 * lane); M[j] = *(const u32x2*)(mp_ + 256 * j + 4 * lane); } } while (0)
    f32x4 xn_[8]; u32x2 mn_[8];
    if (wave < nrows) LNA_LOAD(wave, xn_, mn_);
    for (int li = wave; li < nrows; li += NWAVES) {
        const int row = LNA_ROW(li); const int mr = mod_row(row);
        float* xout = li < 64 ? F.out + (size_t)row * D : (float*)(F.ws + WS_CTXRES) + (size_t)(row - NLAT) * D;
        const float* gv = mod_vec(F, layer, mr, 2); const float* sh = mod_vec(F, layer, mr, 3); const float* scv = mod_vec(F, layer, mr, 4);
        f32x4 v[8]; float s = 0.f;
#pragma unroll
        for (int j = 0; j < 8; ++j) { const f32x4 g = *(const f32x4*)(gv + 256 * j + 4 * lane); const f32x4 m = (f32x4){bf_lo(mn_[j].x), bf_hi(mn_[j].x), bf_lo(mn_[j].y), bf_hi(mn_[j].y)};
            v[j] = xn_[j] * ALPHA + g * m; s += (v[j][0] + v[j][1]) + (v[j][2] + v[j][3]); }
        if (li + NWAVES < nrows) LNA_LOAD(li + NWAVES, xn_, mn_);
        f32x4 L[8], B[8], S[8], H[8];
#pragma unroll
        for (int j = 0; j < 8; ++j) { const int c = 256 * j + 4 * lane; L[j] = *(const f32x4*)(lg + c); B[j] = *(const f32x4*)(lb + c); S[j] = *(const f32x4*)(scv + c); H[j] = *(const f32x4*)(sh + c); }
        SCHED_FENCE();
        const float mean = wave_sum(s) * (1.f / D); float s2 = 0.f;
#pragma unroll
        for (int j = 0; j < 8; ++j) { v[j] = v[j] - mean; s2 += (v[j][0] * v[j][0] + v[j][1] * v[j][1]) + (v[j][2] * v[j][2] + v[j][3] * v[j][3]); }
        const float rstd = 1.0f / sqrtf(wave_sum(s2) * (1.f / D) + LN_EPS);
        bf16* HA = (bf16*)(F.ws + WS_HA) + (size_t)row * D;
#pragma unroll
        for (int j = 0; j < 8; ++j) { const int c = 256 * j + 4 * lane; v[j] = v[j] * rstd * L[j] + B[j]; *(f32x4*)(xout + c) = v[j];
            v[j] = v[j] * (S[j] + 1.0f) + H[j];
            u32x2 o; o.x = cvt_pk_bf16(v[j][0], v[j][1]); o.y = cvt_pk_bf16(v[j][2], v[j][3]); *(u32x2*)(HA + c) = o; }
        float p[16]; f32x4 wA[8], wB[8];
#pragma unroll
        for (int j = 0; j < 8; ++j) wA[j] = *(const LAS f32x4*)(RwL + 256 * j + 4 * lane);
#pragma unroll
        for (int e = 0; e < 16; ++e) {
            if (e + 1 < 16) {
#pragma unroll
                for (int j = 0; j < 8; ++j) { const f32x4 t = *(const LAS f32x4*)(RwL + (e + 1) * D + 256 * j + 4 * lane); if (e & 1) wA[j] = t; else wB[j] = t; } }
            SCHED_FENCE();
            f32x4 a4 = (f32x4){0.f, 0.f, 0.f, 0.f};
#pragma unroll
            for (int j = 0; j < 8; ++j) a4 += v[j] * ((e & 1) ? wB[j] : wA[j]);
            p[e] = (a4[0] + a4[1]) + (a4[2] + a4[3]);
            SCHED_FENCE();
        }
        float q8[8], q4[4], q2[2], q1;
        { const bool hi = (lane & 32) != 0;
#pragma unroll
          for (int i = 0; i < 8; ++i) { const float keep = hi ? p[8 + i] : p[i], give = hi ? p[i] : p[8 + i]; q8[i] = keep + __shfl_xor(give, 32); } }
        { const bool hi = (lane & 16) != 0;
#pragma unroll
          for (int i = 0; i < 4; ++i) { const float keep = hi ? q8[4 + i] : q8[i], give = hi ? q8[i] : q8[4 + i]; q4[i] = keep + __shfl_xor(give, 16); } }
        { const bool hi = (lane & 8) != 0;
#pragma unroll
          for (int i = 0; i < 2; ++i) { const float keep = hi ? q4[2 + i] : q4[i], give = hi ? q4[i] : q4[2 + i]; q2[i] = keep + __shfl_xor(give, 8); } }
        { const bool hi = (lane & 4) != 0; const float keep = hi ? q2[1] : q2[0], give = hi ? q2[0] : q2[1]; q1 = keep + __shfl_xor(give, 4); }
        q1 += __shfl_xor(q1, 1); q1 += __shfl_xor(q1, 2);
        if ((lane & 3) == 0) LG[li * 16 + (lane >> 2)] = q1;
    }
    __syncthreads();
    if (tid < nrows) {
        const int row = LNA_ROW(tid);
        float sg[16], sel[16];
#pragma unroll
        for (int e4 = 0; e4 < 4; ++e4) { const f32x4 l4 = *(const LAS f32x4*)(LG + tid * 16 + 4 * e4); const f32x4 rb4 = *(const f32x4*)(F.in[I_RB] + 4 * e4);
#pragma unroll
            for (int i = 0; i < 4; ++i) { sg[4 * e4 + i] = 1.0f / (1.0f + expf(-l4[i])); sel[4 * e4 + i] = sg[4 * e4 + i] + rb4[i]; } }
        float grp[4];
#pragma unroll
        for (int g = 0; g < 4; ++g) { const float a = sel[4 * g], b = sel[4 * g + 1], c = sel[4 * g + 2], d = sel[4 * g + 3];
            const float h1 = fmaxf(a, b), l1 = fminf(a, b), h2 = fmaxf(c, d), l2 = fminf(c, d); grp[g] = fmaxf(h1, h2) + fmaxf(fminf(h1, h2), fmaxf(l1, l2)); }
        int gb = 0; float best = grp[0];
#pragma unroll
        for (int g = 1; g < 4; ++g) if (grp[g] > best) { best = grp[g]; gb = g; }
        float cs[4], cg[4];
#pragma unroll
        for (int i = 0; i < 4; ++i) { cs[i] = gb == 0 ? sel[i] : gb == 1 ? sel[4 + i] : gb == 2 ? sel[8 + i] : sel[12 + i]; cg[i] = gb == 0 ? sg[i] : gb == 1 ? sg[4 + i] : gb == 2 ? sg[8 + i] : sg[12 + i]; }
        int i0 = 0; float b0 = cs[0];
#pragma unroll
        for (int i = 1; i < 4; ++i) if (cs[i] > b0) { b0 = cs[i]; i0 = i; }
        int i1 = -1; float b1 = 0.f;
#pragma unroll
        for (int i = 0; i < 4; ++i) if (i != i0 && (i1 < 0 || cs[i] > b1)) { b1 = cs[i]; i1 = i; }
        const float s0 = i0 == 0 ? cg[0] : i0 == 1 ? cg[1] : i0 == 2 ? cg[2] : cg[3], s1 = i1 == 0 ? cg[0] : i1 == 1 ? cg[1] : i1 == 2 ? cg[2] : cg[3];
        const float den = s0 + s1; const int e0 = 4 * gb + i0, e1 = 4 * gb + i1;
        int* rt = (int*)(F.ws + WS_ROUTE) + (size_t)row * 4; rt[0] = e0; rt[1] = e1; ((float*)rt)[2] = s0 / den; ((float*)rt)[3] = s1 / den;
        __hip_atomic_fetch_add(cnt + e0, 1, __ATOMIC_RELAXED, __HIP_MEMORY_SCOPE_WORKGROUP); __hip_atomic_fetch_add(cnt + e1, 1, __ATOMIC_RELAXED, __HIP_MEMORY_SCOPE_WORKGROUP);
    }
    __syncthreads();
    if (tid < 16) ((int*)(F.ws + WS_BLKCNT))[F.bid * 16 + tid] = cnt[tid];
#undef LNA_ROW
#undef LNA_XIN
#undef LNA_LOAD
}

__device__ __forceinline__ void list_phase(Frame& F, int layer) {
    PHASE_IDS();
    LAS int* bc = (LAS int*)F.lds;
    LAS int* base = bc + 4096;
    LAS int* tot = base + 16;
    LAS int* tpre = tot + 16;
    const int* blk = (const int*)(F.ws + WS_BLKCNT);
    for (int idx = tid; idx < 4096; idx += NTHR) bc[idx] = blk[idx];
    __syncthreads();
    if (tid < 16) { int s = 0, b0 = 0; for (int b = 0; b < 256; ++b) { if (b == F.bid) b0 = s; s += bc[b * 16 + tid]; } base[tid] = b0; tot[tid] = s; }
    __syncthreads();
    if (tid == 0) { int t = 0; for (int e = 0; e < 16; ++e) { tpre[e] = t; t += (tot[e] + 255) >> 8; } tpre[16] = t; }
    __syncthreads();
    int* srow = (int*)(F.ws + WS_SROW); float* swt = (float*)(F.ws + WS_SWT);
    if (tid < 16) { const int e = tid; int pos = tpre[e] * 256 + base[e];
        const int nrows = (layer == 0) ? 68 : 64;
        for (int i = 0; i < nrows; ++i) { const int row = i < 64 ? F.bid * 64 + i : NLAT + F.bid * 4 + (i - 64);
            const int* rt = (const int*)(F.ws + WS_ROUTE) + (size_t)row * 4; const int e0 = rt[0], e1 = rt[1];
            if (e0 == e) { srow[pos] = row * 2; swt[pos] = ((const float*)rt)[2]; ++pos; }
            if (e1 == e) { srow[pos] = row * 2 + 1; swt[pos] = ((const float*)rt)[3]; ++pos; } } }
    if (F.bid < 16) { const int e = F.bid, lo = tpre[e] * 256 + tot[e], hi = tpre[e + 1] * 256; for (int p = lo + tid; p < hi; p += NTHR) { srow[p] = -1; swt[p] = 0.f; } }
    if (F.bid == 0) { int* te = (int*)(F.ws + WS_TILEE); for (int t = tid; t < tpre[16]; t += NTHR) { int e = 0; for (int q = 1; q < 16; ++q) if (t >= tpre[q]) e = q; te[t] = e; } if (tid == 0) *(int*)(F.ws + WS_TTOT) = tpre[16]; }
}

__device__ __forceinline__ void moe_gemm1(Frame& F, int layer, int phase) {
    PHASE_IDS();
    LAS int* te = (LAS int*)(F.lds + LDS_TILEE);
    const int T = *(const int*)(F.ws + WS_TTOT);
    for (int t = tid; t < T && t < 160; t += NTHR) te[t] = ((const int*)(F.ws + WS_TILEE))[t];
    __syncthreads();
    pg8::SchedMoe S; S.A = (const char*)(F.ws + WS_HA); S.Bt = (const char*)(F.ws + WS_WT_E1) + (size_t)layer * NE * D * D * 2; S.srow = (const int*)(F.ws + WS_SROW); S.tile_e = te;
    const int rounds = (8 * T + F.G - 1) / F.G, NG = BG_STREAM ? (8 * T + rounds - 1) / rounds : F.G;
    S.nM = T; S.nN = 8; S.G = NG; S.c = F.bid; S.tstepA = 0; S.tstepB = (size_t)256 * D * 2; S.estepB = (size_t)D * D * 2;
    if (F.bid < NG) { pg8::EpiMoe1 E{(bf16*)(F.ws + WS_RH)};
        pg8::gemm_phase<pg8::EpiMoe1, pg8::SchedMoe, true>(F.lds, F.wave0, D, S, E, bg_word(F, phase)); }
    if (layer == 0) bg_pull(F, Q_GV1, phase, (unsigned)(NG / 2));
}
__device__ __forceinline__ void moe_gemm2(Frame& F, int layer, int phase) {
    PHASE_IDS();
    LAS int* te = (LAS int*)(F.lds + LDS_TILEE);
    const int T = *(const int*)(F.ws + WS_TTOT);
    for (int t = tid; t < T && t < 160; t += NTHR) te[t] = ((const int*)(F.ws + WS_TILEE))[t];
    __syncthreads();
    pg8::SchedMoe S; S.A = (const char*)(F.ws + WS_RH); S.Bt = (const char*)(F.ws + WS_WT_E2) + (size_t)layer * NE * D * DE * 2; S.srow = nullptr; S.tile_e = te;
    const int rounds = (8 * T + F.G - 1) / F.G, NG = BG_STREAM ? (8 * T + rounds - 1) / rounds : F.G;
    S.nM = T; S.nN = 8; S.G = NG; S.c = F.bid; S.tstepA = (size_t)256 * DE * 2; S.tstepB = (size_t)256 * DE * 2; S.estepB = (size_t)D * DE * 2;
    if (F.bid < NG) { pg8::EpiMoe2 E{(bf16*)(F.ws + WS_REX), (const int*)(F.ws + WS_SROW), (const float*)(F.ws + WS_SWT)};
        pg8::gemm_phase<pg8::EpiMoe2, pg8::SchedMoe, false>(F.lds, F.wave0, DE, S, E, bg_word(F, phase)); }
    if (layer == 0) bg_pull(F, Q_GV1, phase, (unsigned)(NG / 2));
}

constexpr int SC_QS = 0, SC_KS = 17408, SC_VS = 34816, SC_VW = 46080, SC_PS = 57344, SC_CB0 = 66560, SC_CB1 = 88320, SC_GA = 110080;
constexpr int QP = 136, VP = 88, PP = 72;
__device__ __forceinline__ bf16x8 lds_row8(const LAS unsigned char* base, int row, int pitch, int col) { return *(const LAS bf16x8*)(base + (row * pitch + col) * 2); }
typedef short v4i16_t __attribute__((ext_vector_type(4)));
__device__ __forceinline__ bf16x8 lds_tr8(const LAS unsigned char* base, int pitch, int k0, int x0, int lane) {
    const int g = lane >> 4, q = (lane & 15) >> 2, p = lane & 3;
    const LAS unsigned char* a = base + ((k0 + 8 * g + q) * pitch + x0 + 4 * p) * 2;
    const s16x4 lo = __builtin_bit_cast(s16x4, __builtin_amdgcn_ds_read_tr16_b64_v4i16((LAS v4i16_t*)a));
    const s16x4 hi = __builtin_bit_cast(s16x4, __builtin_amdgcn_ds_read_tr16_b64_v4i16((LAS v4i16_t*)(a + 4 * pitch * 2)));
    return (bf16x8){lo[0], lo[1], lo[2], lo[3], hi[0], hi[1], hi[2], hi[3]};
}
constexpr size_t WS_GSCR = 810 * MiB;
__device__ __forceinline__ float fexp(float x) { return __builtin_amdgcn_exp2f(x * 1.44269504088896f); }
__device__ __forceinline__ void scan_phase(Frame& F) {
    PHASE_IDS();
    const int x8 = F.bid & 7, y = F.bid >> 3, vs = y & 3, grp = x8 * 8 + (y >> 2), dir = grp & 1, hh = (grp >> 1) & 7, bb = grp >> 4;
    const int w = wave, i16 = lane & 15, g = lane >> 4;
    const bf16* QKVO = (const bf16*)(F.ws + WS_RC); const float* GT = (const float*)(F.ws + WS_GATES);
    bf16* HOUT = dir == 0 ? (bf16*)(F.ws + WS_RB) : (bf16*)(F.ws + WS_HB2);
    float* GS = (float*)(F.ws + WS_GSCR) + (size_t)F.bid * (68 * 192);
    LAS unsigned char* L = F.lds;
    LAS float* SE = (LAS float*)(L + SC_GA + 2560);
#define SCAN_TOK(step, r) ((step) < 4 ? (NLAT + bb * CTXL + (dir ? (CTXL - 1 - ((step) * 64 + (r))) : ((step) * 64 + (r)))) : (bb * SEQ + (dir ? (SEQ - 1 - (((step) - 4) * 64 + (r))) : (((step) - 4) * 64 + (r)))))
    for (int idx = tid; idx < 64 * 24; idx += NTHR) { const int r = idx / 24, c = 64 + idx % 24; ((LAS bf16*)(L + SC_VS))[r * VP + c] = (c == 64) ? (bf16)0x3F80 : (bf16)0; ((LAS bf16*)(L + SC_VW))[r * VP + c] = 0; }
    { const float big = F.in[I_MBG][(dir * 2) * 8 + hh], bfg = F.in[I_MBG][(dir * 2 + 1) * 8 + hh];
      for (int step = w; step < 68; step += NWAVES) {
        const size_t tg = (size_t)SCAN_TOK(step, lane); const float gi = GT[tg * 32 + (dir * 2) * 8 + hh] + big, gf = GT[tg * 32 + (dir * 2 + 1) * 8 + hh] + bfg;
        const float lf = fminf(gf, 0.f) - log1pf(expf(-fabsf(gf)));
        float bc = lf;
#pragma unroll
        for (int o = 1; o < 64; o <<= 1) { const float t = __shfl_up(bc, o); if (lane >= o) bc += t; }
        const float a = gi - bc; float cm = a;
#pragma unroll
        for (int o = 1; o < 64; o <<= 1) { const float t = __shfl_up(cm, o); if (lane >= o) cm = fmaxf(cm, t); }
        GS[step * 192 + lane] = a; GS[step * 192 + 64 + lane] = bc; GS[step * 192 + 128 + lane] = cm;
        if (lane == 63) { SE[step] = bc; SE[68 + step] = cm; } } }
    __syncthreads();
    if (tid == 0) { float m = 0.f; for (int st = 0; st < 68; ++st) { SE[136 + st] = m; m = SE[st] + fmaxf(m, SE[68 + st]); } }
    f32x4 accc[5];
#pragma unroll
    for (int i = 0; i < 5; ++i) accc[i] = (f32x4){0.f, 0.f, 0.f, 0.f};
    const int qr0 = tid >> 4, qc = (tid & 15) * 8;
    const int vr = tid >> 3, vc = (tid & 7) * 8;
    u32x4 rq0, rq1, rk0, rk1, rv; float ga = 0.f, gb = 0.f, gc = 0.f, av = 0.f;
#define SCAN_LOAD(step) do { const size_t t0_ = (size_t)SCAN_TOK(step, qr0), t1_ = (size_t)SCAN_TOK(step, qr0 + 32), tv_ = (size_t)SCAN_TOK(step, vr); \
        if ((step) >= 4) { rq0 = *(const u32x4*)(QKVO + t0_ * MLW + hh * DQK + qc); rq1 = *(const u32x4*)(QKVO + t1_ * MLW + hh * DQK + qc); } \
        rk0 = *(const u32x4*)(QKVO + t0_ * MLW + 1024 + hh * DQK + qc); rk1 = *(const u32x4*)(QKVO + t1_ * MLW + 1024 + hh * DQK + qc); \
        rv = *(const u32x4*)(QKVO + tv_ * MLW + 2048 + hh * DV + vs * 64 + vc); av = GS[(step) * 192 + vr]; \
        if (w == 0) { ga = GS[(step) * 192 + lane]; gb = GS[(step) * 192 + 64 + lane]; gc = GS[(step) * 192 + 128 + lane]; } } while (0)
    __syncthreads();
    SCAN_LOAD(0);
    for (int step = 0; step < 68; ++step) {
        const bool outp = step >= 4;
        LAS float* GA = (LAS float*)(L + SC_GA) + (step & 1) * 320;
        LAS unsigned char* CBc = L + ((step & 1) ? SC_CB1 : SC_CB0); LAS unsigned char* CBn = L + ((step & 1) ? SC_CB0 : SC_CB1);
        const float m_st = SE[136 + step], Mend = fmaxf(m_st, SE[68 + step]), decay = fexp(m_st - Mend);
        __syncthreads();
        if (w == 0) { const float M = fmaxf(m_st, gc); GA[lane] = ga; GA[64 + lane] = M; GA[128 + lane] = fexp(m_st - M); GA[192 + lane] = fexp(-(gb + M)); }
        if (outp) { *(LAS u32x4*)(L + SC_QS + (qr0 * QP + qc) * 2) = rq0; *(LAS u32x4*)(L + SC_QS + ((qr0 + 32) * QP + qc) * 2) = rq1; }
        *(LAS u32x4*)(L + SC_KS + (qr0 * QP + qc) * 2) = rk0; *(LAS u32x4*)(L + SC_KS + ((qr0 + 32) * QP + qc) * 2) = rk1;
        *(LAS u32x4*)(L + SC_VS + (vr * VP + vc) * 2) = rv;
        { const float wr_ = fexp(av - Mend); u32x4 o; o.x = cvt_pk_bf16(bf_lo(rv.x) * wr_, bf_hi(rv.x) * wr_); o.y = cvt_pk_bf16(bf_lo(rv.y) * wr_, bf_hi(rv.y) * wr_); o.z = cvt_pk_bf16(bf_lo(rv.z) * wr_, bf_hi(rv.z) * wr_); o.w = cvt_pk_bf16(bf_lo(rv.w) * wr_, bf_hi(rv.w) * wr_);
          *(LAS u32x4*)(L + SC_VW + (vr * VP + vc) * 2) = o;
          if (vc == 0) ((LAS bf16*)(L + SC_VW))[vr * VP + 64] = (bf16)(cvt_pk_bf16(wr_, 0.f) & 0xffffu); }
        if (step + 1 < 68) SCAN_LOAD(step + 1);
        __syncthreads();
        const int tb = w & 3;
        if (outp) {
            const int sb0 = 2 * (w >> 2);
            f32x4 sa[2] = {(f32x4){0.f, 0.f, 0.f, 0.f}, (f32x4){0.f, 0.f, 0.f, 0.f}};
#pragma unroll
            for (int ks = 0; ks < 4; ++ks) { const bf16x8 bq = lds_row8(L + SC_QS, 16 * tb + i16, QP, 32 * ks + 8 * g);
#pragma unroll
                for (int j = 0; j < 2; ++j) { const bf16x8 ak = lds_row8(L + SC_KS, 16 * (sb0 + j) + i16, QP, 32 * ks + 8 * g); sa[j] = __builtin_amdgcn_mfma_f32_16x16x32_bf16(ak, bq, sa[j], 0, 0, 0); } }
            const int t = 16 * tb + i16; const float Mt = GA[64 + t];
#pragma unroll
            for (int j = 0; j < 2; ++j) { const int s0 = 16 * (sb0 + j) + 4 * g; const f32x4 a4 = *(const LAS f32x4*)(GA + s0); float p[4];
#pragma unroll
                for (int r = 0; r < 4; ++r) p[r] = (s0 + r <= t) ? fexp(a4[r] - Mt) * sa[j][r] : 0.f;
                u32x2 o; o.x = cvt_pk_bf16(p[0], p[1]); o.y = cvt_pk_bf16(p[2], p[3]); *(LAS u32x2*)(L + SC_PS + (t * PP + s0) * 2) = o; }
        }
#pragma unroll
        for (int i = 0; i < 5; ++i) accc[i] = accc[i] * decay;
#pragma unroll
        for (int ks = 0; ks < 2; ++ks) { const bf16x8 ak = lds_tr8(L + SC_KS, QP, 32 * ks, 16 * w, lane);
#pragma unroll
            for (int i = 0; i < 5; ++i) { const bf16x8 bv = lds_tr8(L + SC_VW, VP, 32 * ks, 16 * i, lane); accc[i] = __builtin_amdgcn_mfma_f32_16x16x32_bf16(ak, bv, accc[i], 0, 0, 0); } }
#pragma unroll
        for (int i = 0; i < 5; ++i) { u32x2 o; o.x = cvt_pk_bf16(accc[i][0], accc[i][1]); o.y = cvt_pk_bf16(accc[i][2], accc[i][3]); *(LAS u32x2*)(CBn + ((16 * i + i16) * QP + 16 * w + 4 * g) * 2) = o; }
        if (outp) {
            __syncthreads();
            const int half = w >> 2; const int vb[3] = {2 * half, 2 * half + 1, 4};
            f32x4 oa[3] = {(f32x4){0.f, 0.f, 0.f, 0.f}, (f32x4){0.f, 0.f, 0.f, 0.f}, (f32x4){0.f, 0.f, 0.f, 0.f}};
#pragma unroll
            for (int ks = 0; ks < 4; ++ks) { const bf16x8 bq = lds_row8(L + SC_QS, 16 * tb + i16, QP, 32 * ks + 8 * g);
#pragma unroll
                for (int j = 0; j < 3; ++j) { const bf16x8 ac = lds_row8(CBc, 16 * vb[j] + i16, QP, 32 * ks + 8 * g); oa[j] = __builtin_amdgcn_mfma_f32_16x16x32_bf16(ac, bq, oa[j], 0, 0, 0); } }
            const int t = 16 * tb + i16; const float it = GA[128 + t];
#pragma unroll
            for (int j = 0; j < 3; ++j) oa[j] = oa[j] * it;
#pragma unroll
            for (int ks = 0; ks < 2; ++ks) { const bf16x8 bp = lds_row8(L + SC_PS, 16 * tb + i16, PP, 32 * ks + 8 * g);
#pragma unroll
                for (int j = 0; j < 3; ++j) { const bf16x8 av8 = lds_tr8(L + SC_VS, VP, 32 * ks, 16 * vb[j], lane); oa[j] = __builtin_amdgcn_mfma_f32_16x16x32_bf16(av8, bp, oa[j], 0, 0, 0); } }
            const float den = __shfl(oa[2][0], i16);
            const float inv = __builtin_amdgcn_rcpf(fmaxf(fabsf(den), GA[192 + t]));
            const size_t tok = (size_t)SCAN_TOK(step, t);
#pragma unroll
            for (int j = 0; j < 2; ++j) { u32x2 o; o.x = cvt_pk_bf16(oa[j][0] * inv, oa[j][1] * inv); o.y = cvt_pk_bf16(oa[j][2] * inv, oa[j][3] * inv);
                *(u32x2*)(HOUT + tok * D + hh * DV + vs * 64 + 16 * vb[j] + 4 * g) = o; }
        }
    }
    __syncthreads();
#undef SCAN_TOK
#undef SCAN_LOAD
}

__device__ __forceinline__ void headnorm_phase(Frame& F) {
    PHASE_IDS();
    const int gw = F.bid * NWAVES + wave, NGW = F.G * NWAVES;
    const bf16* HF = (const bf16*)(F.ws + WS_RB); const bf16* HB = (const bf16*)(F.ws + WS_HB2); const bf16* QKVO = (const bf16*)(F.ws + WS_RC); bf16* Y = (bf16*)(F.ws + WS_HA);
    const float* ng = F.in[I_MNG];
    f32x4 gn[4][2];
#pragma unroll
    for (int j = 0; j < 4; ++j) { gn[j][0] = *(const f32x4*)(ng + 512 * j + 8 * lane); gn[j][1] = *(const f32x4*)(ng + 512 * j + 8 * lane + 4); }
    u32x4 an[4], bn[4], on[4];
#define HN_LOAD(row) do { _Pragma("unroll") for (int j = 0; j < 4; ++j) { const int c = 512 * j + 8 * lane; an[j] = *(const u32x4*)(HF + (size_t)(row) * D + c); bn[j] = *(const u32x4*)(HB + (size_t)(row) * D + c); on[j] = *(const u32x4*)(QKVO + (size_t)(row) * MLW + 4096 + c); } } while (0)
    if (gw < NLAT) HN_LOAD(gw);
    for (int row = gw; row < NLAT; row += NGW) {
        u32x4 a[4], b[4], o[4];
#pragma unroll
        for (int j = 0; j < 4; ++j) { a[j] = an[j]; b[j] = bn[j]; o[j] = on[j]; }
        if (row + NGW < NLAT) HN_LOAD(row + NGW);
        SCHED_FENCE();
#pragma unroll
        for (int j = 0; j < 4; ++j) {
            float h[8]; float s = 0.f;
#pragma unroll
            for (int q = 0; q < 4; ++q) { h[2 * q] = bf_lo(a[j][q]) + bf_lo(b[j][q]); h[2 * q + 1] = bf_hi(a[j][q]) + bf_hi(b[j][q]); s += h[2 * q] + h[2 * q + 1]; }
#pragma unroll
            for (int o2 = 1; o2 < 32; o2 <<= 1) s += __shfl_xor(s, o2);
            const float mean = s * (1.f / DV); float s2 = 0.f;
#pragma unroll
            for (int q = 0; q < 8; ++q) { h[q] -= mean; s2 += h[q] * h[q]; }
#pragma unroll
            for (int o2 = 1; o2 < 32; o2 <<= 1) s2 += __shfl_xor(s2, o2);
            const float rstd = 1.0f / sqrtf(s2 * (1.f / DV) + HN_EPS);
            float yv[8];
#pragma unroll
            for (int q = 0; q < 4; ++q) { const float o0 = bf_lo(o[j][q]), o1 = bf_hi(o[j][q]); const float n0 = gn[j][q >> 1][2 * (q & 1)], n1 = gn[j][q >> 1][2 * (q & 1) + 1];
                yv[2 * q] = h[2 * q] * rstd * n0 * __builtin_amdgcn_rcpf(1.0f + __expf(-o0)); yv[2 * q + 1] = h[2 * q + 1] * rstd * n1 * __builtin_amdgcn_rcpf(1.0f + __expf(-o1)); }
            u32x4 wv; wv.x = cvt_pk_bf16(yv[0], yv[1]); wv.y = cvt_pk_bf16(yv[2], yv[3]); wv.z = cvt_pk_bf16(yv[4], yv[5]); wv.w = cvt_pk_bf16(yv[6], yv[7]);
            *(u32x4*)(Y + (size_t)row * D + 512 * j + 8 * lane) = wv;
        }
    }
#undef HN_LOAD
}

constexpr int NPH = 19;
__global__ void __launch_bounds__(NTHR, 2) fwd_kernel(Args args) {
    extern __shared__ __attribute__((aligned(16))) unsigned char lds_raw[];
    Frame F;
    F.lds = (LAS unsigned char*)lds_raw;
    F.G = gridDim.x; F.bid = blockIdx.x; F.wave0 = __builtin_amdgcn_readfirstlane(threadIdx.x >> 6);
#pragma unroll
    for (int i = 0; i < 21; ++i) F.in[i] = args.in[i];
    F.out = args.out; F.ws = args.ws;
    for (int u = threadIdx.x; u < (LDS_BYTES - LDSCTL_OFF) / 4; u += NTHR) ((LAS unsigned*)(F.lds + LDSCTL_OFF))[u] = 0u;
    __syncthreads();
#if MK_N_LAUNCHES == 1
    XcdBarrier bar = xcd_barrier_post((unsigned*)(F.ws + WS_CTL) + CW_BAR, (volatile LAS unsigned*)(F.lds + LDS_MISC));
#define GRID_BAR() xcd_barrier(bar)
#else
#define GRID_BAR() do { } while (0)
#endif
    const int lo = args.ph_lo, hi = args.ph_hi;
#ifndef PHASE_MASK
#define PHASE_MASK 0x7ffff
#endif
#define IN(k) (((PHASE_MASK >> (k)) & 1) && lo <= (k) && (k) < hi)
#define SEAM(k) do { if (IN(k) && IN((k) + 1)) GRID_BAR(); } while (0)

#ifndef DUP_MASK
#define DUP_MASK 0x0
#endif
#define PHASE(k, body) do { if (IN(k)) { body; if ((DUP_MASK >> (k)) & 1) { GRID_BAR(); body; } } SEAM(k); } while (0)
    PHASE(0, p0_prologue(F));
    PHASE(1, p1_modulate(F));
    PHASE(2, ({
        constexpr int NG = BG_STREAM ? 234 : 256;
        if (F.bid < NG) { pg8::SchedPlain S; S.init((const bf16*)(F.ws + WS_HA), (const bf16*)(F.ws + WS_WT_CIN), NTOK, 6144, D, NG, F.bid);
            pg8::EpiConv1 E{(bf16*)(F.ws + WS_RB), (bf16*)(F.ws + WS_RC)};
            pg8::gemm_phase<pg8::EpiConv1, pg8::SchedPlain, false>(F.lds, F.wave0, D, S, E, bg_word(F, 2)); }
        bg_pull(F, 0, 2, NG / 2); }));
    PHASE(3, p3_conv(F));
    PHASE(4, ({
        constexpr int NG = BG_STREAM ? 182 : 256;
        if (F.bid < NG) { pg8::SchedPlain S; S.init((const bf16*)(F.ws + WS_HA), (const bf16*)(F.ws + WS_WT_COUT), NTOK, D, D, NG, F.bid);
            pg8::EpiBf16 E{(bf16*)(F.ws + WS_RB), D};
            pg8::gemm_phase<pg8::EpiBf16, pg8::SchedPlain, false>(F.lds, F.wave0, D, S, E, bg_word(F, 4)); }
        bg_pull(F, 0, 4, NG / 2); }));
    PHASE(5, lnA_phase(F, 0));
    PHASE(6, ({ list_phase(F, 0); bg_drain(F, Q_GV1, 0); }));
    PHASE(7, moe_gemm1(F, 0, 7));
    PHASE(8, moe_gemm2(F, 0, 8));
    PHASE(9, ({ lnB_phase(F, 0); bg_drain(F, Q_ML, Q_GV1); }));
    PHASE(10, ({
        constexpr int NG = BG_STREAM ? 243 : 256;
        if (F.bid < NG) { pg8::SchedPlain S; S.init((const bf16*)(F.ws + WS_HA), (const bf16*)(F.ws + WS_WT_MIN), NTOK, MLN, D, NG, F.bid);
            pg8::EpiMlIn E{(bf16*)(F.ws + WS_RC), (float*)(F.ws + WS_GATES)};
            pg8::gemm_phase<pg8::EpiMlIn, pg8::SchedPlain, false>(F.lds, F.wave0, D, S, E, bg_word(F, 10)); }
        bg_pull(F, Q_ML, 10, NG / 2); }));
    PHASE(11, scan_phase(F));
    PHASE(12, headnorm_phase(F));
    PHASE(13, ({
        pg8::SchedPlain S; S.init((const bf16*)(F.ws + WS_HA), (const bf16*)(F.ws + WS_WT_MOUT), NLAT, D, D, F.G, F.bid);
        pg8::EpiBf16 E{(bf16*)(F.ws + WS_RB), D};
        pg8::gemm_phase<pg8::EpiBf16, pg8::SchedPlain, false>(F.lds, F.wave0, D, S, E); }));
    PHASE(14, lnA_phase(F, 1));
    PHASE(15, ({ list_phase(F, 1); bg_drain(F, Q_END, Q_ML); }));
    PHASE(16, moe_gemm1(F, 1, 16));
    PHASE(17, moe_gemm2(F, 1, 17));
    PHASE(18, lnB_phase(F, 1));
#undef PHASE
#undef IN
#undef SEAM
}

extern "C" void kernel_launch(void* const* d_in, const int* in_sizes, int n_in, void* d_out, int out_size, void* d_ws, size_t ws_size, hipStream_t stream) {
    static int grid = 0;
    if (grid == 0) {
        if (n_in != 21 || out_size != NLAT * D || ws_size < WS_END) { fprintf(stderr, "kernel_launch: unexpected problem (n_in %d, out %d, ws %zu; need ws >= %zu)\n", n_in, out_size, ws_size, (size_t)WS_END); grid = -1; return; }
        int dev = 0, cus = 0, per_cu = 0;
        if (hipGetDevice(&dev) != hipSuccess || hipDeviceGetAttribute(&cus, hipDeviceAttributeMultiprocessorCount, dev) != hipSuccess) { grid = -1; return; }
        if (hipFuncSetAttribute((const void*)fwd_kernel, hipFuncAttributeMaxDynamicSharedMemorySize, LDS_BYTES) != hipSuccess) { fprintf(stderr, "kernel_launch: hipFuncSetAttribute failed\n"); grid = -1; return; }
        if (hipOccupancyMaxActiveBlocksPerMultiprocessor(&per_cu, (const void*)fwd_kernel, NTHR, LDS_BYTES) != hipSuccess || per_cu < 1) fprintf(stderr, "kernel_launch: occupancy query reports %d\n", per_cu);
        (void)hipGetLastError();
        if (cus < GRID) { fprintf(stderr, "kernel_launch: needs %d CUs, device has %d\n", GRID, cus); grid = -1; return; }
        grid = GRID;
    }
    if (grid < 0) return;
    (void)in_sizes;
    if (hipMemsetAsync((char*)d_ws + WS_CTL, 0, CTL_ZERO_BYTES, stream) != hipSuccess) return;
    Args a{};
    for (int i = 0; i < 21; ++i) a.in[i] = (const float*)d_in[i];
    a.out = (float*)d_out; a.ws = (unsigned char*)d_ws;
#if MK_N_LAUNCHES == 1
    a.ph_lo = 0; a.ph_hi = NPH;
    hipLaunchKernelGGL(fwd_kernel, dim3(grid), dim3(NTHR), LDS_BYTES, stream, a);
#else
    for (int p = 0; p < NPH; ++p) { a.ph_lo = p; a.ph_hi = p + 1; hipLaunchKernelGGL(fwd_kernel, dim3(grid), dim3(NTHR), LDS_BYTES, stream, a); }
#endif
}
```

```cpp
#include <hip/hip_runtime.h>
#include <cstdio>
#include <cstdint>

#ifndef MK_N_LAUNCHES
#define MK_N_LAUNCHES 1
#endif

#define LAS __attribute__((address_space(3)))
typedef unsigned short bf16;
typedef short bf16x8 __attribute__((ext_vector_type(8)));
typedef short s16x4 __attribute__((ext_vector_type(4)));
typedef float f32x4 __attribute__((ext_vector_type(4)));
typedef unsigned u32x4 __attribute__((ext_vector_type(4)));
typedef unsigned u32x2 __attribute__((ext_vector_type(2)));

constexpr int D = 2048, NB = 4, SEQ = 4096, NLAT = NB * SEQ, CTXL = 256, NCTX = NB * CTXL, NTOK = NLAT + NCTX;
constexpr int NE = 16, DE = 1024, NH = 8, DQK = 128, DV = 256;
constexpr int MLW = 6144, MLN = 6400;
constexpr int NWAVES = 8, NTHR = 512, GRID = 256;
constexpr float ALPHA = 1.41421356237f, LN_EPS = 1e-5f, HN_EPS = 1e-6f;
constexpr int MAXTILES = 153;

constexpr size_t MiB = 1u << 20;
constexpr size_t WS_CTL = 0, CTL_ZERO_BYTES = 1 * MiB;
constexpr size_t WS_MOD = 1 * MiB;
constexpr size_t WS_MISC = 2 * MiB;
constexpr size_t WS_ROUTE = WS_MISC + 0, WS_BLKCNT = WS_MISC + 0x48000, WS_SROW = WS_MISC + 0x50000, WS_SWT = WS_MISC + 0x80000, WS_TILEE = WS_MISC + 0xB0000, WS_TTOT = WS_MISC + 0xB0400;
constexpr size_t WS_CTXRES = 6 * MiB;
constexpr size_t WS_GATES = 14 * MiB;
constexpr size_t WS_WT_CIN = 17 * MiB, WS_WT_COUT = 41 * MiB, WS_WT_MIN = 49 * MiB, WS_WT_MOUT = 74 * MiB, WS_WT_E1 = 82 * MiB, WS_WT_E2 = 338 * MiB;
constexpr size_t WS_HA = 466 * MiB, WS_RB = 534 * MiB, WS_RC = 602 * MiB, WS_RH = 670 * MiB, WS_REX = 747 * MiB, WS_HB2 = 883 * MiB, WS_XB = 947 * MiB, WS_END = 1015 * MiB;
constexpr int CW_BAR = 4096;

constexpr int RING_BYTES = 131072, LDSCTL_OFF = 139264, LDS_TILEE = LDSCTL_OFF, LDS_MISC = LDSCTL_OFF + 1024, LDS_BYTES = 147456;

__device__ __forceinline__ unsigned cvt_pk_bf16(float lo, float hi) { unsigned r; asm volatile("v_cvt_pk_bf16_f32 %0, %1, %2" : "=v"(r) : "v"(lo), "v"(hi)); return r; }
__device__ __forceinline__ float bf_lo(unsigned u) { return __uint_as_float(u << 16); }
__device__ __forceinline__ float bf_hi(unsigned u) { return __uint_as_float(u & 0xffff0000u); }
__device__ __forceinline__ float wave_sum(float v) {
#pragma unroll
    for (int o = 1; o < 64; o <<= 1) v += __shfl_xor(v, o);
    return v;
}
#define LDS_WAIT() asm volatile("s_waitcnt lgkmcnt(0)" ::: "memory")
#define VM_WAIT() asm volatile("s_waitcnt vmcnt(0)" ::: "memory")

#define XB_TMO      128
#define XB_XCNT(j)  (256  + 64 * (j))
#define XB_XSUB(j)  (1280 + 64 * (j))
#define XB_XGEN(j)  (2304 + 64 * (j))
#define XB_TOP      3328
#define XB_TOPGEN   3392
#define XCD_BAR_WORDS 3456
#define XB_SPIN_CAP (1u << 18)
__device__ __forceinline__ unsigned xb_ld(unsigned* p)              { return __hip_atomic_load(p, __ATOMIC_RELAXED, __HIP_MEMORY_SCOPE_AGENT); }
__device__ __forceinline__ unsigned xb_add(unsigned* p, unsigned v) { return __hip_atomic_fetch_add(p, v, __ATOMIC_RELAXED, __HIP_MEMORY_SCOPE_AGENT); }
__device__ __forceinline__ unsigned xb_xcc_id() { return (unsigned)__builtin_amdgcn_s_getreg((3 << 11) | 20) & 0xFu; }
#define XB_SPIN(cond, bar) do { unsigned _sp = 0; while (cond) { __builtin_amdgcn_s_sleep(1); \
    if ((++_sp & 255u) == 0u) { if (xb_ld(&(bar)[XB_TMO])) break; if (_sp > XB_SPIN_CAP) { atomicAdd(&(bar)[XB_TMO], 1u); break; } } } } while (0)
struct XcdBarrier { unsigned* bar; unsigned x; volatile LAS unsigned* st; };
__device__ __forceinline__ XcdBarrier xcd_barrier_post(unsigned* bar, volatile LAS unsigned* st) {
    XcdBarrier b; b.bar = bar; b.x = xb_xcc_id(); b.st = st;
    if (threadIdx.x == 0) (void)xb_add(&bar[XB_XCNT(b.x)], 1u);
    return b;
}
__device__ __forceinline__ void xcd_barrier_complete(unsigned* bar, unsigned x, unsigned& nloc, unsigned& nx) {
    const unsigned G = gridDim.x * gridDim.y * gridDim.z;
    unsigned sum, cnt, mine, sp = 0u;
    for (;;) {
        sum = 0u; cnt = 0u; mine = 0u;
#pragma unroll
        for (unsigned j = 0; j < 16; ++j) { const unsigned c = xb_ld(&bar[XB_XCNT(j)]); sum += c; cnt += (c > 0u) ? 1u : 0u; mine = (j == x) ? c : mine; }
        if (sum == G) break;
        __builtin_amdgcn_s_sleep(1);
        if ((++sp & 255u) == 0u) { if (xb_ld(&bar[XB_TMO])) break; if (sp > XB_SPIN_CAP) { atomicAdd(&bar[XB_TMO], 1u); break; } }
    }
    nloc = mine > 0u ? mine : 1u; nx = cnt > 0u ? cnt : 1u;
}
__device__ __forceinline__ void xcd_barrier(const XcdBarrier& b) {
    asm volatile("s_waitcnt vmcnt(0)" ::: "memory");
    __syncthreads();
    if (threadIdx.x == 0) {
        unsigned* bar = b.bar;
        __builtin_amdgcn_s_waitcnt(0);
        unsigned nloc = b.st[0], nx = b.st[1];
        if (nloc == 0u) { xcd_barrier_complete(bar, b.x, nloc, nx); b.st[0] = nloc; b.st[1] = nx; }
        const unsigned old = xb_add(&bar[XB_XSUB(b.x)], 1u);
        const unsigned gen = old / nloc;
        if (old + 1u == (gen + 1u) * nloc) {
            __builtin_amdgcn_fence(__ATOMIC_RELEASE, "agent");
            asm volatile("s_waitcnt vmcnt(0)" ::: "memory");
            const unsigned og = xb_add(&bar[XB_TOP], 1u);
            const unsigned tg = og / nx;
            if (og + 1u == (tg + 1u) * nx) xb_add(&bar[XB_TOPGEN], 1u);
            else XB_SPIN(xb_ld(&bar[XB_TOPGEN]) == tg, bar);
            __builtin_amdgcn_fence(__ATOMIC_ACQUIRE, "agent");
            xb_add(&bar[XB_XGEN(b.x)], 1u);
            asm volatile("s_waitcnt vmcnt(0)" ::: "memory");
        } else {
            XB_SPIN(xb_ld(&bar[XB_XGEN(b.x)]) == gen, bar);
            __builtin_amdgcn_fence(__ATOMIC_ACQUIRE, "agent");
            asm volatile("s_waitcnt vmcnt(0)" ::: "memory");
        }
    }
    __syncthreads();
}

namespace pg8 {
constexpr int BM = 256, BK = 64, HALF = 128, HTB = HALF * BK * 2, NXCD = 8, WGM = 8;
__device__ __forceinline__ int lds_byte(int r, int c) { const int st = (r >> 4) * 2 + (c >> 5), rr = r & 15, cc = c & 31, ob = rr * 64 + cc * 2; return st * 1024 + (ob ^ (((ob >> 9) & 1) << 5)); }
__device__ __forceinline__ void stage_rc(int b, int& R, int& C) { const int st = b / 1024, sb = b % 1024, swz = sb ^ (((sb >> 9) & 1) << 5); R = (st >> 1) * 16 + swz / 64; C = (st & 1) * 32 + (swz % 64) / 2; }
__device__ __forceinline__ int perm32(int rho) { const int n = rho >> 4, i = rho & 15; return 8 * (i >> 2) + 4 * n + (i & 3); }

struct Unit { int pm, pn; const char* a; const char* b; };

__device__ __forceinline__ bool order_next(int i, int G, int c, int nM, int nN, int& pm, int& pn) {
    const int nwg = nM * nN; const long L = (long)i * G + c; if (L >= nwg) return false;
    int wgid = (int)L; { const int q = nwg / NXCD, r = nwg % NXCD, xcd = wgid % NXCD, off = wgid / NXCD; wgid = (xcd < r ? xcd * (q + 1) : r * (q + 1) + (xcd - r) * q) + off; }
    const int nig = WGM * nN, gid = wgid / nig, fm = gid * WGM, gsz = (nM - fm) < WGM ? (nM - fm) : WGM;
    pm = fm + ((wgid % nig) % gsz); pn = (wgid % nig) / gsz; return true;
}
struct SchedPlain {
    const char* A; const char* Bt; int nM, nN, G, c; size_t tstep;
    __device__ __forceinline__ void init(const bf16* A_, const bf16* Bt_, int M, int N, int K, int G_, int c_) { A = (const char*)A_; Bt = (const char*)Bt_; nM = M / BM; nN = N / BM; G = G_; c = c_; tstep = (size_t)BM * K * 2; }
    __device__ __forceinline__ bool next(int i, Unit& u) const { if (!order_next(i, G, c, nM, nN, u.pm, u.pn)) return false; u.a = A + (size_t)u.pm * tstep; u.b = Bt + (size_t)u.pn * tstep; return true; }
};
struct SchedMoe {
    const char* A; const char* Bt; const int* srow; const LAS int* tile_e; int nM, nN, G, c; size_t tstepA, tstepB, estepB;
    __device__ __forceinline__ bool next(int i, Unit& u) const { if (!order_next(i, G, c, nM, nN, u.pm, u.pn)) return false;
        const int e = tile_e[u.pm]; u.a = A + (size_t)u.pm * tstepA; u.b = Bt + (size_t)e * estepB + (size_t)u.pn * tstepB; return true; }
};

template <class Epi, class Sched, bool GATHER>
__device__ __forceinline__ void gemm_phase(LAS unsigned char* lds, const int wid, const int K, const Sched& S, const Epi& E) {
    int lane_ = (int)__builtin_amdgcn_mbcnt_hi(~0u, __builtin_amdgcn_mbcnt_lo(~0u, 0u)); asm volatile("" : "+v"(lane_));
    const int lane = lane_, tid = wid * 64 + lane, wr = wid >> 2, wc = wid & 3, fr = lane & 15, fq = lane >> 4;
    const int nt = K / BK;
    int R0, C0, R1, C1; stage_rc(tid * 16, R0, C0); stage_rc(tid * 16 + 8192, R1, C1);
    unsigned voffB[2]; voffB[0] = (unsigned)(((R0 & ~31) + perm32(R0 & 31)) * K + C0) * 2u; voffB[1] = (unsigned)(((R1 & ~31) + perm32(R1 & 31)) * K + C1) * 2u;
    unsigned cv[4], nv[4];
    const size_t kstep = (size_t)(BK * 2);
    const size_t hstep = (size_t)HALF * K * 2;
    const unsigned ldsw = (unsigned)wid * 1024u;
    const int aoff = lds_byte(wr * 64 + fr, fq * 8), boff = lds_byte(wc * 32 + fr, fq * 8);
#define PG8_SA(b, h) (((b) * 2 + (h)) * HTB)
#define PG8_SB(b, h) ((4 + (b) * 2 + (h)) * HTB)
#define PG8_STG(bufoff, ptr, o0, o1) do { const char* p_ = (const char*)(ptr); asm volatile("" : "+s"(p_));     \
        __builtin_amdgcn_global_load_lds((const unsigned*)(p_ + (o0)), (LAS unsigned*)(lds + (bufoff) + ldsw), 16, 0, 0); \
        __builtin_amdgcn_global_load_lds((const unsigned*)(p_ + (o1)), (LAS unsigned*)(lds + (bufoff) + ldsw + 8192), 16, 0, 0); } while (0)
#define PG8_STGB(bufoff, ptr) PG8_STG(bufoff, ptr, voffB[0], voffB[1])
#define PG8_STGA(bufoff, ptr, h, V) do { if constexpr (GATHER) { PG8_STG(bufoff, ptr, (V)[2 * (h)], (V)[2 * (h) + 1]); } else { PG8_STG(bufoff, (ptr) + (h) * hstep, (V)[0], (V)[1]); } } while (0)
#define PG8_LDA(dst, b, h) do { _Pragma("unroll") for (int m = 0; m < 4; ++m) _Pragma("unroll") for (int k = 0; k < 2; ++k) dst[m][k] = *(const LAS bf16x8*)(lds + PG8_SA(b, h) + aoff + m * 2048 + k * 1024); } while (0)
#define PG8_LDB(dst, b, h) do { _Pragma("unroll") for (int n = 0; n < 2; ++n) _Pragma("unroll") for (int k = 0; k < 2; ++k) dst[n][k] = *(const LAS bf16x8*)(lds + PG8_SB(b, h) + boff + n * 2048 + k * 1024); } while (0)
#define PG8_MMA(ai, bj, At, Bt) do { __builtin_amdgcn_s_setprio(1); _Pragma("unroll") for (int m = 0; m < 4; ++m) _Pragma("unroll") for (int n = 0; n < 2; ++n) _Pragma("unroll") for (int k = 0; k < 2; ++k) \
        acc[ai][bj][m][n] = __builtin_amdgcn_mfma_f32_16x16x32_bf16(Bt[n][k], At[m][k], acc[ai][bj][m][n], 0, 0, 0); __builtin_amdgcn_s_setprio(0); } while (0)
#define PG8_WAIT_V(n) asm volatile("s_waitcnt vmcnt(" #n ")" ::: "memory")
#define PG8_WAIT_L(n) asm volatile("s_waitcnt lgkmcnt(" #n ")" ::: "memory")
#define PG8_BAR __builtin_amdgcn_s_barrier()
#define PG8_SCHED __builtin_amdgcn_sched_barrier(0)
#define PG8_TRIP(A1, A2, B2, V2) do { const char* a3_ = (A2) + kstep; const char* b3_ = (B2) + kstep; \
        PG8_LDB(B0, 0, 0); PG8_LDB(B1, 0, 1); PG8_SCHED; PG8_LDA(At, 0, 0); PG8_STGA(PG8_SA(1, 1), A1, 1, cv); \
        PG8_WAIT_V(8); PG8_WAIT_L(0); PG8_BAR; PG8_MMA(0, 0, At, B0); PG8_MMA(0, 1, At, B1); PG8_BAR; PG8_SCHED; \
        PG8_LDA(At, 0, 1); PG8_STGB(PG8_SB(0, 0), B2); PG8_STGB(PG8_SB(0, 1), (B2) + hstep); PG8_STGA(PG8_SA(0, 0), A2, 0, V2); \
        PG8_WAIT_V(8); PG8_WAIT_L(0); PG8_BAR; PG8_MMA(1, 0, At, B0); PG8_MMA(1, 1, At, B1); PG8_BAR; PG8_SCHED; \
        PG8_LDB(B0, 1, 0); PG8_LDB(B1, 1, 1); PG8_SCHED; PG8_LDA(At, 1, 0); PG8_STGA(PG8_SA(0, 1), A2, 1, V2); \
        PG8_WAIT_V(8); PG8_WAIT_L(0); PG8_BAR; PG8_MMA(0, 0, At, B0); PG8_MMA(0, 1, At, B1); PG8_BAR; PG8_SCHED; \
        PG8_LDA(At, 1, 1); PG8_STGB(PG8_SB(1, 0), b3_); PG8_STGB(PG8_SB(1, 1), b3_ + hstep); PG8_STGA(PG8_SA(1, 0), a3_, 0, V2); \
        PG8_WAIT_V(8); PG8_WAIT_L(0); PG8_BAR; PG8_MMA(1, 0, At, B0); PG8_MMA(1, 1, At, B1); PG8_BAR; PG8_SCHED; } while (0)
#define PG8_OFFS(u, v) do { if constexpr (GATHER) { const int* sr_ = S.srow + (u).pm * 256; int t0_ = sr_[R0], t1_ = sr_[R1], t2_ = sr_[128 + R0], t3_ = sr_[128 + R1]; \
        t0_ = t0_ < 0 ? 0 : (t0_ >> 1); t1_ = t1_ < 0 ? 0 : (t1_ >> 1); t2_ = t2_ < 0 ? 0 : (t2_ >> 1); t3_ = t3_ < 0 ? 0 : (t3_ >> 1); \
        (v)[0] = (unsigned)(t0_ * K + C0) * 2u; (v)[1] = (unsigned)(t1_ * K + C1) * 2u; (v)[2] = (unsigned)(t2_ * K + C0) * 2u; (v)[3] = (unsigned)(t3_ * K + C1) * 2u; } } while (0)
    Unit cur, nxt; int ui = 0;
    if (!S.next(0, cur)) return;
    f32x4 acc[2][2][4][2];
#pragma unroll
    for (int a = 0; a < 2; ++a)
#pragma unroll
        for (int b = 0; b < 2; ++b)
#pragma unroll
            for (int m = 0; m < 4; ++m)
#pragma unroll
                for (int n = 0; n < 2; ++n) acc[a][b][m][n] = (f32x4){0.f, 0.f, 0.f, 0.f};
    bf16x8 At[4][2], B0[2][2], B1[2][2];
    if constexpr (GATHER) { PG8_OFFS(cur, cv); }
    else { cv[0] = (unsigned)(R0 * K + C0) * 2u; cv[1] = (unsigned)(R1 * K + C1) * 2u; cv[2] = 0u; cv[3] = 0u; }
    const char* cA = cur.a; const char* cB = cur.b;
    PG8_STGB(PG8_SB(0, 0), cB); PG8_STGB(PG8_SB(0, 1), cB + hstep); PG8_STGA(PG8_SA(0, 0), cA, 0, cv); PG8_STGA(PG8_SA(0, 1), cA, 1, cv);
    if (wr == 1) PG8_BAR;
    PG8_WAIT_V(2); PG8_BAR;
    PG8_STGB(PG8_SB(1, 0), cB + kstep); PG8_STGA(PG8_SA(1, 0), cA + kstep, 0, cv); PG8_STGB(PG8_SB(1, 1), cB + hstep + kstep);
    PG8_WAIT_V(6); PG8_BAR;
    for (;;) {
        const bool has_next = S.next(ui + 1, nxt);
        const char* nA = has_next ? nxt.a : cA; const char* nB = has_next ? nxt.b : cB;
        if constexpr (GATHER) { if (has_next) { PG8_OFFS(nxt, nv); } else { nv[0] = cv[0]; nv[1] = cv[1]; nv[2] = cv[2]; nv[3] = cv[3]; } }
        for (int t = 0; t < nt - 2; t += 2) { const char* a1 = cA + (size_t)(t + 1) * kstep; const char* a2 = cA + (size_t)(t + 2) * kstep; const char* b2 = cB + (size_t)(t + 2) * kstep; PG8_TRIP(a1, a2, b2, cv); }
        { const char* a1 = cA + (size_t)(nt - 1) * kstep; if constexpr (GATHER) { PG8_TRIP(a1, nA, nB, nv); } else { PG8_TRIP(a1, nA, nB, cv); } }
        if (wr == 0) PG8_BAR;
        E(acc, cur, wr, wc, fr, fq);
        if (!has_next) break;
#pragma unroll
        for (int a = 0; a < 2; ++a)
#pragma unroll
            for (int b = 0; b < 2; ++b)
#pragma unroll
                for (int m = 0; m < 4; ++m)
#pragma unroll
                    for (int n = 0; n < 2; ++n) acc[a][b][m][n] = (f32x4){0.f, 0.f, 0.f, 0.f};
        cur = nxt; cA = nA; cB = nB; ++ui;
        if constexpr (GATHER) { cv[0] = nv[0]; cv[1] = nv[1]; cv[2] = nv[2]; cv[3] = nv[3]; }
        if (wr == 1) PG8_BAR;
    }
    PG8_WAIT_V(0);
    PG8_BAR;
#undef PG8_SA
#undef PG8_SB
#undef PG8_STG
#undef PG8_STGB
#undef PG8_STGA
#undef PG8_LDA
#undef PG8_LDB
#undef PG8_MMA
#undef PG8_WAIT_V
#undef PG8_WAIT_L
#undef PG8_BAR
#undef PG8_SCHED
#undef PG8_TRIP
#undef PG8_OFFS
}

__device__ __forceinline__ u32x4 pack8(const f32x4 v0, const f32x4 v1) { u32x4 w; w.x = cvt_pk_bf16(v0[0], v0[1]); w.y = cvt_pk_bf16(v0[2], v0[3]); w.z = cvt_pk_bf16(v1[0], v1[1]); w.w = cvt_pk_bf16(v1[2], v1[3]); return w; }
struct EpiBf16 {
    bf16* O; int ldc;
    __device__ __forceinline__ void operator()(const f32x4 (&acc)[2][2][4][2], const Unit& u, int wr, int wc, int fr, int fq) const {
        const int row0 = u.pm * BM + wr * 64 + fr, col0 = u.pn * BM + wc * 32 + 8 * fq;
#pragma unroll
        for (int ai = 0; ai < 2; ++ai)
#pragma unroll
            for (int m = 0; m < 4; ++m) { bf16* rowp = O + (size_t)(row0 + ai * HALF + m * 16) * ldc + col0;
#pragma unroll
                for (int bj = 0; bj < 2; ++bj) *(u32x4*)(rowp + bj * HALF) = pack8(acc[ai][bj][m][0], acc[ai][bj][m][1]); }
    }
};
struct EpiConv1 {
    bf16* BG; bf16* Z;
    __device__ __forceinline__ void operator()(const f32x4 (&acc)[2][2][4][2], const Unit& u, int wr, int wc, int fr, int fq) const {
        const int row0 = u.pm * BM + wr * 64 + fr;
        if (u.pn < 8) {
            const int col0 = u.pn * BM + wc * 32 + 8 * fq;
#pragma unroll
            for (int ai = 0; ai < 2; ++ai)
#pragma unroll
                for (int m = 0; m < 4; ++m) { bf16* rowp = BG + (size_t)(row0 + ai * HALF + m * 16) * D + col0;
#pragma unroll
                    for (int bj = 0; bj < 2; ++bj) *(u32x4*)(rowp + bj * HALF) = pack8(acc[ai][bj][m][0], acc[ai][bj][m][1]); }
        } else {
            const int col0 = (u.pn - 8) * HALF + wc * 32 + 8 * fq;
#pragma unroll
            for (int ai = 0; ai < 2; ++ai)
#pragma unroll
                for (int m = 0; m < 4; ++m) { bf16* rowp = Z + (size_t)(row0 + ai * HALF + m * 16) * D + col0;
                    *(u32x4*)rowp = pack8(acc[ai][0][m][0] * acc[ai][1][m][0], acc[ai][0][m][1] * acc[ai][1][m][1]); }
        }
    }
};
struct EpiMlIn {
    bf16* O; float* gates;
    __device__ __forceinline__ void operator()(const f32x4 (&acc)[2][2][4][2], const Unit& u, int wr, int wc, int fr, int fq) const {
        const int row0 = u.pm * BM + wr * 64 + fr;
        if (u.pn < 24) {
            const int col0 = u.pn * BM + wc * 32 + 8 * fq;
#pragma unroll
            for (int ai = 0; ai < 2; ++ai)
#pragma unroll
                for (int m = 0; m < 4; ++m) { bf16* rowp = O + (size_t)(row0 + ai * HALF + m * 16) * MLW + col0;
#pragma unroll
                    for (int bj = 0; bj < 2; ++bj) *(u32x4*)(rowp + bj * HALF) = pack8(acc[ai][bj][m][0], acc[ai][bj][m][1]); }
        } else if (wc == 0) {
#pragma unroll
            for (int ai = 0; ai < 2; ++ai)
#pragma unroll
                for (int m = 0; m < 4; ++m) { float* rowp = gates + (size_t)(row0 + ai * HALF + m * 16) * 32 + 8 * fq;
                    *(f32x4*)rowp = acc[ai][0][m][0]; *(f32x4*)(rowp + 4) = acc[ai][0][m][1]; }
        }
    }
};
__device__ __forceinline__ float silu_f(float g) { return g * __builtin_amdgcn_rcpf(1.0f + __expf(-g)); }
struct EpiMoe1 {
    bf16* H;
    __device__ __forceinline__ void operator()(const f32x4 (&acc)[2][2][4][2], const Unit& u, int wr, int wc, int fr, int fq) const {
        const int row0 = u.pm * BM + wr * 64 + fr, col0 = u.pn * HALF + wc * 32 + 8 * fq;
#pragma unroll
        for (int ai = 0; ai < 2; ++ai)
#pragma unroll
            for (int m = 0; m < 4; ++m) { bf16* rowp = H + (size_t)(row0 + ai * HALF + m * 16) * DE + col0; f32x4 h0, h1;
#pragma unroll
                for (int j = 0; j < 4; ++j) { h0[j] = silu_f(acc[ai][0][m][0][j]) * acc[ai][1][m][0][j]; h1[j] = silu_f(acc[ai][0][m][1][j]) * acc[ai][1][m][1][j]; }
                *(u32x4*)rowp = pack8(h0, h1); }
    }
};
struct EpiMoe2 {
    bf16* EX; const int* srow; const float* swt;
    __device__ __forceinline__ void operator()(const f32x4 (&acc)[2][2][4][2], const Unit& u, int wr, int wc, int fr, int fq) const {
        const int row0 = u.pm * BM + wr * 64 + fr, col0 = u.pn * BM + wc * 32 + 8 * fq;
#pragma unroll
        for (int ai = 0; ai < 2; ++ai)
#pragma unroll
            for (int m = 0; m < 4; ++m) { const int r = row0 + ai * HALF + m * 16; const int ent = srow[r]; const float w = swt[r];
                if (ent >= 0) { bf16* rowp = EX + ((size_t)(ent & 1) * NTOK + (size_t)(ent >> 1)) * D + col0;
#pragma unroll
                    for (int bj = 0; bj < 2; ++bj) *(u32x4*)(rowp + bj * HALF) = pack8(acc[ai][bj][m][0] * w, acc[ai][bj][m][1] * w); } }
    }
};
}

struct Args { const float* in[21]; float* out; unsigned char* ws; int ph_lo, ph_hi; };
struct Frame {
    LAS unsigned char* lds;
    int G, bid, wave0;
    const float* in[21]; float* out; unsigned char* ws;
};
enum { I_X = 0, I_C, I_CTX, I_CCTX, I_WADA, I_BADA, I_LNG, I_LNB, I_CWIN, I_CW, I_CWOUT, I_MWIN, I_MWG, I_MBG, I_MNG, I_MWOUT, I_RW, I_RB, I_EWG, I_EWU, I_EWD };

#define PHASE_IDS() int lane_ = (int)__builtin_amdgcn_mbcnt_hi(~0u, __builtin_amdgcn_mbcnt_lo(~0u, 0u)); asm volatile("" : "+v"(lane_)); const int lane = lane_; const int wave = F.wave0; const int tid = wave * 64 + lane; (void)tid
__device__ __forceinline__ int mod_row(int trow) { return trow < NLAT ? (trow >> 12) : 4; }
__device__ __forceinline__ const float* mod_vec(const Frame& F, int layer, int r, int j) { return (const float*)(F.ws + WS_MOD) + ((size_t)(layer * 5 + r) * 6 + j) * D; }

__device__ __forceinline__ void cvt_tile(const float* src, size_t src_pitch, bf16* dst, size_t dst_pitch, float scale, LAS float* scr, int lane) {
#pragma unroll 8
    for (int i = 0; i < 64; ++i) scr[i * 65 + lane] = src[(size_t)i * src_pitch + lane];
    LDS_WAIT(); asm volatile("" ::: "memory");
    const int c = lane & 7;
#pragma unroll
    for (int j = 0; j < 8; ++j) { const int n = (lane >> 3) + 8 * j; const LAS float* s = scr + (8 * c) * 65 + n;
        u32x4 o; o.x = cvt_pk_bf16(s[0] * scale, s[65] * scale); o.y = cvt_pk_bf16(s[2 * 65] * scale, s[3 * 65] * scale); o.z = cvt_pk_bf16(s[4 * 65] * scale, s[5 * 65] * scale); o.w = cvt_pk_bf16(s[6 * 65] * scale, s[7 * 65] * scale);
        *(u32x4*)(dst + (size_t)n * dst_pitch + 8 * c) = o; }
    LDS_WAIT(); asm volatile("" ::: "memory");
}
__device__ __forceinline__ void p0_prologue(Frame& F) {
    PHASE_IDS();
    LAS float* sc = (LAS float*)F.lds;
    LAS float* red = (LAS float*)(F.lds + 40960);
    for (int idx = tid; idx < 5 * D; idx += NTHR) { const int r = idx / D, k = idx % D; const float cv = r < 4 ? F.in[I_C][r * D + k] : F.in[I_CCTX][k]; sc[idx] = cv / (1.0f + expf(-cv)); }
    __syncthreads();
    float* mod = (float*)(F.ws + WS_MOD);
    for (int it = F.bid; it < 768; it += F.G) {
        const int l = it / 384, n0 = (it % 384) * 32, col = lane & 31, kp = lane >> 5, kbase = wave * 256;
        const float* W = F.in[I_WADA] + (size_t)l * D * 12288 + n0 + col;
        float acc[5] = {0.f, 0.f, 0.f, 0.f, 0.f};
        for (int kk = 0; kk < 128; kk += 8) {
            float wv[8];
#pragma unroll
            for (int u = 0; u < 8; ++u) wv[u] = W[(size_t)(kbase + 2 * (kk + u) + kp) * 12288];
#pragma unroll
            for (int u = 0; u < 8; ++u) { const int k = kbase + 2 * (kk + u) + kp;
#pragma unroll
                for (int r = 0; r < 5; ++r) acc[r] += sc[r * D + k] * wv[u]; }
        }
#pragma unroll
        for (int r = 0; r < 5; ++r) { acc[r] += __shfl_xor(acc[r], 32); if (lane < 32) red[(wave * 5 + r) * 32 + lane] = acc[r]; }
        __syncthreads();
        if (tid < 160) { const int r = tid >> 5, cc = tid & 31; float s = 0.f;
#pragma unroll
            for (int w = 0; w < 8; ++w) s += red[(w * 5 + r) * 32 + cc];
            mod[(size_t)(l * 5 + r) * 12288 + n0 + cc] = s + F.in[I_BADA][l * 12288 + n0 + cc]; }
        __syncthreads();
    }
    LAS float* scr = (LAS float*)(F.lds + wave * 16640);
    const int gw = F.bid * NWAVES + wave, NGW = F.G * NWAVES;
    constexpr int I1 = 3072, I2 = 1024, I3 = 3072, I4 = 1024, I5 = 16384, I6 = 16384, I7 = 16384;
    constexpr int NIT = I1 + I2 + I3 + I4 + I5 + I6 + I7;
    const float QS = 0.08838834764831845f;
    for (int it = gw; it < NIT; it += NGW) {
        int r = it;
        if (r < I1) { const int kb = r / 96, n0 = (r % 96) * 64; int dr; if (n0 < 2048) dr = n0; else if (n0 < 4096) { const int q = n0 - 2048; dr = 2048 + (q >> 7) * 256 + (q & 127); } else { const int q = n0 - 4096; dr = 2048 + (q >> 7) * 256 + 128 + (q & 127); }
            cvt_tile(F.in[I_CWIN] + (size_t)kb * 64 * 6144 + n0, 6144, (bf16*)(F.ws + WS_WT_CIN) + (size_t)dr * D + kb * 64, D, 1.f, scr, lane); continue; } r -= I1;
        if (r < I2) { const int kb = r / 32, n0 = (r % 32) * 64;
            cvt_tile(F.in[I_CWOUT] + (size_t)kb * 64 * D + n0, D, (bf16*)(F.ws + WS_WT_COUT) + (size_t)n0 * D + kb * 64, D, 1.f, scr, lane); continue; } r -= I2;
        if (r < I3) { const int kb = r / 96, n0 = (r % 96) * 64;
            cvt_tile(F.in[I_MWIN] + (size_t)kb * 64 * MLW + n0, MLW, (bf16*)(F.ws + WS_WT_MIN) + (size_t)n0 * D + kb * 64, D, n0 < 1024 ? QS : 1.f, scr, lane); continue; } r -= I3;
        if (r < I4) { const int kb = r / 32, n0 = (r % 32) * 64;
            cvt_tile(F.in[I_MWOUT] + (size_t)kb * 64 * D + n0, D, (bf16*)(F.ws + WS_WT_MOUT) + (size_t)n0 * D + kb * 64, D, 1.f, scr, lane); continue; } r -= I4;
        if (r < I5 + I6) { const int up = r >= I5; if (up) r -= I5; const int le = r / 512, q = r % 512, kb = q / 16, n0 = (q % 16) * 64;
            const float* src = (up ? F.in[I_EWU] : F.in[I_EWG]) + (size_t)le * D * DE + (size_t)kb * 64 * DE + n0;
            const int dr = (n0 >> 7) * 256 + (up ? 128 : 0) + (n0 & 127);
            cvt_tile(src, DE, (bf16*)(F.ws + WS_WT_E1) + (size_t)le * D * D + (size_t)dr * D + kb * 64, D, 1.f, scr, lane); continue; } r -= I5 + I6;
        { const int le = r / 512, q = r % 512, kb = q / 32, n0 = (q % 32) * 64;
            cvt_tile(F.in[I_EWD] + (size_t)le * DE * D + (size_t)kb * 64 * D + n0, D, (bf16*)(F.ws + WS_WT_E2) + (size_t)le * D * DE + (size_t)n0 * DE + kb * 64, DE, 1.f, scr, lane); }
    }
    { bf16* wt = (bf16*)(F.ws + WS_WT_MIN) + (size_t)MLW * D; const float* wg = F.in[I_MWG];
      for (int idx = F.bid * NTHR + tid; idx < 256 * D; idx += F.G * NTHR) { const int n = idx / D, k = idx % D; const float v = n < 32 ? wg[k * 32 + n] : 0.f; wt[idx] = (bf16)(cvt_pk_bf16(v, 0.f) & 0xffffu); } }
}

#define SCHED_FENCE() __builtin_amdgcn_sched_barrier(0)
__device__ __forceinline__ void p1_modulate(Frame& F) {
    PHASE_IDS();
    const int gw = F.bid * NWAVES + wave;
    bf16* HA = (bf16*)(F.ws + WS_HA);
    f32x4 a[8], b[8], x[8], xn[8];
    { const int r = (8 * gw) >> 12; const float* sh = mod_vec(F, 0, r, 0); const float* scv = mod_vec(F, 0, r, 1);
#pragma unroll
      for (int j = 0; j < 8; ++j) { const int c = 256 * j + 4 * lane; a[j] = *(const f32x4*)(scv + c) + 1.0f; b[j] = *(const f32x4*)(sh + c); xn[j] = *(const f32x4*)(F.in[I_X] + (size_t)(8 * gw) * D + c); } }
    for (int i = 0; i < 8; ++i) { const int row = 8 * gw + i;
#pragma unroll
        for (int j = 0; j < 8; ++j) x[j] = xn[j];
        if (i < 7) {
#pragma unroll
            for (int j = 0; j < 8; ++j) xn[j] = *(const f32x4*)(F.in[I_X] + (size_t)(row + 1) * D + 256 * j + 4 * lane); }
        SCHED_FENCE();
#pragma unroll
        for (int j = 0; j < 8; ++j) { const f32x4 h = x[j] * a[j] + b[j]; u32x2 o; o.x = cvt_pk_bf16(h[0], h[1]); o.y = cvt_pk_bf16(h[2], h[3]); *(u32x2*)(HA + (size_t)row * D + 256 * j + 4 * lane) = o; }
    }
    if (gw < NCTX) { const float* sh = mod_vec(F, 0, 4, 0); const float* scv = mod_vec(F, 0, 4, 1);
#pragma unroll
        for (int j = 0; j < 8; ++j) { const int c = 256 * j + 4 * lane; a[j] = *(const f32x4*)(scv + c) + 1.0f; b[j] = *(const f32x4*)(sh + c); x[j] = *(const f32x4*)(F.in[I_CTX] + (size_t)gw * D + c); }
        SCHED_FENCE();
#pragma unroll
        for (int j = 0; j < 8; ++j) { const f32x4 h = x[j] * a[j] + b[j]; u32x2 o; o.x = cvt_pk_bf16(h[0], h[1]); o.y = cvt_pk_bf16(h[2], h[3]); *(u32x2*)(HA + (size_t)(NLAT + gw) * D + 256 * j + 4 * lane) = o; } }
}

__device__ __forceinline__ void p3_conv(Frame& F) {
    PHASE_IDS();
    const int gw = F.bid * NWAVES + wave, NGW = F.G * NWAVES;
    const bf16* BG = (const bf16*)(F.ws + WS_RB); const bf16* Z = (const bf16*)(F.ws + WS_RC); bf16* U = (bf16*)(F.ws + WS_HA);
    const float* cw = F.in[I_CW];
    f32x4 wt[4][3][2];
#pragma unroll
    for (int j = 0; j < 4; ++j)
#pragma unroll
        for (int t = 0; t < 3; ++t) { wt[j][t][0] = *(const f32x4*)(cw + t * D + 512 * j + 8 * lane); wt[j][t][1] = *(const f32x4*)(cw + t * D + 512 * j + 8 * lane + 4); }
    for (int row = gw; row < NTOK; row += NGW) {
        u32x4 zc[4], bg[4], zp[4], zn[4];
        int dpa, dna, dpb, dnb; bool vpa, vna, vpb, vnb;
        if (row < NLAT) { const int s = row & (SEQ - 1), gc = s & 63, gr = s >> 6; vpa = gc > 0; vna = gc < 63; dpa = -1; dna = 1; vpb = gr > 0; vnb = gr < 63; dpb = -64; dnb = 64; }
        else { const int t = (row - NLAT) & (CTXL - 1); vpa = vpb = t > 0; vna = vnb = t < CTXL - 1; dpa = dpb = -1; dna = dnb = 1; }
#pragma unroll
        for (int j = 0; j < 4; ++j) { const int c = 512 * j + 8 * lane; const bool vp = j < 2 ? vpa : vpb, vn = j < 2 ? vna : vnb; const int dp = j < 2 ? dpa : dpb, dn = j < 2 ? dna : dnb;
            zc[j] = *(const u32x4*)(Z + (size_t)row * D + c); bg[j] = *(const u32x4*)(BG + (size_t)row * D + c);
            zp[j] = *(const u32x4*)(Z + (size_t)(vp ? row + dp : row) * D + c); zn[j] = *(const u32x4*)(Z + (size_t)(vn ? row + dn : row) * D + c);
            if (!vp) zp[j] = (u32x4){0u, 0u, 0u, 0u}; if (!vn) zn[j] = (u32x4){0u, 0u, 0u, 0u}; }
        SCHED_FENCE();
#pragma unroll
        for (int j = 0; j < 4; ++j) { float o[8];
#pragma unroll
            for (int q = 0; q < 4; ++q) {
                const float w0l = wt[j][0][q >> 1][2 * (q & 1)], w0h = wt[j][0][q >> 1][2 * (q & 1) + 1], w1l = wt[j][1][q >> 1][2 * (q & 1)], w1h = wt[j][1][q >> 1][2 * (q & 1) + 1], w2l = wt[j][2][q >> 1][2 * (q & 1)], w2h = wt[j][2][q >> 1][2 * (q & 1) + 1];
                o[2 * q] = bf_lo(bg[j][q]) * (w0l * bf_lo(zp[j][q]) + w1l * bf_lo(zc[j][q]) + w2l * bf_lo(zn[j][q]));
                o[2 * q + 1] = bf_hi(bg[j][q]) * (w0h * bf_hi(zp[j][q]) + w1h * bf_hi(zc[j][q]) + w2h * bf_hi(zn[j][q])); }
            u32x4 w; w.x = cvt_pk_bf16(o[0], o[1]); w.y = cvt_pk_bf16(o[2], o[3]); w.z = cvt_pk_bf16(o[4], o[5]); w.w = cvt_pk_bf16(o[6], o[7]);
            *(u32x4*)(U + (size_t)row * D + 512 * j + 8 * lane) = w; }
    }
}

__device__ __forceinline__ void lnB_phase(Frame& F, int layer) {
    PHASE_IDS();
    const int nrows = layer == 0 ? 68 : 64;
    const float* lg = F.in[I_LNG] + (layer * 2 + 1) * D; const float* lb = F.in[I_LNB] + (layer * 2 + 1) * D;
    const bf16* EX = (const bf16*)(F.ws + WS_REX);
#define LNB_ROW(li) ((li) < 64 ? F.bid * 64 + (li) : NLAT + F.bid * 4 + ((li) - 64))
#define LNB_LOAD(li, X, E0, E1) do { const bf16* xp_ = (const bf16*)(F.ws + WS_XB) + (size_t)LNB_ROW(li) * D; const bf16* ep_ = EX + (size_t)LNB_ROW(li) * D; \
        _Pragma("unroll") for (int j = 0; j < 8; ++j) { X[j] = *(const u32x2*)(xp_ + 256 * j + 4 * lane); E0[j] = *(const u32x2*)(ep_ + 256 * j + 4 * lane); E1[j] = *(const u32x2*)(ep_ + (size_t)NTOK * D + 256 * j + 4 * lane); } } while (0)
    u32x2 xn_[8], e0_[8], e1_[8];
    if (wave < nrows) LNB_LOAD(wave, xn_, e0_, e1_);
    for (int li = wave; li < nrows; li += NWAVES) {
        const int row = LNB_ROW(li); const int mr = mod_row(row);
        const float* gv = mod_vec(F, layer, mr, 5);
        f32x4 v[8]; float s = 0.f;
#pragma unroll
        for (int j = 0; j < 8; ++j) { const f32x4 g = *(const f32x4*)(gv + 256 * j + 4 * lane);
            const f32x4 m = (f32x4){bf_lo(e0_[j].x) + bf_lo(e1_[j].x), bf_hi(e0_[j].x) + bf_hi(e1_[j].x), bf_lo(e0_[j].y) + bf_lo(e1_[j].y), bf_hi(e0_[j].y) + bf_hi(e1_[j].y)};
            const f32x4 x = (f32x4){bf_lo(xn_[j].x), bf_hi(xn_[j].x), bf_lo(xn_[j].y), bf_hi(xn_[j].y)};
            v[j] = x * ALPHA + g * m; s += (v[j][0] + v[j][1]) + (v[j][2] + v[j][3]); }
        if (li + NWAVES < nrows) LNB_LOAD(li + NWAVES, xn_, e0_, e1_);
        f32x4 L[8], B[8];
#pragma unroll
        for (int j = 0; j < 8; ++j) { const int c = 256 * j + 4 * lane; L[j] = *(const f32x4*)(lg + c); B[j] = *(const f32x4*)(lb + c); }
        SCHED_FENCE();
        const float mean = wave_sum(s) * (1.f / D); float s2 = 0.f;
#pragma unroll
        for (int j = 0; j < 8; ++j) { v[j] = v[j] - mean; s2 += (v[j][0] * v[j][0] + v[j][1] * v[j][1]) + (v[j][2] * v[j][2] + v[j][3] * v[j][3]); }
        const float rstd = 1.0f / sqrtf(wave_sum(s2) * (1.f / D) + LN_EPS);
        if (layer == 0) {
            bf16* xb = (bf16*)(F.ws + WS_XB) + (size_t)row * D;
#pragma unroll
            for (int j = 0; j < 8; ++j) { const int c = 256 * j + 4 * lane; v[j] = v[j] * rstd * L[j] + B[j]; u32x2 o; o.x = cvt_pk_bf16(v[j][0], v[j][1]); o.y = cvt_pk_bf16(v[j][2], v[j][3]); *(u32x2*)(xb + c) = o; }
            const float* sh = mod_vec(F, 1, mr, 0); const float* scv = mod_vec(F, 1, mr, 1);
#pragma unroll
            for (int j = 0; j < 8; ++j) { const int c = 256 * j + 4 * lane; L[j] = *(const f32x4*)(scv + c); B[j] = *(const f32x4*)(sh + c); }
            SCHED_FENCE();
            bf16* HA = (bf16*)(F.ws + WS_HA) + (size_t)row * D;
#pragma unroll
            for (int j = 0; j < 8; ++j) { const int c = 256 * j + 4 * lane; const f32x4 h = v[j] * (L[j] + 1.0f) + B[j]; u32x2 o; o.x = cvt_pk_bf16(h[0], h[1]); o.y = cvt_pk_bf16(h[2], h[3]); *(u32x2*)(HA + c) = o; }
        } else {
            float* xout = F.out + (size_t)row * D;
#pragma unroll
            for (int j = 0; j < 8; ++j) { const int c = 256 * j + 4 * lane; v[j] = v[j] * rstd * L[j] + B[j]; *(f32x4*)(xout + c) = v[j]; }
        }
    }
#undef LNB_ROW
#undef LNB_LOAD
}

constexpr int LDS_LOGITS = RING_BYTES;
__device__ __forceinline__ void lnA_phase(Frame& F, int layer) {
    PHASE_IDS();
    LAS float* RwL = (LAS float*)F.lds;
    LAS float* LG = (LAS float*)(F.lds + LDS_LOGITS);
    LAS int* cnt = (LAS int*)(F.lds + LDS_MISC + 64);
    for (int idx = tid; idx < D * 4; idx += NTHR) { const int c = idx >> 2, e4 = (idx & 3) * 4; const f32x4 w = *(const f32x4*)(F.in[I_RW] + c * 16 + e4);
        RwL[(e4 + 0) * D + c] = w[0]; RwL[(e4 + 1) * D + c] = w[1]; RwL[(e4 + 2) * D + c] = w[2]; RwL[(e4 + 3) * D + c] = w[3]; }
    if (tid < 16) cnt[tid] = 0;
    __syncthreads();
    const int nrows = layer == 0 ? 68 : 64;
    const float* lg = F.in[I_LNG] + (layer * 2) * D; const float* lb = F.in[I_LNB] + (layer * 2) * D;
    const bf16* MX = (const bf16*)(F.ws + WS_RB);
#define LNA_ROW(li) ((li) < 64 ? F.bid * 64 + (li) : NLAT + F.bid * 4 + ((li) - 64))
#define LNA_XIN(li) ((li) < 64 ? F.in[I_X] + (size_t)(F.bid * 64 + (li)) * D : F.in[I_CTX] + (size_t)(F.bid * 4 + ((li) - 64)) * D)
#define LNA_LOAD(li, X, XH, M) do { const bf16* mp_ = MX + (size_t)LNA_ROW(li) * D; \
        if (layer == 0) { const float* xp_ = LNA_XIN(li); _Pragma("unroll") for (int j = 0; j < 8; ++j) X[j] = *(const f32x4*)(xp_ + 256 * j + 4 * lane); } \
        else { const bf16* xp_ = (const bf16*)(F.ws + WS_XB) + (size_t)LNA_ROW(li) * D; _Pragma("unroll") for (int j = 0; j < 8; ++j) XH[j] = *(const u32x2*)(xp_ + 256 * j + 4 * lane); } \
        _Pragma("unroll") for (int j = 0; j < 8; ++j) M[j] = *(const u32x2*)(mp_ + 256 * j + 4 * lane); } while (0)
    f32x4 xn_[8]; u32x2 xh_[8], mn_[8];
    if (wave < nrows) LNA_LOAD(wave, xn_, xh_, mn_);
    for (int li = wave; li < nrows; li += NWAVES) {
        const int row = LNA_ROW(li); const int mr = mod_row(row);
        bf16* xout = (bf16*)(F.ws + WS_XB) + (size_t)row * D;
        const float* gv = mod_vec(F, layer, mr, 2); const float* sh = mod_vec(F, layer, mr, 3); const float* scv = mod_vec(F, layer, mr, 4);
        f32x4 v[8]; float s = 0.f;
#pragma unroll
        for (int j = 0; j < 8; ++j) { const f32x4 g = *(const f32x4*)(gv + 256 * j + 4 * lane); const f32x4 m = (f32x4){bf_lo(mn_[j].x), bf_hi(mn_[j].x), bf_lo(mn_[j].y), bf_hi(mn_[j].y)};
            const f32x4 x = layer == 0 ? xn_[j] : (f32x4){bf_lo(xh_[j].x), bf_hi(xh_[j].x), bf_lo(xh_[j].y), bf_hi(xh_[j].y)};
            v[j] = x * ALPHA + g * m; s += (v[j][0] + v[j][1]) + (v[j][2] + v[j][3]); }
        if (li + NWAVES < nrows) LNA_LOAD(li + NWAVES, xn_, xh_, mn_);
        f32x4 L[8], B[8], S[8], H[8];
#pragma unroll
        for (int j = 0; j < 8; ++j) { const int c = 256 * j + 4 * lane; L[j] = *(const f32x4*)(lg + c); B[j] = *(const f32x4*)(lb + c); S[j] = *(const f32x4*)(scv + c); H[j] = *(const f32x4*)(sh + c); }
        SCHED_FENCE();
        const float mean = wave_sum(s) * (1.f / D); float s2 = 0.f;
#pragma unroll
        for (int j = 0; j < 8; ++j) { v[j] = v[j] - mean; s2 += (v[j][0] * v[j][0] + v[j][1] * v[j][1]) + (v[j][2] * v[j][2] + v[j][3] * v[j][3]); }
        const float rstd = 1.0f / sqrtf(wave_sum(s2) * (1.f / D) + LN_EPS);
        bf16* HA = (bf16*)(F.ws + WS_HA) + (size_t)row * D;
#pragma unroll
        for (int j = 0; j < 8; ++j) { const int c = 256 * j + 4 * lane; v[j] = v[j] * rstd * L[j] + B[j]; { u32x2 ox; ox.x = cvt_pk_bf16(v[j][0], v[j][1]); ox.y = cvt_pk_bf16(v[j][2], v[j][3]); *(u32x2*)(xout + c) = ox; }
            v[j] = v[j] * (S[j] + 1.0f) + H[j];
            u32x2 o; o.x = cvt_pk_bf16(v[j][0], v[j][1]); o.y = cvt_pk_bf16(v[j][2], v[j][3]); *(u32x2*)(HA + c) = o; }
        float p[16]; f32x4 wA[8], wB[8];
#pragma unroll
        for (int j = 0; j < 8; ++j) wA[j] = *(const LAS f32x4*)(RwL + 256 * j + 4 * lane);
#pragma unroll
        for (int e = 0; e < 16; ++e) {
            if (e + 1 < 16) {
#pragma unroll
                for (int j = 0; j < 8; ++j) { const f32x4 t = *(const LAS f32x4*)(RwL + (e + 1) * D + 256 * j + 4 * lane); if (e & 1) wA[j] = t; else wB[j] = t; } }
            SCHED_FENCE();
            f32x4 a4 = (f32x4){0.f, 0.f, 0.f, 0.f};
#pragma unroll
            for (int j = 0; j < 8; ++j) a4 += v[j] * ((e & 1) ? wB[j] : wA[j]);
            p[e] = (a4[0] + a4[1]) + (a4[2] + a4[3]);
            SCHED_FENCE();
        }
        float q8[8], q4[4], q2[2], q1;
        { const bool hi = (lane & 32) != 0;
#pragma unroll
          for (int i = 0; i < 8; ++i) { const float keep = hi ? p[8 + i] : p[i], give = hi ? p[i] : p[8 + i]; q8[i] = keep + __shfl_xor(give, 32); } }
        { const bool hi = (lane & 16) != 0;
#pragma unroll
          for (int i = 0; i < 4; ++i) { const float keep = hi ? q8[4 + i] : q8[i], give = hi ? q8[i] : q8[4 + i]; q4[i] = keep + __shfl_xor(give, 16); } }
        { const bool hi = (lane & 8) != 0;
#pragma unroll
          for (int i = 0; i < 2; ++i) { const float keep = hi ? q4[2 + i] : q4[i], give = hi ? q4[i] : q4[2 + i]; q2[i] = keep + __shfl_xor(give, 8); } }
        { const bool hi = (lane & 4) != 0; const float keep = hi ? q2[1] : q2[0], give = hi ? q2[0] : q2[1]; q1 = keep + __shfl_xor(give, 4); }
        q1 += __shfl_xor(q1, 1); q1 += __shfl_xor(q1, 2);
        if ((lane & 3) == 0) LG[li * 16 + (lane >> 2)] = q1;
    }
    __syncthreads();
    if (tid < nrows) {
        const int row = LNA_ROW(tid);
        float sg[16], sel[16];
#pragma unroll
        for (int e4 = 0; e4 < 4; ++e4) { const f32x4 l4 = *(const LAS f32x4*)(LG + tid * 16 + 4 * e4); const f32x4 rb4 = *(const f32x4*)(F.in[I_RB] + 4 * e4);
#pragma unroll
            for (int i = 0; i < 4; ++i) { sg[4 * e4 + i] = 1.0f / (1.0f + expf(-l4[i])); sel[4 * e4 + i] = sg[4 * e4 + i] + rb4[i]; } }
        float grp[4];
#pragma unroll
        for (int g = 0; g < 4; ++g) { const float a = sel[4 * g], b = sel[4 * g + 1], c = sel[4 * g + 2], d = sel[4 * g + 3];
            const float h1 = fmaxf(a, b), l1 = fminf(a, b), h2 = fmaxf(c, d), l2 = fminf(c, d); grp[g] = fmaxf(h1, h2) + fmaxf(fminf(h1, h2), fmaxf(l1, l2)); }
        int gb = 0; float best = grp[0];
#pragma unroll
        for (int g = 1; g < 4; ++g) if (grp[g] > best) { best = grp[g]; gb = g; }
        float cs[4], cg[4];
#pragma unroll
        for (int i = 0; i < 4; ++i) { cs[i] = gb == 0 ? sel[i] : gb == 1 ? sel[4 + i] : gb == 2 ? sel[8 + i] : sel[12 + i]; cg[i] = gb == 0 ? sg[i] : gb == 1 ? sg[4 + i] : gb == 2 ? sg[8 + i] : sg[12 + i]; }
        int i0 = 0; float b0 = cs[0];
#pragma unroll
        for (int i = 1; i < 4; ++i) if (cs[i] > b0) { b0 = cs[i]; i0 = i; }
        int i1 = -1; float b1 = 0.f;
#pragma unroll
        for (int i = 0; i < 4; ++i) if (i != i0 && (i1 < 0 || cs[i] > b1)) { b1 = cs[i]; i1 = i; }
        const float s0 = i0 == 0 ? cg[0] : i0 == 1 ? cg[1] : i0 == 2 ? cg[2] : cg[3], s1 = i1 == 0 ? cg[0] : i1 == 1 ? cg[1] : i1 == 2 ? cg[2] : cg[3];
        const float den = s0 + s1; const int e0 = 4 * gb + i0, e1 = 4 * gb + i1;
        int* rt = (int*)(F.ws + WS_ROUTE) + (size_t)row * 4; rt[0] = e0; rt[1] = e1; ((float*)rt)[2] = s0 / den; ((float*)rt)[3] = s1 / den;
        __hip_atomic_fetch_add(cnt + e0, 1, __ATOMIC_RELAXED, __HIP_MEMORY_SCOPE_WORKGROUP); __hip_atomic_fetch_add(cnt + e1, 1, __ATOMIC_RELAXED, __HIP_MEMORY_SCOPE_WORKGROUP);
    }
    __syncthreads();
    if (tid < 16) ((int*)(F.ws + WS_BLKCNT))[F.bid * 16 + tid] = cnt[tid];
#undef LNA_ROW
#undef LNA_XIN
#undef LNA_LOAD
}

__device__ __forceinline__ void list_phase(Frame& F, int layer) {
    PHASE_IDS();
    LAS int* bc = (LAS int*)F.lds;
    LAS int* base = bc + 4096;
    LAS int* tot = base + 16;
    LAS int* tpre = tot + 16;
    const int* blk = (const int*)(F.ws + WS_BLKCNT);
    for (int idx = tid; idx < 4096; idx += NTHR) bc[idx] = blk[idx];
    __syncthreads();
    if (tid < 16) { int s = 0, b0 = 0; for (int b = 0; b < 256; ++b) { if (b == F.bid) b0 = s; s += bc[b * 16 + tid]; } base[tid] = b0; tot[tid] = s; }
    __syncthreads();
    if (tid == 0) { int t = 0; for (int e = 0; e < 16; ++e) { tpre[e] = t; t += (tot[e] + 255) >> 8; } tpre[16] = t; }
    __syncthreads();
    int* srow = (int*)(F.ws + WS_SROW); float* swt = (float*)(F.ws + WS_SWT);
    if (tid < 16) { const int e = tid; int pos = tpre[e] * 256 + base[e];
        const int nrows = (layer == 0) ? 68 : 64;
        for (int i = 0; i < nrows; ++i) { const int row = i < 64 ? F.bid * 64 + i : NLAT + F.bid * 4 + (i - 64);
            const int* rt = (const int*)(F.ws + WS_ROUTE) + (size_t)row * 4; const int e0 = rt[0], e1 = rt[1];
            if (e0 == e) { srow[pos] = row * 2; swt[pos] = ((const float*)rt)[2]; ++pos; }
            if (e1 == e) { srow[pos] = row * 2 + 1; swt[pos] = ((const float*)rt)[3]; ++pos; } } }
    if (F.bid < 16) { const int e = F.bid, lo = tpre[e] * 256 + tot[e], hi = tpre[e + 1] * 256; for (int p = lo + tid; p < hi; p += NTHR) { srow[p] = -1; swt[p] = 0.f; } }
    if (F.bid == 0) { int* te = (int*)(F.ws + WS_TILEE); for (int t = tid; t < tpre[16]; t += NTHR) { int e = 0; for (int q = 1; q < 16; ++q) if (t >= tpre[q]) e = q; te[t] = e; } if (tid == 0) *(int*)(F.ws + WS_TTOT) = tpre[16]; }
}

__device__ __forceinline__ void moe_gemm1(Frame& F, int layer) {
    PHASE_IDS();
    LAS int* te = (LAS int*)(F.lds + LDS_TILEE);
    const int T = *(const int*)(F.ws + WS_TTOT);
    for (int t = tid; t < T && t < 160; t += NTHR) te[t] = ((const int*)(F.ws + WS_TILEE))[t];
    __syncthreads();
    pg8::SchedMoe S; S.A = (const char*)(F.ws + WS_HA); S.Bt = (const char*)(F.ws + WS_WT_E1) + (size_t)layer * NE * D * D * 2; S.srow = (const int*)(F.ws + WS_SROW); S.tile_e = te;
    S.nM = T; S.nN = 8; S.G = F.G; S.c = F.bid; S.tstepA = 0; S.tstepB = (size_t)256 * D * 2; S.estepB = (size_t)D * D * 2;
    pg8::EpiMoe1 E{(bf16*)(F.ws + WS_RH)};
    pg8::gemm_phase<pg8::EpiMoe1, pg8::SchedMoe, true>(F.lds, F.wave0, D, S, E);
}
__device__ __forceinline__ void moe_gemm2(Frame& F, int layer) {
    PHASE_IDS();
    LAS int* te = (LAS int*)(F.lds + LDS_TILEE);
    const int T = *(const int*)(F.ws + WS_TTOT);
    for (int t = tid; t < T && t < 160; t += NTHR) te[t] = ((const int*)(F.ws + WS_TILEE))[t];
    __syncthreads();
    pg8::SchedMoe S; S.A = (const char*)(F.ws + WS_RH); S.Bt = (const char*)(F.ws + WS_WT_E2) + (size_t)layer * NE * D * DE * 2; S.srow = nullptr; S.tile_e = te;
    S.nM = T; S.nN = 8; S.G = F.G; S.c = F.bid; S.tstepA = (size_t)256 * DE * 2; S.tstepB = (size_t)256 * DE * 2; S.estepB = (size_t)D * DE * 2;
    pg8::EpiMoe2 E{(bf16*)(F.ws + WS_REX), (const int*)(F.ws + WS_SROW), (const float*)(F.ws + WS_SWT)};
    pg8::gemm_phase<pg8::EpiMoe2, pg8::SchedMoe, false>(F.lds, F.wave0, DE, S, E);
}

constexpr int SC_QS = 0, SC_KS = 17408, SC_VS = 34816, SC_VW = 46080, SC_PS = 57344, SC_CB0 = 66560, SC_CB1 = 88320, SC_GA = 110080;
constexpr int QP = 136, VP = 88, PP = 72;
__device__ __forceinline__ bf16x8 lds_row8(const LAS unsigned char* base, int row, int pitch, int col) { return *(const LAS bf16x8*)(base + (row * pitch + col) * 2); }
typedef short v4i16_t __attribute__((ext_vector_type(4)));
__device__ __forceinline__ bf16x8 lds_tr8(const LAS unsigned char* base, int pitch, int k0, int x0, int lane) {
    const int g = lane >> 4, q = (lane & 15) >> 2, p = lane & 3;
    const LAS unsigned char* a = base + ((k0 + 8 * g + q) * pitch + x0 + 4 * p) * 2;
    const s16x4 lo = __builtin_bit_cast(s16x4, __builtin_amdgcn_ds_read_tr16_b64_v4i16((LAS v4i16_t*)a));
    const s16x4 hi = __builtin_bit_cast(s16x4, __builtin_amdgcn_ds_read_tr16_b64_v4i16((LAS v4i16_t*)(a + 4 * pitch * 2)));
    return (bf16x8){lo[0], lo[1], lo[2], lo[3], hi[0], hi[1], hi[2], hi[3]};
}
constexpr size_t WS_GSCR = 810 * MiB;
__device__ __forceinline__ float fexp(float x) { return __builtin_amdgcn_exp2f(x * 1.44269504088896f); }
__device__ __forceinline__ void scan_phase(Frame& F) {
    PHASE_IDS();
    const int x8 = F.bid & 7, y = F.bid >> 3, vs = y & 3, grp = x8 * 8 + (y >> 2), dir = grp & 1, hh = (grp >> 1) & 7, bb = grp >> 4;
    const int w = wave, i16 = lane & 15, g = lane >> 4;
    const bf16* QKVO = (const bf16*)(F.ws + WS_RC); const float* GT = (const float*)(F.ws + WS_GATES);
    bf16* HOUT = dir == 0 ? (bf16*)(F.ws + WS_RB) : (bf16*)(F.ws + WS_HB2);
    float* GS = (float*)(F.ws + WS_GSCR) + (size_t)F.bid * (68 * 192);
    LAS unsigned char* L = F.lds;
    LAS float* SE = (LAS float*)(L + SC_GA + 2560);
#define SCAN_TOK(step, r) ((step) < 4 ? (NLAT + bb * CTXL + (dir ? (CTXL - 1 - ((step) * 64 + (r))) : ((step) * 64 + (r)))) : (bb * SEQ + (dir ? (SEQ - 1 - (((step) - 4) * 64 + (r))) : (((step) - 4) * 64 + (r)))))
    for (int idx = tid; idx < 64 * 24; idx += NTHR) { const int r = idx / 24, c = 64 + idx % 24; ((LAS bf16*)(L + SC_VS))[r * VP + c] = (c == 64) ? (bf16)0x3F80 : (bf16)0; ((LAS bf16*)(L + SC_VW))[r * VP + c] = 0; }
    { const float big = F.in[I_MBG][(dir * 2) * 8 + hh], bfg = F.in[I_MBG][(dir * 2 + 1) * 8 + hh];
      for (int step = w; step < 68; step += NWAVES) {
        const size_t tg = (size_t)SCAN_TOK(step, lane); const float gi = GT[tg * 32 + (dir * 2) * 8 + hh] + big, gf = GT[tg * 32 + (dir * 2 + 1) * 8 + hh] + bfg;
        const float lf = fminf(gf, 0.f) - log1pf(expf(-fabsf(gf)));
        float bc = lf;
#pragma unroll
        for (int o = 1; o < 64; o <<= 1) { const float t = __shfl_up(bc, o); if (lane >= o) bc += t; }
        const float a = gi - bc; float cm = a;
#pragma unroll
        for (int o = 1; o < 64; o <<= 1) { const float t = __shfl_up(cm, o); if (lane >= o) cm = fmaxf(cm, t); }
        GS[step * 192 + lane] = a; GS[step * 192 + 64 + lane] = bc; GS[step * 192 + 128 + lane] = cm;
        if (lane == 63) { SE[step] = bc; SE[68 + step] = cm; } } }
    __syncthreads();
    if (tid == 0) { float m = 0.f; for (int st = 0; st < 68; ++st) { SE[136 + st] = m; m = SE[st] + fmaxf(m, SE[68 + st]); } }
    f32x4 accc[5];
#pragma unroll
    for (int i = 0; i < 5; ++i) accc[i] = (f32x4){0.f, 0.f, 0.f, 0.f};
    const int qr0 = tid >> 4, qc = (tid & 15) * 8;
    const int vr = tid >> 3, vc = (tid & 7) * 8;
    u32x4 rq0, rq1, rk0, rk1, rv; float ga = 0.f, gb = 0.f, gc = 0.f, av = 0.f;
#define SCAN_LOAD(step) do { const size_t t0_ = (size_t)SCAN_TOK(step, qr0), t1_ = (size_t)SCAN_TOK(step, qr0 + 32), tv_ = (size_t)SCAN_TOK(step, vr); \
        if ((step) >= 4) { rq0 = *(const u32x4*)(QKVO + t0_ * MLW + hh * DQK + qc); rq1 = *(const u32x4*)(QKVO + t1_ * MLW + hh * DQK + qc); } \
        rk0 = *(const u32x4*)(QKVO + t0_ * MLW + 1024 + hh * DQK + qc); rk1 = *(const u32x4*)(QKVO + t1_ * MLW + 1024 + hh * DQK + qc); \
        rv = *(const u32x4*)(QKVO + tv_ * MLW + 2048 + hh * DV + vs * 64 + vc); av = GS[(step) * 192 + vr]; \
        if (w == 0) { ga = GS[(step) * 192 + lane]; gb = GS[(step) * 192 + 64 + lane]; gc = GS[(step) * 192 + 128 + lane]; } } while (0)
    __syncthreads();
    SCAN_LOAD(0);
    for (int step = 0; step < 68; ++step) {
        const bool outp = step >= 4;
        LAS float* GA = (LAS float*)(L + SC_GA) + (step & 1) * 320;
        LAS unsigned char* CBc = L + ((step & 1) ? SC_CB1 : SC_CB0); LAS unsigned char* CBn = L + ((step & 1) ? SC_CB0 : SC_CB1);
        const float m_st = SE[136 + step], Mend = fmaxf(m_st, SE[68 + step]), decay = fexp(m_st - Mend);
        __syncthreads();
        if (w == 0) { const float M = fmaxf(m_st, gc); GA[lane] = ga; GA[64 + lane] = M; GA[128 + lane] = fexp(m_st - M); GA[192 + lane] = fexp(-(gb + M)); }
        if (outp) { *(LAS u32x4*)(L + SC_QS + (qr0 * QP + qc) * 2) = rq0; *(LAS u32x4*)(L + SC_QS + ((qr0 + 32) * QP + qc) * 2) = rq1; }
        *(LAS u32x4*)(L + SC_KS + (qr0 * QP + qc) * 2) = rk0; *(LAS u32x4*)(L + SC_KS + ((qr0 + 32) * QP + qc) * 2) = rk1;
        *(LAS u32x4*)(L + SC_VS + (vr * VP + vc) * 2) = rv;
        { const float wr_ = fexp(av - Mend); u32x4 o; o.x = cvt_pk_bf16(bf_lo(rv.x) * wr_, bf_hi(rv.x) * wr_); o.y = cvt_pk_bf16(bf_lo(rv.y) * wr_, bf_hi(rv.y) * wr_); o.z = cvt_pk_bf16(bf_lo(rv.z) * wr_, bf_hi(rv.z) * wr_); o.w = cvt_pk_bf16(bf_lo(rv.w) * wr_, bf_hi(rv.w) * wr_);
          *(LAS u32x4*)(L + SC_VW + (vr * VP + vc) * 2) = o;
          if (vc == 0) ((LAS bf16*)(L + SC_VW))[vr * VP + 64] = (bf16)(cvt_pk_bf16(wr_, 0.f) & 0xffffu); }
        if (step + 1 < 68) SCAN_LOAD(step + 1);
        __syncthreads();
        const int tb = w & 3;
        if (outp) {
            const int sb0 = 2 * (w >> 2);
            f32x4 sa[2] = {(f32x4){0.f, 0.f, 0.f, 0.f}, (f32x4){0.f, 0.f, 0.f, 0.f}};
#pragma unroll
            for (int ks = 0; ks < 4; ++ks) { const bf16x8 bq = lds_row8(L + SC_QS, 16 * tb + i16, QP, 32 * ks + 8 * g);
#pragma unroll
                for (int j = 0; j < 2; ++j) { const bf16x8 ak = lds_row8(L + SC_KS, 16 * (sb0 + j) + i16, QP, 32 * ks + 8 * g); sa[j] = __builtin_amdgcn_mfma_f32_16x16x32_bf16(ak, bq, sa[j], 0, 0, 0); } }
            const int t = 16 * tb + i16; const float Mt = GA[64 + t];
#pragma unroll
            for (int j = 0; j < 2; ++j) { const int s0 = 16 * (sb0 + j) + 4 * g; const f32x4 a4 = *(const LAS f32x4*)(GA + s0); float p[4];
#pragma unroll
                for (int r = 0; r < 4; ++r) p[r] = (s0 + r <= t) ? fexp(a4[r] - Mt) * sa[j][r] : 0.f;
                u32x2 o; o.x = cvt_pk_bf16(p[0], p[1]); o.y = cvt_pk_bf16(p[2], p[3]); *(LAS u32x2*)(L + SC_PS + (t * PP + s0) * 2) = o; }
        }
#pragma unroll
        for (int i = 0; i < 5; ++i) accc[i] = accc[i] * decay;
#pragma unroll
        for (int ks = 0; ks < 2; ++ks) { const bf16x8 ak = lds_tr8(L + SC_KS, QP, 32 * ks, 16 * w, lane);
#pragma unroll
            for (int i = 0; i < 5; ++i) { const bf16x8 bv = lds_tr8(L + SC_VW, VP, 32 * ks, 16 * i, lane); accc[i] = __builtin_amdgcn_mfma_f32_16x16x32_bf16(ak, bv, accc[i], 0, 0, 0); } }
#pragma unroll
        for (int i = 0; i < 5; ++i) { u32x2 o; o.x = cvt_pk_bf16(accc[i][0], accc[i][1]); o.y = cvt_pk_bf16(accc[i][2], accc[i][3]); *(LAS u32x2*)(CBn + ((16 * i + i16) * QP + 16 * w + 4 * g) * 2) = o; }
        if (outp) {
            __syncthreads();
            const int half = w >> 2; const int vb[3] = {2 * half, 2 * half + 1, 4};
            f32x4 oa[3] = {(f32x4){0.f, 0.f, 0.f, 0.f}, (f32x4){0.f, 0.f, 0.f, 0.f}, (f32x4){0.f, 0.f, 0.f, 0.f}};
#pragma unroll
            for (int ks = 0; ks < 4; ++ks) { const bf16x8 bq = lds_row8(L + SC_QS, 16 * tb + i16, QP, 32 * ks + 8 * g);
#pragma unroll
                for (int j = 0; j < 3; ++j) { const bf16x8 ac = lds_row8(CBc, 16 * vb[j] + i16, QP, 32 * ks + 8 * g); oa[j] = __builtin_amdgcn_mfma_f32_16x16x32_bf16(ac, bq, oa[j], 0, 0, 0); } }
            const int t = 16 * tb + i16; const float it = GA[128 + t];
#pragma unroll
            for (int j = 0; j < 3; ++j) oa[j] = oa[j] * it;
#pragma unroll
            for (int ks = 0; ks < 2; ++ks) { const bf16x8 bp = lds_row8(L + SC_PS, 16 * tb + i16, PP, 32 * ks + 8 * g);
#pragma unroll
                for (int j = 0; j < 3; ++j) { const bf16x8 av8 = lds_tr8(L + SC_VS, VP, 32 * ks, 16 * vb[j], lane); oa[j] = __builtin_amdgcn_mfma_f32_16x16x32_bf16(av8, bp, oa[j], 0, 0, 0); } }
            const float den = __shfl(oa[2][0], i16);
            const float inv = __builtin_amdgcn_rcpf(fmaxf(fabsf(den), GA[192 + t]));
            const size_t tok = (size_t)SCAN_TOK(step, t);
#pragma unroll
            for (int j = 0; j < 2; ++j) { u32x2 o; o.x = cvt_pk_bf16(oa[j][0] * inv, oa[j][1] * inv); o.y = cvt_pk_bf16(oa[j][2] * inv, oa[j][3] * inv);
                *(u32x2*)(HOUT + tok * D + hh * DV + vs * 64 + 16 * vb[j] + 4 * g) = o; }
        }
    }
    __syncthreads();
#undef SCAN_TOK
#undef SCAN_LOAD
}

__device__ __forceinline__ void headnorm_phase(Frame& F) {
    PHASE_IDS();
    const int gw = F.bid * NWAVES + wave, NGW = F.G * NWAVES;
    const bf16* HF = (const bf16*)(F.ws + WS_RB); const bf16* HB = (const bf16*)(F.ws + WS_HB2); const bf16* QKVO = (const bf16*)(F.ws + WS_RC); bf16* Y = (bf16*)(F.ws + WS_HA);
    const float* ng = F.in[I_MNG];
    f32x4 gn[4][2];
#pragma unroll
    for (int j = 0; j < 4; ++j) { gn[j][0] = *(const f32x4*)(ng + 512 * j + 8 * lane); gn[j][1] = *(const f32x4*)(ng + 512 * j + 8 * lane + 4); }
    u32x4 an[4], bn[4], on[4];
#define HN_LOAD(row) do { _Pragma("unroll") for (int j = 0; j < 4; ++j) { const int c = 512 * j + 8 * lane; an[j] = *(const u32x4*)(HF + (size_t)(row) * D + c); bn[j] = *(const u32x4*)(HB + (size_t)(row) * D + c); on[j] = *(const u32x4*)(QKVO + (size_t)(row) * MLW + 4096 + c); } } while (0)
    if (gw < NLAT) HN_LOAD(gw);
    for (int row = gw; row < NLAT; row += NGW) {
        u32x4 a[4], b[4], o[4];
#pragma unroll
        for (int j = 0; j < 4; ++j) { a[j] = an[j]; b[j] = bn[j]; o[j] = on[j]; }
        if (row + NGW < NLAT) HN_LOAD(row + NGW);
        SCHED_FENCE();
#pragma unroll
        for (int j = 0; j < 4; ++j) {
            float h[8]; float s = 0.f;
#pragma unroll
            for (int q = 0; q < 4; ++q) { h[2 * q] = bf_lo(a[j][q]) + bf_lo(b[j][q]); h[2 * q + 1] = bf_hi(a[j][q]) + bf_hi(b[j][q]); s += h[2 * q] + h[2 * q + 1]; }
#pragma unroll
            for (int o2 = 1; o2 < 32; o2 <<= 1) s += __shfl_xor(s, o2);
            const float mean = s * (1.f / DV); float s2 = 0.f;
#pragma unroll
            for (int q = 0; q < 8; ++q) { h[q] -= mean; s2 += h[q] * h[q]; }
#pragma unroll
            for (int o2 = 1; o2 < 32; o2 <<= 1) s2 += __shfl_xor(s2, o2);
            const float rstd = 1.0f / sqrtf(s2 * (1.f / DV) + HN_EPS);
            float yv[8];
#pragma unroll
            for (int q = 0; q < 4; ++q) { const float o0 = bf_lo(o[j][q]), o1 = bf_hi(o[j][q]); const float n0 = gn[j][q >> 1][2 * (q & 1)], n1 = gn[j][q >> 1][2 * (q & 1) + 1];
                yv[2 * q] = h[2 * q] * rstd * n0 * __builtin_amdgcn_rcpf(1.0f + __expf(-o0)); yv[2 * q + 1] = h[2 * q + 1] * rstd * n1 * __builtin_amdgcn_rcpf(1.0f + __expf(-o1)); }
            u32x4 wv; wv.x = cvt_pk_bf16(yv[0], yv[1]); wv.y = cvt_pk_bf16(yv[2], yv[3]); wv.z = cvt_pk_bf16(yv[4], yv[5]); wv.w = cvt_pk_bf16(yv[6], yv[7]);
            *(u32x4*)(Y + (size_t)row * D + 512 * j + 8 * lane) = wv;
        }
    }
#undef HN_LOAD
}

constexpr int NPH = 19;
__global__ void __launch_bounds__(NTHR, 2) fwd_kernel(Args args) {
    extern __shared__ __attribute__((aligned(16))) unsigned char lds_raw[];
    Frame F;
    F.lds = (LAS unsigned char*)lds_raw;
    F.G = gridDim.x; F.bid = blockIdx.x; F.wave0 = __builtin_amdgcn_readfirstlane(threadIdx.x >> 6);
#pragma unroll
    for (int i = 0; i < 21; ++i) F.in[i] = args.in[i];
    F.out = args.out; F.ws = args.ws;
    for (int u = threadIdx.x; u < (LDS_BYTES - LDSCTL_OFF) / 4; u += NTHR) ((LAS unsigned*)(F.lds + LDSCTL_OFF))[u] = 0u;
    __syncthreads();
#if MK_N_LAUNCHES == 1
    XcdBarrier bar = xcd_barrier_post((unsigned*)(F.ws + WS_CTL) + CW_BAR, (volatile LAS unsigned*)(F.lds + LDS_MISC));
#define GRID_BAR() xcd_barrier(bar)
#else
#define GRID_BAR() do { } while (0)
#endif
    const int lo = args.ph_lo, hi = args.ph_hi;
#ifndef PHASE_MASK
#define PHASE_MASK 0x7ffff
#endif
#define IN(k) (((PHASE_MASK >> (k)) & 1) && lo <= (k) && (k) < hi)
#define SEAM(k) do { if (IN(k) && IN((k) + 1)) GRID_BAR(); } while (0)

#ifndef DUP_MASK
#define DUP_MASK 0x0
#endif
#define PHASE(k, body) do { if (IN(k)) { body; if ((DUP_MASK >> (k)) & 1) { GRID_BAR(); body; } } SEAM(k); } while (0)
    PHASE(0, p0_prologue(F));
    PHASE(1, p1_modulate(F));
    PHASE(2, ({
        pg8::SchedPlain S; S.init((const bf16*)(F.ws + WS_HA), (const bf16*)(F.ws + WS_WT_CIN), NTOK, 6144, D, F.G, F.bid);
        pg8::EpiConv1 E{(bf16*)(F.ws + WS_RB), (bf16*)(F.ws + WS_RC)};
        pg8::gemm_phase<pg8::EpiConv1, pg8::SchedPlain, false>(F.lds, F.wave0, D, S, E); }));
    PHASE(3, p3_conv(F));
    PHASE(4, ({
        pg8::SchedPlain S; S.init((const bf16*)(F.ws + WS_HA), (const bf16*)(F.ws + WS_WT_COUT), NTOK, D, D, F.G, F.bid);
        pg8::EpiBf16 E{(bf16*)(F.ws + WS_RB), D};
        pg8::gemm_phase<pg8::EpiBf16, pg8::SchedPlain, false>(F.lds, F.wave0, D, S, E); }));
    PHASE(5, lnA_phase(F, 0));
    PHASE(6, list_phase(F, 0));
    PHASE(7, moe_gemm1(F, 0));
    PHASE(8, moe_gemm2(F, 0));
    PHASE(9, lnB_phase(F, 0));
    PHASE(10, ({
        pg8::SchedPlain S; S.init((const bf16*)(F.ws + WS_HA), (const bf16*)(F.ws + WS_WT_MIN), NTOK, MLN, D, F.G, F.bid);
        pg8::EpiMlIn E{(bf16*)(F.ws + WS_RC), (float*)(F.ws + WS_GATES)};
        pg8::gemm_phase<pg8::EpiMlIn, pg8::SchedPlain, false>(F.lds, F.wave0, D, S, E); }));
    PHASE(11, scan_phase(F));
    PHASE(12, headnorm_phase(F));
    PHASE(13, ({
        pg8::SchedPlain S; S.init((const bf16*)(F.ws + WS_HA), (const bf16*)(F.ws + WS_WT_MOUT), NLAT, D, D, F.G, F.bid);
        pg8::EpiBf16 E{(bf16*)(F.ws + WS_RB), D};
        pg8::gemm_phase<pg8::EpiBf16, pg8::SchedPlain, false>(F.lds, F.wave0, D, S, E); }));
    PHASE(14, lnA_phase(F, 1));
    PHASE(15, list_phase(F, 1));
    PHASE(16, moe_gemm1(F, 1));
    PHASE(17, moe_gemm2(F, 1));
    PHASE(18, lnB_phase(F, 1));
#undef PHASE
#undef IN
#undef SEAM
}

extern "C" void kernel_launch(void* const* d_in, const int* in_sizes, int n_in, void* d_out, int out_size, void* d_ws, size_t ws_size, hipStream_t stream) {
    static int grid = 0;
    if (grid == 0) {
        if (n_in != 21 || out_size != NLAT * D || ws_size < WS_END) { fprintf(stderr, "kernel_launch: unexpected problem (n_in %d, out %d, ws %zu; need ws >= %zu)\n", n_in, out_size, ws_size, (size_t)WS_END); grid = -1; return; }
        int dev = 0, cus = 0, per_cu = 0;
        if (hipGetDevice(&dev) != hipSuccess || hipDeviceGetAttribute(&cus, hipDeviceAttributeMultiprocessorCount, dev) != hipSuccess) { grid = -1; return; }
        if (hipFuncSetAttribute((const void*)fwd_kernel, hipFuncAttributeMaxDynamicSharedMemorySize, LDS_BYTES) != hipSuccess) { fprintf(stderr, "kernel_launch: hipFuncSetAttribute failed\n"); grid = -1; return; }
        if (hipOccupancyMaxActiveBlocksPerMultiprocessor(&per_cu, (const void*)fwd_kernel, NTHR, LDS_BYTES) != hipSuccess || per_cu < 1) fprintf(stderr, "kernel_launch: occupancy query reports %d\n", per_cu);
        (void)hipGetLastError();
        if (cus < GRID) { fprintf(stderr, "kernel_launch: needs %d CUs, device has %d\n", GRID, cus); grid = -1; return; }
        grid = GRID;
    }
    if (grid < 0) return;
    (void)in_sizes;
    if (hipMemsetAsync((char*)d_ws + WS_CTL, 0, CTL_ZERO_BYTES, stream) != hipSuccess) return;
    Args a{};
    for (int i = 0; i < 21; ++i) a.in[i] = (const float*)d_in[i];
    a.out = (float*)d_out; a.ws = (unsigned char*)d_ws;
#if MK_N_LAUNCHES == 1
    a.ph_lo = 0; a.ph_hi = NPH;
    hipLaunchKernelGGL(fwd_kernel, dim3(grid), dim3(NTHR), LDS_BYTES, stream, a);
#else
    for (int p = 0; p < NPH; ++p) { a.ph_lo = p; a.ph_hi = p + 1; hipLaunchKernelGGL(fwd_kernel, dim3(grid), dim3(NTHR), LDS_BYTES, stream, a); }
#endif
}
```

```cpp
#include <hip/hip_runtime.h>
#include <cstdio>
#include <cstdint>

#ifndef MK_N_LAUNCHES
#define MK_N_LAUNCHES 1
#endif

#define LAS __attribute__((address_space(3)))
typedef unsigned short bf16;
typedef short bf16x8 __attribute__((ext_vector_type(8)));
typedef short s16x4 __attribute__((ext_vector_type(4)));
typedef float f32x4 __attribute__((ext_vector_type(4)));
typedef unsigned u32x4 __attribute__((ext_vector_type(4)));
typedef unsigned u32x2 __attribute__((ext_vector_type(2)));

constexpr int D = 2048, NB = 4, SEQ = 4096, NLAT = NB * SEQ, CTXL = 256, NCTX = NB * CTXL, NTOK = NLAT + NCTX;
constexpr int NE = 16, DE = 1024, NH = 8, DQK = 128, DV = 256;
constexpr int MLW = 6144, MLN = 6400;
constexpr int NWAVES = 8, NTHR = 512, GRID = 256;
constexpr float ALPHA = 1.41421356237f, LN_EPS = 1e-5f, HN_EPS = 1e-6f;
constexpr int MAXTILES = 153;

constexpr size_t MiB = 1u << 20;
constexpr size_t WS_CTL = 0, CTL_ZERO_BYTES = 1 * MiB;
constexpr size_t WS_MOD = 1 * MiB;
constexpr size_t WS_MISC = 2 * MiB;
constexpr int CAP = 17408;
constexpr size_t WS_SROW = WS_MISC + 0, WS_SWT = WS_MISC + 0x200000;
constexpr int CW_GCNT = 12288;
constexpr size_t WS_CTXRES = 6 * MiB;
constexpr size_t WS_GATES = 14 * MiB;
constexpr size_t WS_WT_CIN = 17 * MiB, WS_WT_COUT = 41 * MiB, WS_WT_MIN = 49 * MiB, WS_WT_MOUT = 74 * MiB, WS_WT_E1 = 82 * MiB, WS_WT_E2 = 338 * MiB;
constexpr size_t WS_HA = 466 * MiB, WS_RB = 534 * MiB, WS_RC = 602 * MiB, WS_RH = 670 * MiB, WS_REX = 747 * MiB, WS_HB2 = 883 * MiB, WS_XB = 947 * MiB, WS_END = 1015 * MiB;
constexpr int CW_BAR = 4096;

constexpr int RING_BYTES = 131072, LDSCTL_OFF = 139264, LDS_TILEE = LDSCTL_OFF, LDS_TILEV = LDSCTL_OFF + 1024, LDS_MISC = LDSCTL_OFF + 2048, LDS_BYTES = 147456;

__device__ __forceinline__ unsigned cvt_pk_bf16(float lo, float hi) { unsigned r; asm volatile("v_cvt_pk_bf16_f32 %0, %1, %2" : "=v"(r) : "v"(lo), "v"(hi)); return r; }
__device__ __forceinline__ float bf_lo(unsigned u) { return __uint_as_float(u << 16); }
__device__ __forceinline__ float bf_hi(unsigned u) { return __uint_as_float(u & 0xffff0000u); }
__device__ __forceinline__ float wave_sum(float v) {
#pragma unroll
    for (int o = 1; o < 64; o <<= 1) v += __shfl_xor(v, o);
    return v;
}
#define LDS_WAIT() asm volatile("s_waitcnt lgkmcnt(0)" ::: "memory")
#define VM_WAIT() asm volatile("s_waitcnt vmcnt(0)" ::: "memory")

#define XB_TMO      128
#define XB_XCNT(j)  (256  + 64 * (j))
#define XB_XSUB(j)  (1280 + 64 * (j))
#define XB_XGEN(j)  (2304 + 64 * (j))
#define XB_TOP      3328
#define XB_TOPGEN   3392
#define XCD_BAR_WORDS 3456
#define XB_SPIN_CAP (1u << 18)
__device__ __forceinline__ unsigned xb_ld(unsigned* p)              { return __hip_atomic_load(p, __ATOMIC_RELAXED, __HIP_MEMORY_SCOPE_AGENT); }
__device__ __forceinline__ unsigned xb_add(unsigned* p, unsigned v) { return __hip_atomic_fetch_add(p, v, __ATOMIC_RELAXED, __HIP_MEMORY_SCOPE_AGENT); }
__device__ __forceinline__ unsigned xb_xcc_id() { return (unsigned)__builtin_amdgcn_s_getreg((3 << 11) | 20) & 0xFu; }
#define XB_SPIN(cond, bar) do { unsigned _sp = 0; while (cond) { __builtin_amdgcn_s_sleep(1); \
    if ((++_sp & 255u) == 0u) { if (xb_ld(&(bar)[XB_TMO])) break; if (_sp > XB_SPIN_CAP) { atomicAdd(&(bar)[XB_TMO], 1u); break; } } } } while (0)
struct XcdBarrier { unsigned* bar; unsigned x; volatile LAS unsigned* st; };
__device__ __forceinline__ XcdBarrier xcd_barrier_post(unsigned* bar, volatile LAS unsigned* st) {
    XcdBarrier b; b.bar = bar; b.x = xb_xcc_id(); b.st = st;
    if (threadIdx.x == 0) (void)xb_add(&bar[XB_XCNT(b.x)], 1u);
    return b;
}
__device__ __forceinline__ void xcd_barrier_complete(unsigned* bar, unsigned x, unsigned& nloc, unsigned& nx) {
    const unsigned G = gridDim.x * gridDim.y * gridDim.z;
    unsigned sum, cnt, mine, sp = 0u;
    for (;;) {
        sum = 0u; cnt = 0u; mine = 0u;
#pragma unroll
        for (unsigned j = 0; j < 16; ++j) { const unsigned c = xb_ld(&bar[XB_XCNT(j)]); sum += c; cnt += (c > 0u) ? 1u : 0u; mine = (j == x) ? c : mine; }
        if (sum == G) break;
        __builtin_amdgcn_s_sleep(1);
        if ((++sp & 255u) == 0u) { if (xb_ld(&bar[XB_TMO])) break; if (sp > XB_SPIN_CAP) { atomicAdd(&bar[XB_TMO], 1u); break; } }
    }
    nloc = mine > 0u ? mine : 1u; nx = cnt > 0u ? cnt : 1u;
}
__device__ __forceinline__ void xcd_barrier(const XcdBarrier& b) {
    asm volatile("s_waitcnt vmcnt(0)" ::: "memory");
    __syncthreads();
    if (threadIdx.x == 0) {
        unsigned* bar = b.bar;
        __builtin_amdgcn_s_waitcnt(0);
        unsigned nloc = b.st[0], nx = b.st[1];
        if (nloc == 0u) { xcd_barrier_complete(bar, b.x, nloc, nx); b.st[0] = nloc; b.st[1] = nx; }
        const unsigned old = xb_add(&bar[XB_XSUB(b.x)], 1u);
        const unsigned gen = old / nloc;
        if (old + 1u == (gen + 1u) * nloc) {
            __builtin_amdgcn_fence(__ATOMIC_RELEASE, "agent");
            asm volatile("s_waitcnt vmcnt(0)" ::: "memory");
            const unsigned og = xb_add(&bar[XB_TOP], 1u);
            const unsigned tg = og / nx;
            if (og + 1u == (tg + 1u) * nx) xb_add(&bar[XB_TOPGEN], 1u);
            else XB_SPIN(xb_ld(&bar[XB_TOPGEN]) == tg, bar);
            __builtin_amdgcn_fence(__ATOMIC_ACQUIRE, "agent");
            xb_add(&bar[XB_XGEN(b.x)], 1u);
            asm volatile("s_waitcnt vmcnt(0)" ::: "memory");
        } else {
            XB_SPIN(xb_ld(&bar[XB_XGEN(b.x)]) == gen, bar);
            __builtin_amdgcn_fence(__ATOMIC_ACQUIRE, "agent");
            asm volatile("s_waitcnt vmcnt(0)" ::: "memory");
        }
    }
    __syncthreads();
}

namespace pg8 {
constexpr int BM = 256, BK = 64, HALF = 128, HTB = HALF * BK * 2, NXCD = 8, WGM = 8;
__device__ __forceinline__ int lds_byte(int r, int c) { const int st = (r >> 4) * 2 + (c >> 5), rr = r & 15, cc = c & 31, ob = rr * 64 + cc * 2; return st * 1024 + (ob ^ (((ob >> 9) & 1) << 5)); }
__device__ __forceinline__ void stage_rc(int b, int& R, int& C) { const int st = b / 1024, sb = b % 1024, swz = sb ^ (((sb >> 9) & 1) << 5); R = (st >> 1) * 16 + swz / 64; C = (st & 1) * 32 + (swz % 64) / 2; }
__device__ __forceinline__ int perm32(int rho) { const int n = rho >> 4, i = rho & 15; return 8 * (i >> 2) + 4 * n + (i & 3); }

struct Unit { int pm, pn; const char* a; const char* b; };

__device__ __forceinline__ bool order_next(int i, int G, int c, int nM, int nN, int& pm, int& pn) {
    const int nwg = nM * nN; const long L = (long)i * G + c; if (L >= nwg) return false;
    int wgid = (int)L; { const int q = nwg / NXCD, r = nwg % NXCD, xcd = wgid % NXCD, off = wgid / NXCD; wgid = (xcd < r ? xcd * (q + 1) : r * (q + 1) + (xcd - r) * q) + off; }
    const int nig = WGM * nN, gid = wgid / nig, fm = gid * WGM, gsz = (nM - fm) < WGM ? (nM - fm) : WGM;
    pm = fm + ((wgid % nig) % gsz); pn = (wgid % nig) / gsz; return true;
}
struct SchedPlain {
    const char* A; const char* Bt; int nM, nN, G, c; size_t tstep;
    __device__ __forceinline__ void init(const bf16* A_, const bf16* Bt_, int M, int N, int K, int G_, int c_) { A = (const char*)A_; Bt = (const char*)Bt_; nM = M / BM; nN = N / BM; G = G_; c = c_; tstep = (size_t)BM * K * 2; }
    __device__ __forceinline__ bool next(int i, Unit& u) const { if (!order_next(i, G, c, nM, nN, u.pm, u.pn)) return false; u.a = A + (size_t)u.pm * tstep; u.b = Bt + (size_t)u.pn * tstep; return true; }
};
struct SchedMoe {
    const char* A; const char* Bt; const int* srow; const LAS int* tile_off; const LAS int* tile_ev; int nM, nN, G, c; size_t tstepA, tstepB, estepB;
    __device__ __forceinline__ bool next(int i, Unit& u) const { if (!order_next(i, G, c, nM, nN, u.pm, u.pn)) return false;
        const int e = tile_ev[u.pm] & 255; u.a = A + (size_t)u.pm * tstepA; u.b = Bt + (size_t)e * estepB + (size_t)u.pn * tstepB; return true; }
};

template <class Epi, class Sched, bool GATHER>
__device__ __forceinline__ void gemm_phase(LAS unsigned char* lds, const int wid, const int K, const Sched& S, const Epi& E) {
    int lane_ = (int)__builtin_amdgcn_mbcnt_hi(~0u, __builtin_amdgcn_mbcnt_lo(~0u, 0u)); asm volatile("" : "+v"(lane_));
    const int lane = lane_, tid = wid * 64 + lane, wr = wid >> 2, wc = wid & 3, fr = lane & 15, fq = lane >> 4;
    const int nt = K / BK;
    int R0, C0, R1, C1; stage_rc(tid * 16, R0, C0); stage_rc(tid * 16 + 8192, R1, C1);
    unsigned voffB[2]; voffB[0] = (unsigned)(((R0 & ~31) + perm32(R0 & 31)) * K + C0) * 2u; voffB[1] = (unsigned)(((R1 & ~31) + perm32(R1 & 31)) * K + C1) * 2u;
    unsigned cv[4], nv[4];
    const size_t kstep = (size_t)(BK * 2);
    const size_t hstep = (size_t)HALF * K * 2;
    const unsigned ldsw = (unsigned)wid * 1024u;
    const int aoff = lds_byte(wr * 64 + fr, fq * 8), boff = lds_byte(wc * 32 + fr, fq * 8);
#define PG8_SA(b, h) (((b) * 2 + (h)) * HTB)
#define PG8_SB(b, h) ((4 + (b) * 2 + (h)) * HTB)
#define PG8_STG(bufoff, ptr, o0, o1) do { const char* p_ = (const char*)(ptr); asm volatile("" : "+s"(p_));     \
        __builtin_amdgcn_global_load_lds((const unsigned*)(p_ + (o0)), (LAS unsigned*)(lds + (bufoff) + ldsw), 16, 0, 0); \
        __builtin_amdgcn_global_load_lds((const unsigned*)(p_ + (o1)), (LAS unsigned*)(lds + (bufoff) + ldsw + 8192), 16, 0, 0); } while (0)
#define PG8_STGB(bufoff, ptr) PG8_STG(bufoff, ptr, voffB[0], voffB[1])
#define PG8_STGA(bufoff, ptr, h, V) do { if constexpr (GATHER) { PG8_STG(bufoff, ptr, (V)[2 * (h)], (V)[2 * (h) + 1]); } else { PG8_STG(bufoff, (ptr) + (h) * hstep, (V)[0], (V)[1]); } } while (0)
#define PG8_LDA(dst, b, h) do { _Pragma("unroll") for (int m = 0; m < 4; ++m) _Pragma("unroll") for (int k = 0; k < 2; ++k) dst[m][k] = *(const LAS bf16x8*)(lds + PG8_SA(b, h) + aoff + m * 2048 + k * 1024); } while (0)
#define PG8_LDB(dst, b, h) do { _Pragma("unroll") for (int n = 0; n < 2; ++n) _Pragma("unroll") for (int k = 0; k < 2; ++k) dst[n][k] = *(const LAS bf16x8*)(lds + PG8_SB(b, h) + boff + n * 2048 + k * 1024); } while (0)
#define PG8_MMA(ai, bj, At, Bt) do { __builtin_amdgcn_s_setprio(1); _Pragma("unroll") for (int m = 0; m < 4; ++m) _Pragma("unroll") for (int n = 0; n < 2; ++n) _Pragma("unroll") for (int k = 0; k < 2; ++k) \
        acc[ai][bj][m][n] = __builtin_amdgcn_mfma_f32_16x16x32_bf16(Bt[n][k], At[m][k], acc[ai][bj][m][n], 0, 0, 0); __builtin_amdgcn_s_setprio(0); } while (0)
#define PG8_WAIT_V(n) asm volatile("s_waitcnt vmcnt(" #n ")" ::: "memory")
#define PG8_WAIT_L(n) asm volatile("s_waitcnt lgkmcnt(" #n ")" ::: "memory")
#define PG8_BAR __builtin_amdgcn_s_barrier()
#define PG8_SCHED __builtin_amdgcn_sched_barrier(0)
#define PG8_TRIP(A1, A2, B2, V2) do { const char* a3_ = (A2) + kstep; const char* b3_ = (B2) + kstep; \
        PG8_LDB(B0, 0, 0); PG8_LDB(B1, 0, 1); PG8_SCHED; PG8_LDA(At, 0, 0); PG8_STGA(PG8_SA(1, 1), A1, 1, cv); \
        PG8_WAIT_V(8); PG8_WAIT_L(0); PG8_BAR; PG8_MMA(0, 0, At, B0); PG8_MMA(0, 1, At, B1); PG8_BAR; PG8_SCHED; \
        PG8_LDA(At, 0, 1); PG8_STGB(PG8_SB(0, 0), B2); PG8_STGB(PG8_SB(0, 1), (B2) + hstep); PG8_STGA(PG8_SA(0, 0), A2, 0, V2); \
        PG8_WAIT_V(8); PG8_WAIT_L(0); PG8_BAR; PG8_MMA(1, 0, At, B0); PG8_MMA(1, 1, At, B1); PG8_BAR; PG8_SCHED; \
        PG8_LDB(B0, 1, 0); PG8_LDB(B1, 1, 1); PG8_SCHED; PG8_LDA(At, 1, 0); PG8_STGA(PG8_SA(0, 1), A2, 1, V2); \
        PG8_WAIT_V(8); PG8_WAIT_L(0); PG8_BAR; PG8_MMA(0, 0, At, B0); PG8_MMA(0, 1, At, B1); PG8_BAR; PG8_SCHED; \
        PG8_LDA(At, 1, 1); PG8_STGB(PG8_SB(1, 0), b3_); PG8_STGB(PG8_SB(1, 1), b3_ + hstep); PG8_STGA(PG8_SA(1, 0), a3_, 0, V2); \
        PG8_WAIT_V(8); PG8_WAIT_L(0); PG8_BAR; PG8_MMA(1, 0, At, B0); PG8_MMA(1, 1, At, B1); PG8_BAR; PG8_SCHED; } while (0)
#define PG8_OFFS(u, v) do { if constexpr (GATHER) { const int* sr_ = S.srow + S.tile_off[(u).pm]; const int nv_ = S.tile_ev[(u).pm] >> 8; int t0_ = sr_[R0], t1_ = sr_[R1], t2_ = sr_[128 + R0], t3_ = sr_[128 + R1]; \
        t0_ = R0 < nv_ ? (t0_ >> 1) : 0; t1_ = R1 < nv_ ? (t1_ >> 1) : 0; t2_ = 128 + R0 < nv_ ? (t2_ >> 1) : 0; t3_ = 128 + R1 < nv_ ? (t3_ >> 1) : 0;     \
        (v)[0] = (unsigned)(t0_ * K + C0) * 2u; (v)[1] = (unsigned)(t1_ * K + C1) * 2u; (v)[2] = (unsigned)(t2_ * K + C0) * 2u; (v)[3] = (unsigned)(t3_ * K + C1) * 2u; } } while (0)
    Unit cur, nxt; int ui = 0;
    if (!S.next(0, cur)) return;
    f32x4 acc[2][2][4][2];
#pragma unroll
    for (int a = 0; a < 2; ++a)
#pragma unroll
        for (int b = 0; b < 2; ++b)
#pragma unroll
            for (int m = 0; m < 4; ++m)
#pragma unroll
                for (int n = 0; n < 2; ++n) acc[a][b][m][n] = (f32x4){0.f, 0.f, 0.f, 0.f};
    bf16x8 At[4][2], B0[2][2], B1[2][2];
    if constexpr (GATHER) { PG8_OFFS(cur, cv); }
    else { cv[0] = (unsigned)(R0 * K + C0) * 2u; cv[1] = (unsigned)(R1 * K + C1) * 2u; cv[2] = 0u; cv[3] = 0u; }
    const char* cA = cur.a; const char* cB = cur.b;
    PG8_STGB(PG8_SB(0, 0), cB); PG8_STGB(PG8_SB(0, 1), cB + hstep); PG8_STGA(PG8_SA(0, 0), cA, 0, cv); PG8_STGA(PG8_SA(0, 1), cA, 1, cv);
    if (wr == 1) PG8_BAR;
    PG8_WAIT_V(2); PG8_BAR;
    PG8_STGB(PG8_SB(1, 0), cB + kstep); PG8_STGA(PG8_SA(1, 0), cA + kstep, 0, cv); PG8_STGB(PG8_SB(1, 1), cB + hstep + kstep);
    PG8_WAIT_V(6); PG8_BAR;
    for (;;) {
        const bool has_next = S.next(ui + 1, nxt);
        const char* nA = has_next ? nxt.a : cA; const char* nB = has_next ? nxt.b : cB;
        if constexpr (GATHER) { if (has_next) { PG8_OFFS(nxt, nv); } else { nv[0] = cv[0]; nv[1] = cv[1]; nv[2] = cv[2]; nv[3] = cv[3]; } }
        for (int t = 0; t < nt - 2; t += 2) { const char* a1 = cA + (size_t)(t + 1) * kstep; const char* a2 = cA + (size_t)(t + 2) * kstep; const char* b2 = cB + (size_t)(t + 2) * kstep; PG8_TRIP(a1, a2, b2, cv); }
        { const char* a1 = cA + (size_t)(nt - 1) * kstep; if constexpr (GATHER) { PG8_TRIP(a1, nA, nB, nv); } else { PG8_TRIP(a1, nA, nB, cv); } }
        if (wr == 0) PG8_BAR;
        E(acc, cur, wr, wc, fr, fq);
        if (!has_next) break;
#pragma unroll
        for (int a = 0; a < 2; ++a)
#pragma unroll
            for (int b = 0; b < 2; ++b)
#pragma unroll
                for (int m = 0; m < 4; ++m)
#pragma unroll
                    for (int n = 0; n < 2; ++n) acc[a][b][m][n] = (f32x4){0.f, 0.f, 0.f, 0.f};
        cur = nxt; cA = nA; cB = nB; ++ui;
        if constexpr (GATHER) { cv[0] = nv[0]; cv[1] = nv[1]; cv[2] = nv[2]; cv[3] = nv[3]; }
        if (wr == 1) PG8_BAR;
    }
    PG8_WAIT_V(0);
    PG8_BAR;
#undef PG8_SA
#undef PG8_SB
#undef PG8_STG
#undef PG8_STGB
#undef PG8_STGA
#undef PG8_LDA
#undef PG8_LDB
#undef PG8_MMA
#undef PG8_WAIT_V
#undef PG8_WAIT_L
#undef PG8_BAR
#undef PG8_SCHED
#undef PG8_TRIP
#undef PG8_OFFS
}

__device__ __forceinline__ u32x4 pack8(const f32x4 v0, const f32x4 v1) { u32x4 w; w.x = cvt_pk_bf16(v0[0], v0[1]); w.y = cvt_pk_bf16(v0[2], v0[3]); w.z = cvt_pk_bf16(v1[0], v1[1]); w.w = cvt_pk_bf16(v1[2], v1[3]); return w; }
struct EpiBf16 {
    bf16* O; int ldc;
    __device__ __forceinline__ void operator()(const f32x4 (&acc)[2][2][4][2], const Unit& u, int wr, int wc, int fr, int fq) const {
        const int row0 = u.pm * BM + wr * 64 + fr, col0 = u.pn * BM + wc * 32 + 8 * fq;
#pragma unroll
        for (int ai = 0; ai < 2; ++ai)
#pragma unroll
            for (int m = 0; m < 4; ++m) { bf16* rowp = O + (size_t)(row0 + ai * HALF + m * 16) * ldc + col0;
#pragma unroll
                for (int bj = 0; bj < 2; ++bj) *(u32x4*)(rowp + bj * HALF) = pack8(acc[ai][bj][m][0], acc[ai][bj][m][1]); }
    }
};
struct EpiConv1 {
    bf16* BG; bf16* Z;
    __device__ __forceinline__ void operator()(const f32x4 (&acc)[2][2][4][2], const Unit& u, int wr, int wc, int fr, int fq) const {
        const int row0 = u.pm * BM + wr * 64 + fr;
        if (u.pn < 8) {
            const int col0 = u.pn * BM + wc * 32 + 8 * fq;
#pragma unroll
            for (int ai = 0; ai < 2; ++ai)
#pragma unroll
                for (int m = 0; m < 4; ++m) { bf16* rowp = BG + (size_t)(row0 + ai * HALF + m * 16) * D + col0;
#pragma unroll
                    for (int bj = 0; bj < 2; ++bj) *(u32x4*)(rowp + bj * HALF) = pack8(acc[ai][bj][m][0], acc[ai][bj][m][1]); }
        } else {
            const int col0 = (u.pn - 8) * HALF + wc * 32 + 8 * fq;
#pragma unroll
            for (int ai = 0; ai < 2; ++ai)
#pragma unroll
                for (int m = 0; m < 4; ++m) { bf16* rowp = Z + (size_t)(row0 + ai * HALF + m * 16) * D + col0;
                    *(u32x4*)rowp = pack8(acc[ai][0][m][0] * acc[ai][1][m][0], acc[ai][0][m][1] * acc[ai][1][m][1]); }
        }
    }
};
struct EpiMlIn {
    bf16* O; float* gates;
    __device__ __forceinline__ void operator()(const f32x4 (&acc)[2][2][4][2], const Unit& u, int wr, int wc, int fr, int fq) const {
        const int row0 = u.pm * BM + wr * 64 + fr;
        if (u.pn < 24) {
            const int col0 = u.pn * BM + wc * 32 + 8 * fq;
#pragma unroll
            for (int ai = 0; ai < 2; ++ai)
#pragma unroll
                for (int m = 0; m < 4; ++m) { bf16* rowp = O + (size_t)(row0 + ai * HALF + m * 16) * MLW + col0;
#pragma unroll
                    for (int bj = 0; bj < 2; ++bj) *(u32x4*)(rowp + bj * HALF) = pack8(acc[ai][bj][m][0], acc[ai][bj][m][1]); }
        } else if (wc == 0) {
#pragma unroll
            for (int ai = 0; ai < 2; ++ai)
#pragma unroll
                for (int m = 0; m < 4; ++m) { float* rowp = gates + (size_t)(row0 + ai * HALF + m * 16) * 32 + 8 * fq;
                    *(f32x4*)rowp = acc[ai][0][m][0]; *(f32x4*)(rowp + 4) = acc[ai][0][m][1]; }
        }
    }
};
__device__ __forceinline__ float silu_f(float g) { return g * __builtin_amdgcn_rcpf(1.0f + __expf(-g)); }
struct EpiMoe1 {
    bf16* H;
    __device__ __forceinline__ void operator()(const f32x4 (&acc)[2][2][4][2], const Unit& u, int wr, int wc, int fr, int fq) const {
        const int row0 = u.pm * BM + wr * 64 + fr, col0 = u.pn * HALF + wc * 32 + 8 * fq;
#pragma unroll
        for (int ai = 0; ai < 2; ++ai)
#pragma unroll
            for (int m = 0; m < 4; ++m) { bf16* rowp = H + (size_t)(row0 + ai * HALF + m * 16) * DE + col0; f32x4 h0, h1;
#pragma unroll
                for (int j = 0; j < 4; ++j) { h0[j] = silu_f(acc[ai][0][m][0][j]) * acc[ai][1][m][0][j]; h1[j] = silu_f(acc[ai][0][m][1][j]) * acc[ai][1][m][1][j]; }
                *(u32x4*)rowp = pack8(h0, h1); }
    }
};
struct EpiMoe2 {
    bf16* EX; const int* srow; const float* swt; const LAS int* tile_off; const LAS int* tile_ev;
    __device__ __forceinline__ void operator()(const f32x4 (&acc)[2][2][4][2], const Unit& u, int wr, int wc, int fr, int fq) const {
        const int rl0 = wr * 64 + fr, col0 = u.pn * BM + wc * 32 + 8 * fq, off = tile_off[u.pm], nv = tile_ev[u.pm] >> 8;
#pragma unroll
        for (int ai = 0; ai < 2; ++ai)
#pragma unroll
            for (int m = 0; m < 4; ++m) { const int rl = rl0 + ai * HALF + m * 16;
                if (rl < nv) { const int ent = srow[off + rl]; const float w = swt[off + rl]; bf16* rowp = EX + ((size_t)(ent & 1) * NTOK + (size_t)(ent >> 1)) * D + col0;
#pragma unroll
                    for (int bj = 0; bj < 2; ++bj) *(u32x4*)(rowp + bj * HALF) = pack8(acc[ai][bj][m][0] * w, acc[ai][bj][m][1] * w); } }
    }
};
}

struct Args { const float* in[21]; float* out; unsigned char* ws; int ph_lo, ph_hi; };
struct Frame {
    LAS unsigned char* lds;
    int G, bid, wave0;
    const float* in[21]; float* out; unsigned char* ws;
};
enum { I_X = 0, I_C, I_CTX, I_CCTX, I_WADA, I_BADA, I_LNG, I_LNB, I_CWIN, I_CW, I_CWOUT, I_MWIN, I_MWG, I_MBG, I_MNG, I_MWOUT, I_RW, I_RB, I_EWG, I_EWU, I_EWD };

#define PHASE_IDS() int lane_ = (int)__builtin_amdgcn_mbcnt_hi(~0u, __builtin_amdgcn_mbcnt_lo(~0u, 0u)); asm volatile("" : "+v"(lane_)); const int lane = lane_; const int wave = F.wave0; const int tid = wave * 64 + lane; (void)tid
__device__ __forceinline__ int mod_row(int trow) { return trow < NLAT ? (trow >> 12) : 4; }
__device__ __forceinline__ const float* mod_vec(const Frame& F, int layer, int r, int j) { return (const float*)(F.ws + WS_MOD) + ((size_t)(layer * 5 + r) * 6 + j) * D; }

__device__ __forceinline__ void cvt_tile(const float* src, size_t src_pitch, bf16* dst, size_t dst_pitch, float scale, LAS float* scr, int lane) {
#pragma unroll 8
    for (int i = 0; i < 64; ++i) scr[i * 65 + lane] = src[(size_t)i * src_pitch + lane];
    LDS_WAIT(); asm volatile("" ::: "memory");
    const int c = lane & 7;
#pragma unroll
    for (int j = 0; j < 8; ++j) { const int n = (lane >> 3) + 8 * j; const LAS float* s = scr + (8 * c) * 65 + n;
        u32x4 o; o.x = cvt_pk_bf16(s[0] * scale, s[65] * scale); o.y = cvt_pk_bf16(s[2 * 65] * scale, s[3 * 65] * scale); o.z = cvt_pk_bf16(s[4 * 65] * scale, s[5 * 65] * scale); o.w = cvt_pk_bf16(s[6 * 65] * scale, s[7 * 65] * scale);
        *(u32x4*)(dst + (size_t)n * dst_pitch + 8 * c) = o; }
    LDS_WAIT(); asm volatile("" ::: "memory");
}
__device__ __forceinline__ void p0_prologue(Frame& F) {
    PHASE_IDS();
    LAS float* sc = (LAS float*)F.lds;
    LAS float* red = (LAS float*)(F.lds + 40960);
    for (int idx = tid; idx < 5 * D; idx += NTHR) { const int r = idx / D, k = idx % D; const float cv = r < 4 ? F.in[I_C][r * D + k] : F.in[I_CCTX][k]; sc[idx] = cv / (1.0f + expf(-cv)); }
    __syncthreads();
    float* mod = (float*)(F.ws + WS_MOD);
    for (int it = F.bid; it < 768; it += F.G) {
        const int l = it / 384, n0 = (it % 384) * 32, col = lane & 31, kp = lane >> 5, kbase = wave * 256;
        const float* W = F.in[I_WADA] + (size_t)l * D * 12288 + n0 + col;
        float acc[5] = {0.f, 0.f, 0.f, 0.f, 0.f};
        for (int kk = 0; kk < 128; kk += 8) {
            float wv[8];
#pragma unroll
            for (int u = 0; u < 8; ++u) wv[u] = W[(size_t)(kbase + 2 * (kk + u) + kp) * 12288];
#pragma unroll
            for (int u = 0; u < 8; ++u) { const int k = kbase + 2 * (kk + u) + kp;
#pragma unroll
                for (int r = 0; r < 5; ++r) acc[r] += sc[r * D + k] * wv[u]; }
        }
#pragma unroll
        for (int r = 0; r < 5; ++r) { acc[r] += __shfl_xor(acc[r], 32); if (lane < 32) red[(wave * 5 + r) * 32 + lane] = acc[r]; }
        __syncthreads();
        if (tid < 160) { const int r = tid >> 5, cc = tid & 31; float s = 0.f;
#pragma unroll
            for (int w = 0; w < 8; ++w) s += red[(w * 5 + r) * 32 + cc];
            mod[(size_t)(l * 5 + r) * 12288 + n0 + cc] = s + F.in[I_BADA][l * 12288 + n0 + cc]; }
        __syncthreads();
    }
    LAS float* scr = (LAS float*)(F.lds + wave * 16640);
    const int gw = F.bid * NWAVES + wave, NGW = F.G * NWAVES;
    constexpr int I1 = 3072, I2 = 1024, I3 = 3072, I4 = 1024, I5 = 16384, I6 = 16384, I7 = 16384;
    constexpr int NIT = I1 + I2 + I3 + I4 + I5 + I6 + I7;
    const float QS = 0.08838834764831845f;
    for (int it = gw; it < NIT; it += NGW) {
        int r = it;
        if (r < I1) { const int kb = r / 96, n0 = (r % 96) * 64; int dr; if (n0 < 2048) dr = n0; else if (n0 < 4096) { const int q = n0 - 2048; dr = 2048 + (q >> 7) * 256 + (q & 127); } else { const int q = n0 - 4096; dr = 2048 + (q >> 7) * 256 + 128 + (q & 127); }
            cvt_tile(F.in[I_CWIN] + (size_t)kb * 64 * 6144 + n0, 6144, (bf16*)(F.ws + WS_WT_CIN) + (size_t)dr * D + kb * 64, D, 1.f, scr, lane); continue; } r -= I1;
        if (r < I2) { const int kb = r / 32, n0 = (r % 32) * 64;
            cvt_tile(F.in[I_CWOUT] + (size_t)kb * 64 * D + n0, D, (bf16*)(F.ws + WS_WT_COUT) + (size_t)n0 * D + kb * 64, D, 1.f, scr, lane); continue; } r -= I2;
        if (r < I3) { const int kb = r / 96, n0 = (r % 96) * 64;
            cvt_tile(F.in[I_MWIN] + (size_t)kb * 64 * MLW + n0, MLW, (bf16*)(F.ws + WS_WT_MIN) + (size_t)n0 * D + kb * 64, D, n0 < 1024 ? QS : 1.f, scr, lane); continue; } r -= I3;
        if (r < I4) { const int kb = r / 32, n0 = (r % 32) * 64;
            cvt_tile(F.in[I_MWOUT] + (size_t)kb * 64 * D + n0, D, (bf16*)(F.ws + WS_WT_MOUT) + (size_t)n0 * D + kb * 64, D, 1.f, scr, lane); continue; } r -= I4;
        if (r < I5 + I6) { const int up = r >= I5; if (up) r -= I5; const int le = r / 512, q = r % 512, kb = q / 16, n0 = (q % 16) * 64;
            const float* src = (up ? F.in[I_EWU] : F.in[I_EWG]) + (size_t)le * D * DE + (size_t)kb * 64 * DE + n0;
            const int dr = (n0 >> 7) * 256 + (up ? 128 : 0) + (n0 & 127);
            cvt_tile(src, DE, (bf16*)(F.ws + WS_WT_E1) + (size_t)le * D * D + (size_t)dr * D + kb * 64, D, 1.f, scr, lane); continue; } r -= I5 + I6;
        { const int le = r / 512, q = r % 512, kb = q / 32, n0 = (q % 32) * 64;
            cvt_tile(F.in[I_EWD] + (size_t)le * DE * D + (size_t)kb * 64 * D + n0, D, (bf16*)(F.ws + WS_WT_E2) + (size_t)le * D * DE + (size_t)n0 * DE + kb * 64, DE, 1.f, scr, lane); }
    }
    { bf16* wt = (bf16*)(F.ws + WS_WT_MIN) + (size_t)MLW * D; const float* wg = F.in[I_MWG];
      for (int idx = F.bid * NTHR + tid; idx < 256 * D; idx += F.G * NTHR) { const int n = idx / D, k = idx % D; const float v = n < 32 ? wg[k * 32 + n] : 0.f; wt[idx] = (bf16)(cvt_pk_bf16(v, 0.f) & 0xffffu); } }
}

#define SCHED_FENCE() __builtin_amdgcn_sched_barrier(0)
__device__ __forceinline__ void p1_modulate(Frame& F) {
    PHASE_IDS();
    const int gw = F.bid * NWAVES + wave;
    bf16* HA = (bf16*)(F.ws + WS_HA);
    f32x4 a[8], b[8], x[8], xn[8];
    { const int r = (8 * gw) >> 12; const float* sh = mod_vec(F, 0, r, 0); const float* scv = mod_vec(F, 0, r, 1);
#pragma unroll
      for (int j = 0; j < 8; ++j) { const int c = 256 * j + 4 * lane; a[j] = *(const f32x4*)(scv + c) + 1.0f; b[j] = *(const f32x4*)(sh + c); xn[j] = *(const f32x4*)(F.in[I_X] + (size_t)(8 * gw) * D + c); } }
    for (int i = 0; i < 8; ++i) { const int row = 8 * gw + i;
#pragma unroll
        for (int j = 0; j < 8; ++j) x[j] = xn[j];
        if (i < 7) {
#pragma unroll
            for (int j = 0; j < 8; ++j) xn[j] = *(const f32x4*)(F.in[I_X] + (size_t)(row + 1) * D + 256 * j + 4 * lane); }
        SCHED_FENCE();
#pragma unroll
        for (int j = 0; j < 8; ++j) { const f32x4 h = x[j] * a[j] + b[j]; u32x2 o; o.x = cvt_pk_bf16(h[0], h[1]); o.y = cvt_pk_bf16(h[2], h[3]); *(u32x2*)(HA + (size_t)row * D + 256 * j + 4 * lane) = o; }
    }
    if (gw < NCTX) { const float* sh = mod_vec(F, 0, 4, 0); const float* scv = mod_vec(F, 0, 4, 1);
#pragma unroll
        for (int j = 0; j < 8; ++j) { const int c = 256 * j + 4 * lane; a[j] = *(const f32x4*)(scv + c) + 1.0f; b[j] = *(const f32x4*)(sh + c); x[j] = *(const f32x4*)(F.in[I_CTX] + (size_t)gw * D + c); }
        SCHED_FENCE();
#pragma unroll
        for (int j = 0; j < 8; ++j) { const f32x4 h = x[j] * a[j] + b[j]; u32x2 o; o.x = cvt_pk_bf16(h[0], h[1]); o.y = cvt_pk_bf16(h[2], h[3]); *(u32x2*)(HA + (size_t)(NLAT + gw) * D + 256 * j + 4 * lane) = o; } }
}

__device__ __forceinline__ void p3_conv(Frame& F) {
    PHASE_IDS();
    const int gw = F.bid * NWAVES + wave, NGW = F.G * NWAVES;
    const bf16* BG = (const bf16*)(F.ws + WS_RB); const bf16* Z = (const bf16*)(F.ws + WS_RC); bf16* U = (bf16*)(F.ws + WS_HA);
    const float* cw = F.in[I_CW];
    f32x4 wt[4][3][2];
#pragma unroll
    for (int j = 0; j < 4; ++j)
#pragma unroll
        for (int t = 0; t < 3; ++t) { wt[j][t][0] = *(const f32x4*)(cw + t * D + 512 * j + 8 * lane); wt[j][t][1] = *(const f32x4*)(cw + t * D + 512 * j + 8 * lane + 4); }
    for (int row = gw; row < NTOK; row += NGW) {
        u32x4 zc[4], bg[4], zp[4], zn[4];
        int dpa, dna, dpb, dnb; bool vpa, vna, vpb, vnb;
        if (row < NLAT) { const int s = row & (SEQ - 1), gc = s & 63, gr = s >> 6; vpa = gc > 0; vna = gc < 63; dpa = -1; dna = 1; vpb = gr > 0; vnb = gr < 63; dpb = -64; dnb = 64; }
        else { const int t = (row - NLAT) & (CTXL - 1); vpa = vpb = t > 0; vna = vnb = t < CTXL - 1; dpa = dpb = -1; dna = dnb = 1; }
#pragma unroll
        for (int j = 0; j < 4; ++j) { const int c = 512 * j + 8 * lane; const bool vp = j < 2 ? vpa : vpb, vn = j < 2 ? vna : vnb; const int dp = j < 2 ? dpa : dpb, dn = j < 2 ? dna : dnb;
            zc[j] = *(const u32x4*)(Z + (size_t)row * D + c); bg[j] = *(const u32x4*)(BG + (size_t)row * D + c);
            zp[j] = *(const u32x4*)(Z + (size_t)(vp ? row + dp : row) * D + c); zn[j] = *(const u32x4*)(Z + (size_t)(vn ? row + dn : row) * D + c);
            if (!vp) zp[j] = (u32x4){0u, 0u, 0u, 0u}; if (!vn) zn[j] = (u32x4){0u, 0u, 0u, 0u}; }
        SCHED_FENCE();
#pragma unroll
        for (int j = 0; j < 4; ++j) { float o[8];
#pragma unroll
            for (int q = 0; q < 4; ++q) {
                const float w0l = wt[j][0][q >> 1][2 * (q & 1)], w0h = wt[j][0][q >> 1][2 * (q & 1) + 1], w1l = wt[j][1][q >> 1][2 * (q & 1)], w1h = wt[j][1][q >> 1][2 * (q & 1) + 1], w2l = wt[j][2][q >> 1][2 * (q & 1)], w2h = wt[j][2][q >> 1][2 * (q & 1) + 1];
                o[2 * q] = bf_lo(bg[j][q]) * (w0l * bf_lo(zp[j][q]) + w1l * bf_lo(zc[j][q]) + w2l * bf_lo(zn[j][q]));
                o[2 * q + 1] = bf_hi(bg[j][q]) * (w0h * bf_hi(zp[j][q]) + w1h * bf_hi(zc[j][q]) + w2h * bf_hi(zn[j][q])); }
            u32x4 w; w.x = cvt_pk_bf16(o[0], o[1]); w.y = cvt_pk_bf16(o[2], o[3]); w.z = cvt_pk_bf16(o[4], o[5]); w.w = cvt_pk_bf16(o[6], o[7]);
            *(u32x4*)(U + (size_t)row * D + 512 * j + 8 * lane) = w; }
    }
}

__device__ __forceinline__ void lnB_phase(Frame& F, int layer) {
    PHASE_IDS();
    const int nrows = layer == 0 ? 68 : 64;
    const float* lg = F.in[I_LNG] + (layer * 2 + 1) * D; const float* lb = F.in[I_LNB] + (layer * 2 + 1) * D;
    const bf16* EX = (const bf16*)(F.ws + WS_REX);
#define LNB_ROW(li) ((li) < 64 ? F.bid * 64 + (li) : NLAT + F.bid * 4 + ((li) - 64))
#define LNB_LOAD(li, X, E0, E1) do { const bf16* xp_ = (const bf16*)(F.ws + WS_XB) + (size_t)LNB_ROW(li) * D; const bf16* ep_ = EX + (size_t)LNB_ROW(li) * D; \
        _Pragma("unroll") for (int j = 0; j < 8; ++j) { X[j] = *(const u32x2*)(xp_ + 256 * j + 4 * lane); E0[j] = *(const u32x2*)(ep_ + 256 * j + 4 * lane); E1[j] = *(const u32x2*)(ep_ + (size_t)NTOK * D + 256 * j + 4 * lane); } } while (0)
    u32x2 xn_[8], e0_[8], e1_[8];
    if (wave < nrows) LNB_LOAD(wave, xn_, e0_, e1_);
    for (int li = wave; li < nrows; li += NWAVES) {
        const int row = LNB_ROW(li); const int mr = mod_row(row);
        const float* gv = mod_vec(F, layer, mr, 5);
        f32x4 v[8]; float s = 0.f;
#pragma unroll
        for (int j = 0; j < 8; ++j) { const f32x4 g = *(const f32x4*)(gv + 256 * j + 4 * lane);
            const f32x4 m = (f32x4){bf_lo(e0_[j].x) + bf_lo(e1_[j].x), bf_hi(e0_[j].x) + bf_hi(e1_[j].x), bf_lo(e0_[j].y) + bf_lo(e1_[j].y), bf_hi(e0_[j].y) + bf_hi(e1_[j].y)};
            const f32x4 x = (f32x4){bf_lo(xn_[j].x), bf_hi(xn_[j].x), bf_lo(xn_[j].y), bf_hi(xn_[j].y)};
            v[j] = x * ALPHA + g * m; s += (v[j][0] + v[j][1]) + (v[j][2] + v[j][3]); }
        if (li + NWAVES < nrows) LNB_LOAD(li + NWAVES, xn_, e0_, e1_);
        f32x4 L[8], B[8];
#pragma unroll
        for (int j = 0; j < 8; ++j) { const int c = 256 * j + 4 * lane; L[j] = *(const f32x4*)(lg + c); B[j] = *(const f32x4*)(lb + c); }
        SCHED_FENCE();
        const float mean = wave_sum(s) * (1.f / D); float s2 = 0.f;
#pragma unroll
        for (int j = 0; j < 8; ++j) { v[j] = v[j] - mean; s2 += (v[j][0] * v[j][0] + v[j][1] * v[j][1]) + (v[j][2] * v[j][2] + v[j][3] * v[j][3]); }
        const float rstd = 1.0f / sqrtf(wave_sum(s2) * (1.f / D) + LN_EPS);
        if (layer == 0) {
            bf16* xb = (bf16*)(F.ws + WS_XB) + (size_t)row * D;
#pragma unroll
            for (int j = 0; j < 8; ++j) { const int c = 256 * j + 4 * lane; v[j] = v[j] * rstd * L[j] + B[j]; u32x2 o; o.x = cvt_pk_bf16(v[j][0], v[j][1]); o.y = cvt_pk_bf16(v[j][2], v[j][3]); *(u32x2*)(xb + c) = o; }
            const float* sh = mod_vec(F, 1, mr, 0); const float* scv = mod_vec(F, 1, mr, 1);
#pragma unroll
            for (int j = 0; j < 8; ++j) { const int c = 256 * j + 4 * lane; L[j] = *(const f32x4*)(scv + c); B[j] = *(const f32x4*)(sh + c); }
            SCHED_FENCE();
            bf16* HA = (bf16*)(F.ws + WS_HA) + (size_t)row * D;
#pragma unroll
            for (int j = 0; j < 8; ++j) { const int c = 256 * j + 4 * lane; const f32x4 h = v[j] * (L[j] + 1.0f) + B[j]; u32x2 o; o.x = cvt_pk_bf16(h[0], h[1]); o.y = cvt_pk_bf16(h[2], h[3]); *(u32x2*)(HA + c) = o; }
        } else {
            float* xout = F.out + (size_t)row * D;
#pragma unroll
            for (int j = 0; j < 8; ++j) { const int c = 256 * j + 4 * lane; v[j] = v[j] * rstd * L[j] + B[j]; *(f32x4*)(xout + c) = v[j]; }
        }
    }
#undef LNB_ROW
#undef LNB_LOAD
}

constexpr int LDS_LOGITS = RING_BYTES;
__device__ __forceinline__ void lnA_phase(Frame& F, int layer) {
    PHASE_IDS();
    LAS float* RwL = (LAS float*)F.lds;
    LAS float* LG = (LAS float*)(F.lds + LDS_LOGITS);
    LAS int* cnt = (LAS int*)(F.lds + LDS_MISC + 64);
    for (int idx = tid; idx < D * 4; idx += NTHR) { const int c = idx >> 2, e4 = (idx & 3) * 4; const f32x4 w = *(const f32x4*)(F.in[I_RW] + c * 16 + e4);
        RwL[(e4 + 0) * D + c] = w[0]; RwL[(e4 + 1) * D + c] = w[1]; RwL[(e4 + 2) * D + c] = w[2]; RwL[(e4 + 3) * D + c] = w[3]; }
    if (tid < 32) cnt[tid] = 0;
    __syncthreads();
    const int nrows = layer == 0 ? 68 : 64;
    const float* lg = F.in[I_LNG] + (layer * 2) * D; const float* lb = F.in[I_LNB] + (layer * 2) * D;
    const bf16* MX = (const bf16*)(F.ws + WS_RB);
#define LNA_ROW(li) ((li) < 64 ? F.bid * 64 + (li) : NLAT + F.bid * 4 + ((li) - 64))
#define LNA_XIN(li) ((li) < 64 ? F.in[I_X] + (size_t)(F.bid * 64 + (li)) * D : F.in[I_CTX] + (size_t)(F.bid * 4 + ((li) - 64)) * D)
#define LNA_LOAD(li, X, XH, M) do { const bf16* mp_ = MX + (size_t)LNA_ROW(li) * D; \
        if (layer == 0) { const float* xp_ = LNA_XIN(li); _Pragma("unroll") for (int j = 0; j < 8; ++j) X[j] = *(const f32x4*)(xp_ + 256 * j + 4 * lane); } \
        else { const bf16* xp_ = (const bf16*)(F.ws + WS_XB) + (size_t)LNA_ROW(li) * D; _Pragma("unroll") for (int j = 0; j < 8; ++j) XH[j] = *(const u32x2*)(xp_ + 256 * j + 4 * lane); } \
        _Pragma("unroll") for (int j = 0; j < 8; ++j) M[j] = *(const u32x2*)(mp_ + 256 * j + 4 * lane); } while (0)
    f32x4 xn_[8]; u32x2 xh_[8], mn_[8];
    if (wave < nrows) LNA_LOAD(wave, xn_, xh_, mn_);
    for (int li = wave; li < nrows; li += NWAVES) {
        const int row = LNA_ROW(li); const int mr = mod_row(row);
        bf16* xout = (bf16*)(F.ws + WS_XB) + (size_t)row * D;
        const float* gv = mod_vec(F, layer, mr, 2); const float* sh = mod_vec(F, layer, mr, 3); const float* scv = mod_vec(F, layer, mr, 4);
        f32x4 v[8]; float s = 0.f;
#pragma unroll
        for (int j = 0; j < 8; ++j) { const f32x4 g = *(const f32x4*)(gv + 256 * j + 4 * lane); const f32x4 m = (f32x4){bf_lo(mn_[j].x), bf_hi(mn_[j].x), bf_lo(mn_[j].y), bf_hi(mn_[j].y)};
            const f32x4 x = layer == 0 ? xn_[j] : (f32x4){bf_lo(xh_[j].x), bf_hi(xh_[j].x), bf_lo(xh_[j].y), bf_hi(xh_[j].y)};
            v[j] = x * ALPHA + g * m; s += (v[j][0] + v[j][1]) + (v[j][2] + v[j][3]); }
        if (li + NWAVES < nrows) LNA_LOAD(li + NWAVES, xn_, xh_, mn_);
        f32x4 L[8], B[8], S[8], H[8];
#pragma unroll
        for (int j = 0; j < 8; ++j) { const int c = 256 * j + 4 * lane; L[j] = *(const f32x4*)(lg + c); B[j] = *(const f32x4*)(lb + c); S[j] = *(const f32x4*)(scv + c); H[j] = *(const f32x4*)(sh + c); }
        SCHED_FENCE();
        const float mean = wave_sum(s) * (1.f / D); float s2 = 0.f;
#pragma unroll
        for (int j = 0; j < 8; ++j) { v[j] = v[j] - mean; s2 += (v[j][0] * v[j][0] + v[j][1] * v[j][1]) + (v[j][2] * v[j][2] + v[j][3] * v[j][3]); }
        const float rstd = 1.0f / sqrtf(wave_sum(s2) * (1.f / D) + LN_EPS);
        bf16* HA = (bf16*)(F.ws + WS_HA) + (size_t)row * D;
#pragma unroll
        for (int j = 0; j < 8; ++j) { const int c = 256 * j + 4 * lane; v[j] = v[j] * rstd * L[j] + B[j]; { u32x2 ox; ox.x = cvt_pk_bf16(v[j][0], v[j][1]); ox.y = cvt_pk_bf16(v[j][2], v[j][3]); *(u32x2*)(xout + c) = ox; }
            v[j] = v[j] * (S[j] + 1.0f) + H[j];
            u32x2 o; o.x = cvt_pk_bf16(v[j][0], v[j][1]); o.y = cvt_pk_bf16(v[j][2], v[j][3]); *(u32x2*)(HA + c) = o; }
        float p[16]; f32x4 wA[8], wB[8];
#pragma unroll
        for (int j = 0; j < 8; ++j) wA[j] = *(const LAS f32x4*)(RwL + 256 * j + 4 * lane);
#pragma unroll
        for (int e = 0; e < 16; ++e) {
            if (e + 1 < 16) {
#pragma unroll
                for (int j = 0; j < 8; ++j) { const f32x4 t = *(const LAS f32x4*)(RwL + (e + 1) * D + 256 * j + 4 * lane); if (e & 1) wA[j] = t; else wB[j] = t; } }
            SCHED_FENCE();
            f32x4 a4 = (f32x4){0.f, 0.f, 0.f, 0.f};
#pragma unroll
            for (int j = 0; j < 8; ++j) a4 += v[j] * ((e & 1) ? wB[j] : wA[j]);
            p[e] = (a4[0] + a4[1]) + (a4[2] + a4[3]);
            SCHED_FENCE();
        }
        float q8[8], q4[4], q2[2], q1;
        { const bool hi = (lane & 32) != 0;
#pragma unroll
          for (int i = 0; i < 8; ++i) { const float keep = hi ? p[8 + i] : p[i], give = hi ? p[i] : p[8 + i]; q8[i] = keep + __shfl_xor(give, 32); } }
        { const bool hi = (lane & 16) != 0;
#pragma unroll
          for (int i = 0; i < 4; ++i) { const float keep = hi ? q8[4 + i] : q8[i], give = hi ? q8[i] : q8[4 + i]; q4[i] = keep + __shfl_xor(give, 16); } }
        { const bool hi = (lane & 8) != 0;
#pragma unroll
          for (int i = 0; i < 2; ++i) { const float keep = hi ? q4[2 + i] : q4[i], give = hi ? q4[i] : q4[2 + i]; q2[i] = keep + __shfl_xor(give, 8); } }
        { const bool hi = (lane & 4) != 0; const float keep = hi ? q2[1] : q2[0], give = hi ? q2[0] : q2[1]; q1 = keep + __shfl_xor(give, 4); }
        q1 += __shfl_xor(q1, 1); q1 += __shfl_xor(q1, 2);
        if ((lane & 3) == 0) LG[li * 16 + (lane >> 2)] = q1;
    }
    __syncthreads();
    int se0 = 0, se1 = 0, lr0 = 0, lr1 = 0; float sw0 = 0.f, sw1 = 0.f;
    if (tid < nrows) {
        float sg[16], sel[16];
#pragma unroll
        for (int e4 = 0; e4 < 4; ++e4) { const f32x4 l4 = *(const LAS f32x4*)(LG + tid * 16 + 4 * e4); const f32x4 rb4 = *(const f32x4*)(F.in[I_RB] + 4 * e4);
#pragma unroll
            for (int i = 0; i < 4; ++i) { sg[4 * e4 + i] = 1.0f / (1.0f + expf(-l4[i])); sel[4 * e4 + i] = sg[4 * e4 + i] + rb4[i]; } }
        float grp[4];
#pragma unroll
        for (int g = 0; g < 4; ++g) { const float a = sel[4 * g], b = sel[4 * g + 1], c = sel[4 * g + 2], d = sel[4 * g + 3];
            const float h1 = fmaxf(a, b), l1 = fminf(a, b), h2 = fmaxf(c, d), l2 = fminf(c, d); grp[g] = fmaxf(h1, h2) + fmaxf(fminf(h1, h2), fmaxf(l1, l2)); }
        int gb = 0; float best = grp[0];
#pragma unroll
        for (int g = 1; g < 4; ++g) if (grp[g] > best) { best = grp[g]; gb = g; }
        float cs[4], cg[4];
#pragma unroll
        for (int i = 0; i < 4; ++i) { cs[i] = gb == 0 ? sel[i] : gb == 1 ? sel[4 + i] : gb == 2 ? sel[8 + i] : sel[12 + i]; cg[i] = gb == 0 ? sg[i] : gb == 1 ? sg[4 + i] : gb == 2 ? sg[8 + i] : sg[12 + i]; }
        int i0 = 0; float b0 = cs[0];
#pragma unroll
        for (int i = 1; i < 4; ++i) if (cs[i] > b0) { b0 = cs[i]; i0 = i; }
        int i1 = -1; float b1 = 0.f;
#pragma unroll
        for (int i = 0; i < 4; ++i) if (i != i0 && (i1 < 0 || cs[i] > b1)) { b1 = cs[i]; i1 = i; }
        const float s0 = i0 == 0 ? cg[0] : i0 == 1 ? cg[1] : i0 == 2 ? cg[2] : cg[3], s1 = i1 == 0 ? cg[0] : i1 == 1 ? cg[1] : i1 == 2 ? cg[2] : cg[3];
        const float den = s0 + s1; const int e0 = 4 * gb + i0, e1 = 4 * gb + i1;
        se0 = e0; se1 = e1; sw0 = s0 / den; sw1 = s1 / den;
        lr0 = __hip_atomic_fetch_add(cnt + e0, 1, __ATOMIC_RELAXED, __HIP_MEMORY_SCOPE_WORKGROUP); lr1 = __hip_atomic_fetch_add(cnt + e1, 1, __ATOMIC_RELAXED, __HIP_MEMORY_SCOPE_WORKGROUP);
    }
    __syncthreads();
    if (tid < 16) { const int n = cnt[tid]; cnt[16 + tid] = n ? (int)__hip_atomic_fetch_add((unsigned*)(F.ws + WS_CTL) + CW_GCNT + (layer * 16 + tid) * 64, (unsigned)n, __ATOMIC_RELAXED, __HIP_MEMORY_SCOPE_AGENT) : 0; }
    __syncthreads();
    if (tid < nrows) { const int row = LNA_ROW(tid); int* srow = (int*)(F.ws + WS_SROW); float* swt = (float*)(F.ws + WS_SWT);
        const int p0 = se0 * CAP + cnt[16 + se0] + lr0, p1 = se1 * CAP + cnt[16 + se1] + lr1;
        srow[p0] = row * 2; swt[p0] = sw0; srow[p1] = row * 2 + 1; swt[p1] = sw1; }
#undef LNA_ROW
#undef LNA_XIN
#undef LNA_LOAD
}

__device__ __forceinline__ void moe_gemm1(Frame& F, int layer) {
    PHASE_IDS();
    LAS int* toff = (LAS int*)(F.lds + LDS_TILEE); LAS int* tev = (LAS int*)(F.lds + LDS_TILEV); LAS int* tT = (LAS int*)(F.lds + LDS_MISC + 192);
    if (tid == 0) { int T_ = 0; const unsigned* gc = (const unsigned*)(F.ws + WS_CTL) + CW_GCNT + layer * 16 * 64;
        for (int e = 0; e < NE; ++e) { const int n = (int)gc[e * 64]; for (int m0 = 0; m0 < n; m0 += 256) { toff[T_] = e * CAP + m0; tev[T_] = e | ((n - m0 < 256 ? n - m0 : 256) << 8); ++T_; } }
        *tT = T_; }
    __syncthreads();
    const int T = *tT;
    pg8::SchedMoe S; S.A = (const char*)(F.ws + WS_HA); S.Bt = (const char*)(F.ws + WS_WT_E1) + (size_t)layer * NE * D * D * 2; S.srow = (const int*)(F.ws + WS_SROW); S.tile_off = toff; S.tile_ev = tev;
    S.nM = T; S.nN = 8; S.G = F.G; S.c = F.bid; S.tstepA = 0; S.tstepB = (size_t)256 * D * 2; S.estepB = (size_t)D * D * 2;
    pg8::EpiMoe1 E{(bf16*)(F.ws + WS_RH)};
    pg8::gemm_phase<pg8::EpiMoe1, pg8::SchedMoe, true>(F.lds, F.wave0, D, S, E);
}
__device__ __forceinline__ void moe_gemm2(Frame& F, int layer) {
    PHASE_IDS();
    LAS int* toff = (LAS int*)(F.lds + LDS_TILEE); LAS int* tev = (LAS int*)(F.lds + LDS_TILEV); LAS int* tT = (LAS int*)(F.lds + LDS_MISC + 192);
    if (tid == 0) { int T_ = 0; const unsigned* gc = (const unsigned*)(F.ws + WS_CTL) + CW_GCNT + layer * 16 * 64;
        for (int e = 0; e < NE; ++e) { const int n = (int)gc[e * 64]; for (int m0 = 0; m0 < n; m0 += 256) { toff[T_] = e * CAP + m0; tev[T_] = e | ((n - m0 < 256 ? n - m0 : 256) << 8); ++T_; } }
        *tT = T_; }
    __syncthreads();
    const int T = *tT;
    pg8::SchedMoe S; S.A = (const char*)(F.ws + WS_RH); S.Bt = (const char*)(F.ws + WS_WT_E2) + (size_t)layer * NE * D * DE * 2; S.srow = nullptr; S.tile_off = toff; S.tile_ev = tev;
    S.nM = T; S.nN = 8; S.G = F.G; S.c = F.bid; S.tstepA = (size_t)256 * DE * 2; S.tstepB = (size_t)256 * DE * 2; S.estepB = (size_t)D * DE * 2;
    pg8::EpiMoe2 E{(bf16*)(F.ws + WS_REX), (const int*)(F.ws + WS_SROW), (const float*)(F.ws + WS_SWT), toff, tev};
    pg8::gemm_phase<pg8::EpiMoe2, pg8::SchedMoe, false>(F.lds, F.wave0, DE, S, E);
}

constexpr int SC_QS = 0, SC_KS = 17408, SC_VS = 34816, SC_VW = 46080, SC_PS = 57344, SC_CB0 = 66560, SC_CB1 = 88320, SC_GA = 110080;
constexpr int QP = 136, VP = 88, PP = 72;
__device__ __forceinline__ bf16x8 lds_row8(const LAS unsigned char* base, int row, int pitch, int col) { return *(const LAS bf16x8*)(base + (row * pitch + col) * 2); }
typedef short v4i16_t __attribute__((ext_vector_type(4)));
__device__ __forceinline__ bf16x8 lds_tr8(const LAS unsigned char* base, int pitch, int k0, int x0, int lane) {
    const int g = lane >> 4, q = (lane & 15) >> 2, p = lane & 3;
    const LAS unsigned char* a = base + ((k0 + 8 * g + q) * pitch + x0 + 4 * p) * 2;
    const s16x4 lo = __builtin_bit_cast(s16x4, __builtin_amdgcn_ds_read_tr16_b64_v4i16((LAS v4i16_t*)a));
    const s16x4 hi = __builtin_bit_cast(s16x4, __builtin_amdgcn_ds_read_tr16_b64_v4i16((LAS v4i16_t*)(a + 4 * pitch * 2)));
    return (bf16x8){lo[0], lo[1], lo[2], lo[3], hi[0], hi[1], hi[2], hi[3]};
}
constexpr size_t WS_GSCR = 810 * MiB;
__device__ __forceinline__ float fexp(float x) { return __builtin_amdgcn_exp2f(x * 1.44269504088896f); }
__device__ __forceinline__ void scan_phase(Frame& F) {
    PHASE_IDS();
    const int x8 = F.bid & 7, y = F.bid >> 3, vs = y & 3, grp = x8 * 8 + (y >> 2), dir = grp & 1, hh = (grp >> 1) & 7, bb = grp >> 4;
    const int w = wave, i16 = lane & 15, g = lane >> 4;
    const bf16* QKVO = (const bf16*)(F.ws + WS_RC); const float* GT = (const float*)(F.ws + WS_GATES);
    bf16* HOUT = dir == 0 ? (bf16*)(F.ws + WS_RB) : (bf16*)(F.ws + WS_HB2);
    float* GS = (float*)(F.ws + WS_GSCR) + (size_t)F.bid * (68 * 192);
    LAS unsigned char* L = F.lds;
    LAS float* SE = (LAS float*)(L + SC_GA + 2560);
#define SCAN_TOK(step, r) ((step) < 4 ? (NLAT + bb * CTXL + (dir ? (CTXL - 1 - ((step) * 64 + (r))) : ((step) * 64 + (r)))) : (bb * SEQ + (dir ? (SEQ - 1 - (((step) - 4) * 64 + (r))) : (((step) - 4) * 64 + (r)))))
    for (int idx = tid; idx < 64 * 24; idx += NTHR) { const int r = idx / 24, c = 64 + idx % 24; ((LAS bf16*)(L + SC_VS))[r * VP + c] = (c == 64) ? (bf16)0x3F80 : (bf16)0; ((LAS bf16*)(L + SC_VW))[r * VP + c] = 0; }
    { const float big = F.in[I_MBG][(dir * 2) * 8 + hh], bfg = F.in[I_MBG][(dir * 2 + 1) * 8 + hh];
      for (int step = w; step < 68; step += NWAVES) {
        const size_t tg = (size_t)SCAN_TOK(step, lane); const float gi = GT[tg * 32 + (dir * 2) * 8 + hh] + big, gf = GT[tg * 32 + (dir * 2 + 1) * 8 + hh] + bfg;
        const float lf = fminf(gf, 0.f) - log1pf(expf(-fabsf(gf)));
        float bc = lf;
#pragma unroll
        for (int o = 1; o < 64; o <<= 1) { const float t = __shfl_up(bc, o); if (lane >= o) bc += t; }
        const float a = gi - bc; float cm = a;
#pragma unroll
        for (int o = 1; o < 64; o <<= 1) { const float t = __shfl_up(cm, o); if (lane >= o) cm = fmaxf(cm, t); }
        GS[step * 192 + lane] = a; GS[step * 192 + 64 + lane] = bc; GS[step * 192 + 128 + lane] = cm;
        if (lane == 63) { SE[step] = bc; SE[68 + step] = cm; } } }
    __syncthreads();
    if (tid == 0) { float m = 0.f; for (int st = 0; st < 68; ++st) { SE[136 + st] = m; m = SE[st] + fmaxf(m, SE[68 + st]); } }
    f32x4 accc[5];
#pragma unroll
    for (int i = 0; i < 5; ++i) accc[i] = (f32x4){0.f, 0.f, 0.f, 0.f};
    const int qr0 = tid >> 4, qc = (tid & 15) * 8;
    const int vr = tid >> 3, vc = (tid & 7) * 8;
    u32x4 rq0, rq1, rk0, rk1, rv; float ga = 0.f, gb = 0.f, gc = 0.f, av = 0.f;
#define SCAN_LOAD(step) do { const size_t t0_ = (size_t)SCAN_TOK(step, qr0), t1_ = (size_t)SCAN_TOK(step, qr0 + 32), tv_ = (size_t)SCAN_TOK(step, vr); \
        if ((step) >= 4) { rq0 = *(const u32x4*)(QKVO + t0_ * MLW + hh * DQK + qc); rq1 = *(const u32x4*)(QKVO + t1_ * MLW + hh * DQK + qc); } \
        rk0 = *(const u32x4*)(QKVO + t0_ * MLW + 1024 + hh * DQK + qc); rk1 = *(const u32x4*)(QKVO + t1_ * MLW + 1024 + hh * DQK + qc); \
        rv = *(const u32x4*)(QKVO + tv_ * MLW + 2048 + hh * DV + vs * 64 + vc); av = GS[(step) * 192 + vr]; \
        if (w == 0) { ga = GS[(step) * 192 + lane]; gb = GS[(step) * 192 + 64 + lane]; gc = GS[(step) * 192 + 128 + lane]; } } while (0)
    __syncthreads();
    SCAN_LOAD(0);
    for (int step = 0; step < 68; ++step) {
        const bool outp = step >= 4;
        LAS float* GA = (LAS float*)(L + SC_GA) + (step & 1) * 320;
        LAS unsigned char* CBc = L + ((step & 1) ? SC_CB1 : SC_CB0); LAS unsigned char* CBn = L + ((step & 1) ? SC_CB0 : SC_CB1);
        const float m_st = SE[136 + step], Mend = fmaxf(m_st, SE[68 + step]), decay = fexp(m_st - Mend);
        __syncthreads();
        if (w == 0) { const float M = fmaxf(m_st, gc); GA[lane] = ga; GA[64 + lane] = M; GA[128 + lane] = fexp(m_st - M); GA[192 + lane] = fexp(-(gb + M)); }
        if (outp) { *(LAS u32x4*)(L + SC_QS + (qr0 * QP + qc) * 2) = rq0; *(LAS u32x4*)(L + SC_QS + ((qr0 + 32) * QP + qc) * 2) = rq1; }
        *(LAS u32x4*)(L + SC_KS + (qr0 * QP + qc) * 2) = rk0; *(LAS u32x4*)(L + SC_KS + ((qr0 + 32) * QP + qc) * 2) = rk1;
        *(LAS u32x4*)(L + SC_VS + (vr * VP + vc) * 2) = rv;
        { const float wr_ = fexp(av - Mend); u32x4 o; o.x = cvt_pk_bf16(bf_lo(rv.x) * wr_, bf_hi(rv.x) * wr_); o.y = cvt_pk_bf16(bf_lo(rv.y) * wr_, bf_hi(rv.y) * wr_); o.z = cvt_pk_bf16(bf_lo(rv.z) * wr_, bf_hi(rv.z) * wr_); o.w = cvt_pk_bf16(bf_lo(rv.w) * wr_, bf_hi(rv.w) * wr_);
          *(LAS u32x4*)(L + SC_VW + (vr * VP + vc) * 2) = o;
          if (vc == 0) ((LAS bf16*)(L + SC_VW))[vr * VP + 64] = (bf16)(cvt_pk_bf16(wr_, 0.f) & 0xffffu); }
        if (step + 1 < 68) SCAN_LOAD(step + 1);
        __syncthreads();
        const int tb = w & 3;
        if (outp) {
            const int sb0 = 2 * (w >> 2);
            f32x4 sa[2] = {(f32x4){0.f, 0.f, 0.f, 0.f}, (f32x4){0.f, 0.f, 0.f, 0.f}};
#pragma unroll
            for (int ks = 0; ks < 4; ++ks) { const bf16x8 bq = lds_row8(L + SC_QS, 16 * tb + i16, QP, 32 * ks + 8 * g);
#pragma unroll
                for (int j = 0; j < 2; ++j) { const bf16x8 ak = lds_row8(L + SC_KS, 16 * (sb0 + j) + i16, QP, 32 * ks + 8 * g); sa[j] = __builtin_amdgcn_mfma_f32_16x16x32_bf16(ak, bq, sa[j], 0, 0, 0); } }
            const int t = 16 * tb + i16; const float Mt = GA[64 + t];
#pragma unroll
            for (int j = 0; j < 2; ++j) { const int s0 = 16 * (sb0 + j) + 4 * g; const f32x4 a4 = *(const LAS f32x4*)(GA + s0); float p[4];
#pragma unroll
                for (int r = 0; r < 4; ++r) p[r] = (s0 + r <= t) ? fexp(a4[r] - Mt) * sa[j][r] : 0.f;
                u32x2 o; o.x = cvt_pk_bf16(p[0], p[1]); o.y = cvt_pk_bf16(p[2], p[3]); *(LAS u32x2*)(L + SC_PS + (t * PP + s0) * 2) = o; }
        }
#pragma unroll
        for (int i = 0; i < 5; ++i) accc[i] = accc[i] * decay;
#pragma unroll
        for (int ks = 0; ks < 2; ++ks) { const bf16x8 ak = lds_tr8(L + SC_KS, QP, 32 * ks, 16 * w, lane);
#pragma unroll
            for (int i = 0; i < 5; ++i) { const bf16x8 bv = lds_tr8(L + SC_VW, VP, 32 * ks, 16 * i, lane); accc[i] = __builtin_amdgcn_mfma_f32_16x16x32_bf16(ak, bv, accc[i], 0, 0, 0); } }
#pragma unroll
        for (int i = 0; i < 5; ++i) { u32x2 o; o.x = cvt_pk_bf16(accc[i][0], accc[i][1]); o.y = cvt_pk_bf16(accc[i][2], accc[i][3]); *(LAS u32x2*)(CBn + ((16 * i + i16) * QP + 16 * w + 4 * g) * 2) = o; }
        if (outp) {
            __syncthreads();
            const int half = w >> 2; const int vb[3] = {2 * half, 2 * half + 1, 4};
            f32x4 oa[3] = {(f32x4){0.f, 0.f, 0.f, 0.f}, (f32x4){0.f, 0.f, 0.f, 0.f}, (f32x4){0.f, 0.f, 0.f, 0.f}};
#pragma unroll
            for (int ks = 0; ks < 4; ++ks) { const bf16x8 bq = lds_row8(L + SC_QS, 16 * tb + i16, QP, 32 * ks + 8 * g);
#pragma unroll
                for (int j = 0; j < 3; ++j) { const bf16x8 ac = lds_row8(CBc, 16 * vb[j] + i16, QP, 32 * ks + 8 * g); oa[j] = __builtin_amdgcn_mfma_f32_16x16x32_bf16(ac, bq, oa[j], 0, 0, 0); } }
            const int t = 16 * tb + i16; const float it = GA[128 + t];
#pragma unroll
            for (int j = 0; j < 3; ++j) oa[j] = oa[j] * it;
#pragma unroll
            for (int ks = 0; ks < 2; ++ks) { const bf16x8 bp = lds_row8(L + SC_PS, 16 * tb + i16, PP, 32 * ks + 8 * g);
#pragma unroll
                for (int j = 0; j < 3; ++j) { const bf16x8 av8 = lds_tr8(L + SC_VS, VP, 32 * ks, 16 * vb[j], lane); oa[j] = __builtin_amdgcn_mfma_f32_16x16x32_bf16(av8, bp, oa[j], 0, 0, 0); } }
            const float den = __shfl(oa[2][0], i16);
            const float inv = __builtin_amdgcn_rcpf(fmaxf(fabsf(den), GA[192 + t]));
            const size_t tok = (size_t)SCAN_TOK(step, t);
#pragma unroll
            for (int j = 0; j < 2; ++j) { u32x2 o; o.x = cvt_pk_bf16(oa[j][0] * inv, oa[j][1] * inv); o.y = cvt_pk_bf16(oa[j][2] * inv, oa[j][3] * inv);
                *(u32x2*)(HOUT + tok * D + hh * DV + vs * 64 + 16 * vb[j] + 4 * g) = o; }
        }
    }
    __syncthreads();
#undef SCAN_TOK
#undef SCAN_LOAD
}

__device__ __forceinline__ void headnorm_phase(Frame& F) {
    PHASE_IDS();
    const int gw = F.bid * NWAVES + wave, NGW = F.G * NWAVES;
    const bf16* HF = (const bf16*)(F.ws + WS_RB); const bf16* HB = (const bf16*)(F.ws + WS_HB2); const bf16* QKVO = (const bf16*)(F.ws + WS_RC); bf16* Y = (bf16*)(F.ws + WS_HA);
    const float* ng = F.in[I_MNG];
    f32x4 gn[4][2];
#pragma unroll
    for (int j = 0; j < 4; ++j) { gn[j][0] = *(const f32x4*)(ng + 512 * j + 8 * lane); gn[j][1] = *(const f32x4*)(ng + 512 * j + 8 * lane + 4); }
    u32x4 an[4], bn[4], on[4];
#define HN_LOAD(row) do { _Pragma("unroll") for (int j = 0; j < 4; ++j) { const int c = 512 * j + 8 * lane; an[j] = *(const u32x4*)(HF + (size_t)(row) * D + c); bn[j] = *(const u32x4*)(HB + (size_t)(row) * D + c); on[j] = *(const u32x4*)(QKVO + (size_t)(row) * MLW + 4096 + c); } } while (0)
    if (gw < NLAT) HN_LOAD(gw);
    for (int row = gw; row < NLAT; row += NGW) {
        u32x4 a[4], b[4], o[4];
#pragma unroll
        for (int j = 0; j < 4; ++j) { a[j] = an[j]; b[j] = bn[j]; o[j] = on[j]; }
        if (row + NGW < NLAT) HN_LOAD(row + NGW);
        SCHED_FENCE();
#pragma unroll
        for (int j = 0; j < 4; ++j) {
            float h[8]; float s = 0.f;
#pragma unroll
            for (int q = 0; q < 4; ++q) { h[2 * q] = bf_lo(a[j][q]) + bf_lo(b[j][q]); h[2 * q + 1] = bf_hi(a[j][q]) + bf_hi(b[j][q]); s += h[2 * q] + h[2 * q + 1]; }
#pragma unroll
            for (int o2 = 1; o2 < 32; o2 <<= 1) s += __shfl_xor(s, o2);
            const float mean = s * (1.f / DV); float s2 = 0.f;
#pragma unroll
            for (int q = 0; q < 8; ++q) { h[q] -= mean; s2 += h[q] * h[q]; }
#pragma unroll
            for (int o2 = 1; o2 < 32; o2 <<= 1) s2 += __shfl_xor(s2, o2);
            const float rstd = 1.0f / sqrtf(s2 * (1.f / DV) + HN_EPS);
            float yv[8];
#pragma unroll
            for (int q = 0; q < 4; ++q) { const float o0 = bf_lo(o[j][q]), o1 = bf_hi(o[j][q]); const float n0 = gn[j][q >> 1][2 * (q & 1)], n1 = gn[j][q >> 1][2 * (q & 1) + 1];
                yv[2 * q] = h[2 * q] * rstd * n0 * __builtin_amdgcn_rcpf(1.0f + __expf(-o0)); yv[2 * q + 1] = h[2 * q + 1] * rstd * n1 * __builtin_amdgcn_rcpf(1.0f + __expf(-o1)); }
            u32x4 wv; wv.x = cvt_pk_bf16(yv[0], yv[1]); wv.y = cvt_pk_bf16(yv[2], yv[3]); wv.z = cvt_pk_bf16(yv[4], yv[5]); wv.w = cvt_pk_bf16(yv[6], yv[7]);
            *(u32x4*)(Y + (size_t)row * D + 512 * j + 8 * lane) = wv;
        }
    }
#undef HN_LOAD
}

constexpr int NPH = 19;
__global__ void __launch_bounds__(NTHR, 2) fwd_kernel(Args args) {
    extern __shared__ __attribute__((aligned(16))) unsigned char lds_raw[];
    Frame F;
    F.lds = (LAS unsigned char*)lds_raw;
    F.G = gridDim.x; F.bid = blockIdx.x; F.wave0 = __builtin_amdgcn_readfirstlane(threadIdx.x >> 6);
#pragma unroll
    for (int i = 0; i < 21; ++i) F.in[i] = args.in[i];
    F.out = args.out; F.ws = args.ws;
    for (int u = threadIdx.x; u < (LDS_BYTES - LDSCTL_OFF) / 4; u += NTHR) ((LAS unsigned*)(F.lds + LDSCTL_OFF))[u] = 0u;
    __syncthreads();
#if MK_N_LAUNCHES == 1
    XcdBarrier bar = xcd_barrier_post((unsigned*)(F.ws + WS_CTL) + CW_BAR, (volatile LAS unsigned*)(F.lds + LDS_MISC));
#define GRID_BAR() xcd_barrier(bar)
#else
#define GRID_BAR() do { } while (0)
#endif
    const int lo = args.ph_lo, hi = args.ph_hi;
#ifndef PHASE_MASK
#define PHASE_MASK 0x7ffff
#endif
#define IN(k) (((PHASE_MASK >> (k)) & 1) && lo <= (k) && (k) < hi)
#define SEAM(k) do { if (IN(k) && IN((k) + 1)) GRID_BAR(); } while (0)

#ifndef DUP_MASK
#define DUP_MASK 0x0
#endif
#define PHASE(k, body) do { if (IN(k)) { body; if ((DUP_MASK >> (k)) & 1) { GRID_BAR(); body; } } SEAM(k); } while (0)
    PHASE(0, p0_prologue(F));
    PHASE(1, p1_modulate(F));
    PHASE(2, ({
        pg8::SchedPlain S; S.init((const bf16*)(F.ws + WS_HA), (const bf16*)(F.ws + WS_WT_CIN), NTOK, 6144, D, F.G, F.bid);
        pg8::EpiConv1 E{(bf16*)(F.ws + WS_RB), (bf16*)(F.ws + WS_RC)};
        pg8::gemm_phase<pg8::EpiConv1, pg8::SchedPlain, false>(F.lds, F.wave0, D, S, E); }));
    PHASE(3, p3_conv(F));
    PHASE(4, ({
        pg8::SchedPlain S; S.init((const bf16*)(F.ws + WS_HA), (const bf16*)(F.ws + WS_WT_COUT), NTOK, D, D, F.G, F.bid);
        pg8::EpiBf16 E{(bf16*)(F.ws + WS_RB), D};
        pg8::gemm_phase<pg8::EpiBf16, pg8::SchedPlain, false>(F.lds, F.wave0, D, S, E); }));
    PHASE(5, lnA_phase(F, 0));
    PHASE(7, moe_gemm1(F, 0));
    PHASE(8, moe_gemm2(F, 0));
    PHASE(9, lnB_phase(F, 0));
    PHASE(10, ({
        pg8::SchedPlain S; S.init((const bf16*)(F.ws + WS_HA), (const bf16*)(F.ws + WS_WT_MIN), NTOK, MLN, D, F.G, F.bid);
        pg8::EpiMlIn E{(bf16*)(F.ws + WS_RC), (float*)(F.ws + WS_GATES)};
        pg8::gemm_phase<pg8::EpiMlIn, pg8::SchedPlain, false>(F.lds, F.wave0, D, S, E); }));
    PHASE(11, scan_phase(F));
    PHASE(12, headnorm_phase(F));
    PHASE(13, ({
        pg8::SchedPlain S; S.init((const bf16*)(F.ws + WS_HA), (const bf16*)(F.ws + WS_WT_MOUT), NLAT, D, D, F.G, F.bid);
        pg8::EpiBf16 E{(bf16*)(F.ws + WS_RB), D};
        pg8::gemm_phase<pg8::EpiBf16, pg8::SchedPlain, false>(F.lds, F.wave0, D, S, E); }));
    PHASE(14, lnA_phase(F, 1));
    PHASE(16, moe_gemm1(F, 1));
    PHASE(17, moe_gemm2(F, 1));
    PHASE(18, lnB_phase(F, 1));
#undef PHASE
#undef IN
#undef SEAM
}

extern "C" void kernel_launch(void* const* d_in, const int* in_sizes, int n_in, void* d_out, int out_size, void* d_ws, size_t ws_size, hipStream_t stream) {
    static int grid = 0;
    if (grid == 0) {
        if (n_in != 21 || out_size != NLAT * D || ws_size < WS_END) { fprintf(stderr, "kernel_launch: unexpected problem (n_in %d, out %d, ws %zu; need ws >= %zu)\n", n_in, out_size, ws_size, (size_t)WS_END); grid = -1; return; }
        int dev = 0, cus = 0, per_cu = 0;
        if (hipGetDevice(&dev) != hipSuccess || hipDeviceGetAttribute(&cus, hipDeviceAttributeMultiprocessorCount, dev) != hipSuccess) { grid = -1; return; }
        if (hipFuncSetAttribute((const void*)fwd_kernel, hipFuncAttributeMaxDynamicSharedMemorySize, LDS_BYTES) != hipSuccess) { fprintf(stderr, "kernel_launch: hipFuncSetAttribute failed\n"); grid = -1; return; }
        if (hipOccupancyMaxActiveBlocksPerMultiprocessor(&per_cu, (const void*)fwd_kernel, NTHR, LDS_BYTES) != hipSuccess || per_cu < 1) fprintf(stderr, "kernel_launch: occupancy query reports %d\n", per_cu);
        (void)hipGetLastError();
        if (cus < GRID) { fprintf(stderr, "kernel_launch: needs %d CUs, device has %d\n", GRID, cus); grid = -1; return; }
        grid = GRID;
    }
    if (grid < 0) return;
    (void)in_sizes;
    if (hipMemsetAsync((char*)d_ws + WS_CTL, 0, CTL_ZERO_BYTES, stream) != hipSuccess) return;
    Args a{};
    for (int i = 0; i < 21; ++i) a.in[i] = (const float*)d_in[i];
    a.out = (float*)d_out; a.ws = (unsigned char*)d_ws;
#if MK_N_LAUNCHES == 1
    a.ph_lo = 0; a.ph_hi = NPH;
    hipLaunchKernelGGL(fwd_kernel, dim3(grid), dim3(NTHR), LDS_BYTES, stream, a);
#else
    for (int p = 0; p < NPH; ++p) { a.ph_lo = p; a.ph_hi = p + 1; hipLaunchKernelGGL(fwd_kernel, dim3(grid), dim3(NTHR), LDS_BYTES, stream, a); }
#endif
}
```
